# Optimizing an MI355X kernel written in HIP

```python
import jax, jax.numpy as jnp
from jax import lax
import numpy as np

D_MODEL = 1024
BATCH = 2
SEQ = 8192
DEPTH = 2
DEC_BATCH = 8
DEC_SEQ = 64
PAST_LEN = 2048

CHUNK = 64
N_A_LAYERS = DEPTH // 2
N_B_LAYERS = DEPTH - N_A_LAYERS
POOL_WINDOWS = (2, 4, 8, 16)
N_POOL_GROUPS = len(POOL_WINDOWS)
POOL_GROUP = D_MODEL // N_POOL_GROUPS
POOL_HIST = max(POOL_WINDOWS) - 1
N_HEADS = 16
HEAD_DIM = D_MODEL // N_HEADS
HD = N_HEADS * HEAD_DIM
D_FF = ((8 * D_MODEL // 3 + 127) // 128) * 128
Q_BLOCK = 128
RMS_EPS = 1e-6
FORGET_BIAS_INIT = 2.0

kernel_name = "yoco_pool_fox_streaming_step"


def _rms_norm(x, g):
    xf = x.astype(jnp.float32)
    y = xf * lax.rsqrt(jnp.mean(xf * xf, axis=-1, keepdims=True) + RMS_EPS)
    return (y * g.astype(jnp.float32)).astype(x.dtype)


def _swiglu(h, w_in, w_out):
    g, u = jnp.split(h @ w_in, 2, axis=-1)
    return (jax.nn.silu(g) * u) @ w_out


def _pool_mix(hist, u, pos0, w_pool, scale):
    B, T, D = u.shape
    full = jnp.concatenate([hist.astype(jnp.float32), u.astype(jnp.float32)], axis=1)
    cs = jnp.concatenate([jnp.zeros((B, 1, D), jnp.float32), jnp.cumsum(full, axis=1)], axis=1)
    P = POOL_HIST
    end = cs[:, P + 1:P + 1 + T]
    pos = pos0 + jnp.arange(T)
    outs = []
    for g, w in enumerate(POOL_WINDOWS):
        sl = slice(g * POOL_GROUP, (g + 1) * POOL_GROUP)
        start = cs[:, P + 1 - w:P + 1 - w + T, sl]
        cnt = jnp.minimum(pos + 1, w).astype(jnp.float32)[None, :, None]
        mean = (end[..., sl] - start) / cnt
        outs.append(mean - u[..., sl].astype(jnp.float32))
    d = jnp.stack(outs, axis=2).astype(u.dtype)
    y = jnp.einsum('btgc,gcd->btgd', d, w_pool).reshape(B, T, D)
    return y * scale


def _forget_attention(q, k, v, c_q, c_k):
    B, Tq = q.shape[0], q.shape[1]
    Tk = k.shape[1]
    scale = HEAD_DIM ** -0.5
    k_pos = jnp.arange(Tk)
    q_pos = jnp.arange(Tq) + (Tk - Tq)
    c_kT = jnp.transpose(c_k, (0, 2, 1))

    def block(args):
        qb, cqb, posb = args
        s = jnp.einsum('bqhd,bkhd->bhqk', qb, k, preferred_element_type=jnp.float32) * scale
        decay = jnp.transpose(cqb, (0, 2, 1))[..., None] - c_kT[:, :, None, :]
        mask = k_pos[None, :] <= posb[:, None]
        s = jnp.where(mask, s + decay, -jnp.inf)
        p = jax.nn.softmax(s, axis=-1)
        return jnp.einsum('bhqk,bkhd->bqhd', p.astype(v.dtype), v)

    if Tq <= Q_BLOCK:
        return block((q, c_q, q_pos))
    nb = Tq // Q_BLOCK
    qb = q.reshape(B, nb, Q_BLOCK, N_HEADS, HEAD_DIM).transpose(1, 0, 2, 3, 4)
    cqb = c_q.reshape(B, nb, Q_BLOCK, N_HEADS).transpose(1, 0, 2, 3)
    pb = q_pos.reshape(nb, Q_BLOCK)
    o = lax.map(block, (qb, cqb, pb))
    return o.transpose(1, 0, 2, 3, 4).reshape(B, Tq, N_HEADS, HEAD_DIM)


def _trunk(x, pool_hist, past, weights):
    (ln_ffn1, ln_mix, ln_ffn2, w_ffn_in, w_ffn_out, w_pool, pool_scale,
     ln_kv, w_kv, w_fgate, b_fgate, w_q, w_o, ln_final) = weights
    B, T, _ = x.shape
    pos0 = 0 if past is None else past[0].shape[1]
    new_pool = []
    k_all = v_all = c_k = c_q = None
    k_new = v_new = logf_new = None
    for l in range(DEPTH):
        x = x + 0.5 * _swiglu(_rms_norm(x, ln_ffn1[l]), w_ffn_in[l, 0], w_ffn_out[l, 0])
        u = _rms_norm(x, ln_mix[l])
        if l < N_A_LAYERS:
            hist = pool_hist[l].astype(u.dtype)
            x = x + _pool_mix(hist, u, pos0, w_pool[l], pool_scale[l])
            new_pool.append(jnp.concatenate([hist, u], axis=1)[:, -POOL_HIST:])
        else:
            j = l - N_A_LAYERS
            q = (u @ w_q[j]).reshape(B, T, N_HEADS, HEAD_DIM)
            o = _forget_attention(q, k_all, v_all, c_q, c_k)
            x = x + o.reshape(B, T, HD) @ w_o[j]
        x = x + 0.5 * _swiglu(_rms_norm(x, ln_ffn2[l]), w_ffn_in[l, 1], w_ffn_out[l, 1])
        if l == N_A_LAYERS - 1:
            kv_in = _rms_norm(x, ln_kv)
            kv = kv_in @ w_kv
            k_new = kv[..., :HD].reshape(B, T, N_HEADS, HEAD_DIM)
            v_new = kv[..., HD:].reshape(B, T, N_HEADS, HEAD_DIM)
            logf_new = jax.nn.log_sigmoid((kv_in @ w_fgate).astype(jnp.float32) + b_fgate.astype(jnp.float32))
            if past is None:
                k_all, v_all, logf_all = k_new, v_new, logf_new
            else:
                k_all = jnp.concatenate([past[0].astype(k_new.dtype), k_new], axis=1)
                v_all = jnp.concatenate([past[1].astype(v_new.dtype), v_new], axis=1)
                logf_all = jnp.concatenate([past[2].astype(jnp.float32), logf_new], axis=1)
            c_k = jnp.cumsum(logf_all, axis=1)
            c_q = c_k[:, -T:]
    y = _rms_norm(x, ln_final)
    return y, jnp.stack(new_pool), k_new, v_new, logf_new.astype(x.dtype)


def setup_inputs(seed: int = 0) -> dict:
    key = jax.random.key(seed)
    ks = jax.random.split(key, 24)

    def nrm(k, shape, scale):
        return jax.random.normal(k, shape, jnp.float32) * scale

    def gain(k, shape):
        return 1.0 + nrm(k, shape, 0.05)

    return {
        'x_prompt': nrm(ks[0], (BATCH, SEQ, D_MODEL), 1.0),
        'x_sample': nrm(ks[1], (DEC_BATCH, DEC_SEQ, D_MODEL), 1.0),
        'cache_pool': nrm(ks[2], (N_A_LAYERS, DEC_BATCH, POOL_HIST, D_MODEL), 1.0),
        'cache_k': nrm(ks[3], (DEC_BATCH, PAST_LEN, N_HEADS, HEAD_DIM), 1.0),
        'cache_v': nrm(ks[4], (DEC_BATCH, PAST_LEN, N_HEADS, HEAD_DIM), 1.0),
        'cache_logf': jax.nn.log_sigmoid(FORGET_BIAS_INIT + nrm(ks[5], (DEC_BATCH, PAST_LEN, N_HEADS), 1.0)),
        'ln_ffn1': gain(ks[6], (DEPTH, D_MODEL)),
        'ln_mix': gain(ks[7], (DEPTH, D_MODEL)),
        'ln_ffn2': gain(ks[8], (DEPTH, D_MODEL)),
        'w_ffn_in': nrm(ks[9], (DEPTH, 2, D_MODEL, 2 * D_FF), D_MODEL ** -0.5),
        'w_ffn_out': nrm(ks[10], (DEPTH, 2, D_FF, D_MODEL), D_FF ** -0.5),
        'w_pool': nrm(ks[11], (N_A_LAYERS, N_POOL_GROUPS, POOL_GROUP, POOL_GROUP), POOL_GROUP ** -0.5),
        'pool_scale': gain(ks[12], (N_A_LAYERS, D_MODEL)),
        'ln_kv': gain(ks[13], (D_MODEL,)),
        'w_kv': nrm(ks[14], (D_MODEL, 2 * HD), D_MODEL ** -0.5),
        'w_fgate': nrm(ks[15], (D_MODEL, N_HEADS), D_MODEL ** -0.5),
        'b_fgate': FORGET_BIAS_INIT + nrm(ks[16], (N_HEADS,), 0.1),
        'w_q': nrm(ks[17], (N_B_LAYERS, D_MODEL, HD), D_MODEL ** -0.5),
        'w_o': nrm(ks[18], (N_B_LAYERS, HD, D_MODEL), HD ** -0.5),
        'ln_final': gain(ks[19], (D_MODEL,)),
    }


def reference(x_prompt, x_sample, cache_pool, cache_k, cache_v, cache_logf,
              ln_ffn1, ln_mix, ln_ffn2, w_ffn_in, w_ffn_out, w_pool, pool_scale,
              ln_kv, w_kv, w_fgate, b_fgate, w_q, w_o, ln_final):
    weights = (ln_ffn1, ln_mix, ln_ffn2, w_ffn_in, w_ffn_out, w_pool, pool_scale,
               ln_kv, w_kv, w_fgate, b_fgate, w_q, w_o, ln_final)
    prompt_hist = jnp.zeros((N_A_LAYERS, x_prompt.shape[0], POOL_HIST, D_MODEL), x_prompt.dtype)
    y_prompt, pool_prompt, k_prompt, v_prompt, logf_prompt = _trunk(x_prompt, prompt_hist, None, weights)
    y_sample, pool_sample, k_sample, v_sample, logf_sample = _trunk(
        x_sample, cache_pool, (cache_k, cache_v, cache_logf), weights)
    return (y_prompt, y_sample, pool_prompt, pool_sample, k_prompt, v_prompt, logf_prompt,
            k_sample, v_sample, logf_sample)
```

```cpp
#include <hip/hip_runtime.h>
#include <hip/hip_cooperative_groups.h>
#include <cstdio>
#include <cstdint>
#include <cmath>
namespace cg = cooperative_groups;
namespace pg8 {
#define PG8_LAS __attribute__((address_space(3)))
typedef unsigned short bf16_t;
typedef short bf16x8 __attribute__((ext_vector_type(8)));
typedef float f32x4 __attribute__((ext_vector_type(4)));
typedef unsigned u32x4 __attribute__((ext_vector_type(4)));
constexpr int BM = 256, BK = 64, HALF = 128, HTB = HALF * BK * 2  , STAGE_BYTES = 8 * HTB, NXCD = 8, WGM = 8;

__host__ __device__ __forceinline__ int lds_byte(int r, int c) { const int st = (r >> 4) * 2 + (c >> 5), rr = r & 15, cc = c & 31, ob = rr * 64 + cc * 2; return st * 1024 + (ob ^ (((ob >> 9) & 1) << 5)); }
__host__ __device__ __forceinline__ void stage_rc(int b, int& R, int& C) { const int st = b / 1024, sb = b % 1024, swz = sb ^ (((sb >> 9) & 1) << 5); R = (st >> 1) * 16 + swz / 64; C = (st & 1) * 32 + (swz % 64) / 2; }
__host__ __device__ __forceinline__ int perm32(int rho) { const int n = rho >> 4, i = rho & 15; return 8 * (i >> 2) + 4 * n + (i & 3); }

struct Unit { int pm, pn; };
struct Gemm { const bf16_t* A; const bf16_t* Bt; int K; int lda; size_t a_pn_step; };

struct StaticOrder {
    int nM, nN, nwg, G, c;
    __host__ __device__ void init(int M, int N, int G_, int c_) { nM = M / BM; nN = N / BM; nwg = nM * nN; G = G_; c = c_; }
    __host__ __device__ bool next(int i, Unit& u) const {
        const long L = (long)i * G + c; if (L >= nwg) return false;
        int wgid = (int)L; { const int q = nwg / NXCD, r = nwg % NXCD, xcd = wgid % NXCD, off = wgid / NXCD; wgid = (xcd < r ? xcd * (q + 1) : r * (q + 1) + (xcd - r) * q) + off; }
        const int nig = WGM * nN, gid = wgid / nig, fm = gid * WGM, gsz = (nM - fm) < WGM ? (nM - fm) : WGM;
        u.pm = fm + ((wgid % nig) % gsz); u.pn = (wgid % nig) / gsz; return true;
    }
    __device__ __forceinline__ void a_ready(const Unit&) const {}
    __device__ __forceinline__ void done(const Unit&) const {}
};

__device__ __forceinline__ void map_tile(long L, int nM, int nN, Unit& u) {
    const int nwg = nM * nN; int wgid = (int)L; { const int q = nwg / NXCD, r = nwg % NXCD, xcd = wgid % NXCD, off = wgid / NXCD; wgid = (xcd < r ? xcd * (q + 1) : r * (q + 1) + (xcd - r) * q) + off; }
    const int nig = WGM * nN, gid = wgid / nig, fm = gid * WGM, gsz = (nM - fm) < WGM ? (nM - fm) : WGM;
    u.pm = fm + ((wgid % nig) % gsz); u.pn = (wgid % nig) / gsz;
}
struct RideOrder {
    static constexpr int GIVE = 3;
    int nN, c, nP, sample_e, orphanL;
    __device__ __forceinline__ void init(int nN_, int c_) {
        nN = nN_; c = c_; const int nwgP = 64 * nN, nS = 2 * nN;
        nP = (nwgP - c + 255) / 256; sample_e = (c >= 128 && c < 128 + nS) ? c - 128 : -1; orphanL = -1;
        if (c >= 248) nP -= GIVE;
        else if (c >= 128 + nS && c < 128 + nS + 8 * GIVE) { const int o = c - 128 - nS, sc = 248 + o / GIVE; orphanL = ((nwgP - sc + 255) / 256 - 1 - o % GIVE) * 256 + sc; }
    }
    __device__ __forceinline__ bool next(int i, Unit& u) const {
        if (sample_e >= 0) { if (i == 0) { u.pm = 64 + (sample_e & 1); u.pn = sample_e >> 1; return true; } --i; }
        long L; if (i < nP) L = (long)i * 256 + c; else if (i == nP && orphanL >= 0) L = orphanL; else return false;
        map_tile(L, 64, nN, u); return true;
    }
    __device__ __forceinline__ void a_ready(const Unit&) const {}
    __device__ __forceinline__ void done(const Unit&) const {}
};
struct OneUnit {
    int pm, pn;
    __device__ __forceinline__ bool next(int i, Unit& u) const { if (i != 0 || pm < 0) return false; u.pm = pm; u.pn = pn; return true; }
    __device__ __forceinline__ void a_ready(const Unit&) const {}
    __device__ __forceinline__ void done(const Unit&) const {}
};

constexpr int ROWS_P = 16384;
constexpr int DM_ = 1024, FF_ = 2816;
constexpr size_t OFF_KP = 17455104, OFF_VP = 34232320, OFF_KS = 51271680, OFF_VS = 51795968;
__device__ __forceinline__ unsigned cvt_pk_bf16(float lo, float hi) { unsigned r; asm volatile("v_cvt_pk_bf16_f32 %0, %1, %2" : "=v"(r) : "v"(lo), "v"(hi)); return r; }
__device__ __forceinline__ u32x4 pack8(const f32x4 a, const f32x4 b) { u32x4 w; w.x = cvt_pk_bf16(a[0], a[1]); w.y = cvt_pk_bf16(a[2], a[3]); w.z = cvt_pk_bf16(b[0], b[1]); w.w = cvt_pk_bf16(b[2], b[3]); return w; }
__device__ __forceinline__ float row_rstd(const float* SS, int row) {
    const f32x4* p = (const f32x4*)(SS + (size_t)row * 16);
    const f32x4 a = p[0], b = p[1], c = p[2], d = p[3];
    const float s = (((a[0] + a[1]) + (a[2] + a[3])) + ((b[0] + b[1]) + (b[2] + b[3]))) + (((c[0] + c[1]) + (c[2] + c[3])) + ((d[0] + d[1]) + (d[2] + d[3])));
    return rsqrtf(s * (1.0f / 1024.0f) + 1e-6f);
}
__device__ __forceinline__ void rows_rstd(const float* SS, int row0, int fq, float (&rs)[2][4]) {
    f32x4 t[2][4];
#pragma unroll
    for (int ai = 0; ai < 2; ++ai)
#pragma unroll
        for (int m = 0; m < 4; ++m) t[ai][m] = *(const f32x4*)(SS + (size_t)(row0 + ai * HALF + m * 16) * 16 + 4 * fq);
#pragma unroll
    for (int ai = 0; ai < 2; ++ai)
#pragma unroll
        for (int m = 0; m < 4; ++m) { float s = (t[ai][m][0] + t[ai][m][1]) + (t[ai][m][2] + t[ai][m][3]); s += __shfl_xor(s, 16); s += __shfl_xor(s, 32); rs[ai][m] = rsqrtf(s * (1.0f / 1024.0f) + 1e-6f); }
}
__device__ __forceinline__ float silu_mul(float g, float u) { return g * __builtin_amdgcn_rcpf(1.0f + __builtin_amdgcn_exp2f(-1.4426950408889634f * g)) * u; }

struct EpiSwiglu {
    static constexpr bool PERM = true, AFTER_DRAIN = false;
    bf16_t* ACT; const float* SS; int pn0; unsigned* cnt; PG8_LAS unsigned* lcnt;
    __device__ __forceinline__ void operator()(const f32x4 (&acc)[2][2][4][2], const Unit& u, int wr, int wc, int fr, int fq) const {
        const int row0 = u.pm * BM + wr * 64 + fr, col0 = (u.pn - pn0) * 128 + wc * 32 + 8 * fq;
        float rsv[2][4]; rows_rstd(SS, row0, fq, rsv);
#pragma unroll
        for (int ai = 0; ai < 2; ++ai)
#pragma unroll
            for (int m = 0; m < 4; ++m) {
                const int row = row0 + ai * HALF + m * 16; const float rs = rsv[ai][m];
                const float k1 = -1.4426950408889634f * rs, k2 = rs * rs;
                f32x4 h[2];
#pragma unroll
                for (int n = 0; n < 2; ++n) { const f32x4 g = acc[ai][0][m][n], uu = acc[ai][1][m][n]; const f32x4 t = g * k1; f32x4 ex;
#pragma unroll
                    for (int e = 0; e < 4; ++e) ex[e] = __builtin_amdgcn_exp2f(t[e]);
                    const f32x4 d = ex + 1.0f; f32x4 r;
#pragma unroll
                    for (int e = 0; e < 4; ++e) r[e] = __builtin_amdgcn_rcpf(d[e]);
                    h[n] = ((g * uu) * k2) * r; }
                *(u32x4*)(ACT + (size_t)row * FF_ + col0) = pack8(h[0], h[1]);
            }
        if (cnt && u.pm >= 64) {
            asm volatile("s_waitcnt vmcnt(0)" ::: "memory");
            unsigned old = 0u;
            if ((fr | fq) == 0) old = __hip_atomic_fetch_add(lcnt, 1u, __ATOMIC_RELAXED, __HIP_MEMORY_SCOPE_WORKGROUP);
            old = (unsigned)__builtin_amdgcn_readfirstlane((int)old);
            if (old == 7u) {
                if ((fr | fq) == 0) __hip_atomic_store(lcnt, 0u, __ATOMIC_RELAXED, __HIP_MEMORY_SCOPE_WORKGROUP);
                __builtin_amdgcn_fence(__ATOMIC_RELEASE, "agent");
                if ((fr | fq) == 0) __hip_atomic_fetch_add(cnt + 64 * (u.pm - 64), 8u, __ATOMIC_RELAXED, __HIP_MEMORY_SCOPE_AGENT);
            }
        }
    }
};
struct EpiRes {
    static constexpr bool PERM = true, AFTER_DRAIN = false;
    const float* in_lo; const float* in_hi;
    float* out32; bf16_t* XB; float* SS; const float* colscale; float alpha;
    __device__ __forceinline__ void operator()(const f32x4 (&acc)[2][2][4][2], const Unit& u, int wr, int wc, int fr, int fq) const {
        const int row0 = u.pm * BM + wr * 64 + fr, colw = u.pn * BM + wc * 32 + 8 * fq;
        f32x4 sc[2][2];
#pragma unroll
        for (int bj = 0; bj < 2; ++bj)
#pragma unroll
            for (int n = 0; n < 2; ++n) sc[bj][n] = colscale ? *(const f32x4*)(colscale + colw + bj * HALF + 4 * n) : (f32x4){alpha, alpha, alpha, alpha};
#define EPIRES_ROW(B0, B1, M_, BJ_) do { const int row = row0 + ai * HALF + (M_) * 16, col = colw + (BJ_) * HALF; \
            const f32x4 o0 = (B0) + sc[BJ_][0] * acc[ai][BJ_][M_][0], o1 = (B1) + sc[BJ_][1] * acc[ai][BJ_][M_][1]; \
            if (out32) { float* op = out32 + (size_t)row * DM_ + col; *(f32x4*)op = o0; *(f32x4*)(op + 4) = o1; } \
            *(u32x4*)(XB + (size_t)row * DM_ + col) = pack8(o0, o1); \
            ssq[M_] += ((o0[0] * o0[0] + o0[1] * o0[1]) + (o0[2] * o0[2] + o0[3] * o0[3])) + ((o1[0] * o1[0] + o1[1] * o1[1]) + (o1[2] * o1[2] + o1[3] * o1[3])); } while (0)
#pragma unroll
        for (int ai = 0; ai < 2; ++ai) {
            float ssq[4] = {0.f, 0.f, 0.f, 0.f};
            if (in_lo) {
#pragma unroll
                for (int mh = 0; mh < 2; ++mh) { f32x4 bq[2][2][2];
#pragma unroll
                    for (int mm = 0; mm < 2; ++mm) { const int row = row0 + ai * HALF + (2 * mh + mm) * 16; const float* bp = (row < ROWS_P) ? in_lo + (size_t)row * DM_ : in_hi + (size_t)(row - ROWS_P) * DM_;
#pragma unroll
                        for (int bj = 0; bj < 2; ++bj) { bq[mm][bj][0] = *(const f32x4*)(bp + colw + bj * HALF); bq[mm][bj][1] = *(const f32x4*)(bp + colw + bj * HALF + 4); } }
#pragma unroll
                    for (int mm = 0; mm < 2; ++mm)
#pragma unroll
                        for (int bj = 0; bj < 2; ++bj) EPIRES_ROW(bq[mm][bj][0], bq[mm][bj][1], 2 * mh + mm, bj); }
            } else {
                u32x4 bw[4][2];
#pragma unroll
                for (int m = 0; m < 4; ++m)
#pragma unroll
                    for (int bj = 0; bj < 2; ++bj) bw[m][bj] = *(const u32x4*)(XB + (size_t)(row0 + ai * HALF + m * 16) * DM_ + colw + bj * HALF);
#pragma unroll
                for (int m = 0; m < 4; ++m)
#pragma unroll
                    for (int bj = 0; bj < 2; ++bj) { const u32x4 w = bw[m][bj];
                        const f32x4 b0 = (f32x4){__uint_as_float(w.x << 16), __uint_as_float(w.x & 0xffff0000u), __uint_as_float(w.y << 16), __uint_as_float(w.y & 0xffff0000u)};
                        const f32x4 b1 = (f32x4){__uint_as_float(w.z << 16), __uint_as_float(w.z & 0xffff0000u), __uint_as_float(w.w << 16), __uint_as_float(w.w & 0xffff0000u)};
                        EPIRES_ROW(b0, b1, m, bj); }
            }
#pragma unroll
            for (int m = 0; m < 4; ++m) { float s = ssq[m]; s += __shfl_xor(s, 16); s += __shfl_xor(s, 32);
                if (fq == 0) SS[(size_t)(row0 + ai * HALF + m * 16) * 16 + u.pn * 4 + wc] = s; }
        }
#undef EPIRES_ROW
    }
};
struct EpiKV {
    static constexpr bool PERM = true, AFTER_DRAIN = false;
    float* dout; bf16_t* KBp; bf16_t* VBp; bf16_t* KSp; bf16_t* VSp; const float* SS; unsigned* KMX; unsigned* cnt;
    __device__ __forceinline__ void operator()(const f32x4 (&acc)[2][2][4][2], const Unit& u, int wr, int wc, int fr, int fq) const {
        const bool isV = u.pn >= 4, samp = u.pm >= 64; const int ct = (u.pn & 3) * BM;
        const int row0 = u.pm * BM + wr * 64 + fr, colw = ct + wc * 32 + 8 * fq;
        float rsv[2][4]; rows_rstd(SS, row0, fq, rsv);
#pragma unroll
        for (int ai = 0; ai < 2; ++ai) {
            float mx[2] = {0.f, 0.f};
#pragma unroll
            for (int m = 0; m < 4; ++m) {
                const int row = row0 + ai * HALF + m * 16; const float rs = rsv[ai][m];
                float* fp; bf16_t* bp;
                if (!samp) { fp = dout + (isV ? OFF_VP : OFF_KP) + (size_t)row * DM_; bp = (isV ? VBp : KBp) + (size_t)row * DM_; }
                else { const int r2 = row - ROWS_P, b = r2 >> 6, t = r2 & 63; fp = dout + (isV ? OFF_VS : OFF_KS) + (size_t)r2 * DM_; bp = (isV ? VSp : KSp) + (size_t)(b * 2112 + 2048 + t) * DM_; }
#pragma unroll
                for (int bj = 0; bj < 2; ++bj) {
                    const int col = colw + bj * HALF;
                    const f32x4 v0 = acc[ai][bj][m][0] * rs, v1 = acc[ai][bj][m][1] * rs;
                    __builtin_nontemporal_store(v0, (f32x4*)(fp + col)); __builtin_nontemporal_store(v1, (f32x4*)(fp + col + 4));
                    *(u32x4*)(bp + col) = pack8(v0, v1);
                    if (!isV) {
                        float n2 = ((v0[0] * v0[0] + v0[1] * v0[1]) + (v0[2] * v0[2] + v0[3] * v0[3])) + ((v1[0] * v1[0] + v1[1] * v1[1]) + (v1[2] * v1[2] + v1[3] * v1[3]));
                        n2 += __shfl_xor(n2, 16); n2 += __shfl_xor(n2, 32);
                        mx[bj] = fmaxf(mx[bj], n2);
                    }
                }
            }
            if (!isV) {
#pragma unroll
                for (int bj = 0; bj < 2; ++bj) {
                    float v = mx[bj];
                    v = fmaxf(v, __shfl_xor(v, 1)); v = fmaxf(v, __shfl_xor(v, 2)); v = fmaxf(v, __shfl_xor(v, 4)); v = fmaxf(v, __shfl_xor(v, 8));
                    const int sb = samp ? 2 + (u.pm - 64) * 4 + 2 * ai + wr : (u.pm >> 5);
                    const int head = (ct + bj * HALF + wc * 32) >> 6, half = wc & 1;
                    if (fr == 0 && fq == 0) atomicMax(KMX + (sb * 16 + head) * 2 + half, __float_as_uint(v));
                }
            }
        }
        if (cnt && samp) {
            if ((fr | fq) == 0) __hip_atomic_fetch_add(cnt + 64 * (u.pm - 64), 1u, __ATOMIC_RELAXED, __HIP_MEMORY_SCOPE_AGENT);
        }
    }
};
struct EpiQ {
    static constexpr bool PERM = true, AFTER_DRAIN = false;
    bf16_t* Q; const float* SS; float c2;
    __device__ __forceinline__ void operator()(const f32x4 (&acc)[2][2][4][2], const Unit& u, int wr, int wc, int fr, int fq) const {
        const int row0 = u.pm * BM + wr * 64 + fr, colw = u.pn * BM + wc * 32 + 8 * fq;
        float rsv[2][4]; rows_rstd(SS, row0, fq, rsv);
#pragma unroll
        for (int ai = 0; ai < 2; ++ai)
#pragma unroll
            for (int m = 0; m < 4; ++m) {
                const int row = row0 + ai * HALF + m * 16; const float rs = rsv[ai][m] * c2;
#pragma unroll
                for (int bj = 0; bj < 2; ++bj) *(u32x4*)(Q + (size_t)row * DM_ + colw + bj * HALF) = pack8(acc[ai][bj][m][0] * rs, acc[ai][bj][m][1] * rs);
            }
    }
};
struct EpiKVSwiglu {
    static constexpr bool PERM = true, AFTER_DRAIN = false;
    EpiKV kv; EpiSwiglu sw;
    __device__ __forceinline__ void operator()(const f32x4 (&acc)[2][2][4][2], const Unit& u, int wr, int wc, int fr, int fq) const {
        if (u.pn < 8) kv(acc, u, wr, wc, fr, fq); else sw(acc, u, wr, wc, fr, fq);
    }
};
template <class Epi, class Sched, bool ALIGN_EPI = false, bool SP2 = false>
__device__ __forceinline__ void gemm_phase(PG8_LAS unsigned char* lds, const Gemm g, const Sched& S, const Epi& E) {
    const int tid = threadIdx.x, wid = __builtin_amdgcn_readfirstlane(tid >> 6), lane = tid & 63, wr = wid >> 2, wc = wid & 3, fr = lane & 15, fq = lane >> 4;
    const int K = g.K, nt = K / BK;
    unsigned voffA[2], voffB[2];
#pragma unroll
    for (int i = 0; i < 2; ++i) { int R, C; stage_rc(tid * 16 + i * 8192, R, C); const int Rb = Epi::PERM ? ((R & ~31) + perm32(R & 31)) : R;
        voffA[i] = (unsigned)(R * g.lda + C) * 2u; voffB[i] = (unsigned)(Rb * K + C) * 2u; }
    const size_t kstep = (size_t)(BK * 2);
    const size_t hstepA = (size_t)HALF * g.lda * 2, hstepB = (size_t)HALF * K * 2;
    const size_t tstepA = 2 * hstepA, tstepB = 2 * hstepB;
    const unsigned ldsw = (unsigned)wid * 1024u;
    const int aoff = lds_byte(wr * 64 + fr, fq * 8), boff = lds_byte(wc * 32 + fr, fq * 8);
#define PG8_SA(b, h) (((b) * 2 + (h)) * HTB)
#define PG8_SB(b, h) ((4 + (b) * 2 + (h)) * HTB)
#define PG8_STAGE(bufoff, gbase, voff) do { _Pragma("unroll") for (int _i = 0; _i < 2; ++_i) \
        __builtin_amdgcn_global_load_lds((const unsigned*)((const char*)(gbase) + (voff)[_i]), (PG8_LAS unsigned*)(lds + (bufoff) + ldsw + _i * 8192), 16, 0, 0); } while (0)
#define PG8_LDA(dst, b, h) do { _Pragma("unroll") for (int m = 0; m < 4; ++m) _Pragma("unroll") for (int k = 0; k < 2; ++k) dst[m][k] = *(const PG8_LAS bf16x8*)(lds + PG8_SA(b, h) + aoff + m * 2048 + k * 1024); } while (0)
#define PG8_LDB(dst, b, h) do { _Pragma("unroll") for (int n = 0; n < 2; ++n) _Pragma("unroll") for (int k = 0; k < 2; ++k) dst[n][k] = *(const PG8_LAS bf16x8*)(lds + PG8_SB(b, h) + boff + n * 2048 + k * 1024); } while (0)
#define PG8_MMA(ai, bj, At, Bt) do { __builtin_amdgcn_s_setprio(1); _Pragma("unroll") for (int m = 0; m < 4; ++m) _Pragma("unroll") for (int n = 0; n < 2; ++n) _Pragma("unroll") for (int k = 0; k < 2; ++k) \
        acc[ai][bj][m][n] = __builtin_amdgcn_mfma_f32_16x16x32_bf16(Bt[n][k], At[m][k], acc[ai][bj][m][n], 0, 0, 0); __builtin_amdgcn_s_setprio(0); } while (0)
#define PG8_WAIT_V(n) asm volatile("s_waitcnt vmcnt(" #n ")" ::: "memory")
#define PG8_WAIT_L(n) asm volatile("s_waitcnt lgkmcnt(" #n ")" ::: "memory")
#define PG8_BAR __builtin_amdgcn_s_barrier()
#define PG8_SCHED __builtin_amdgcn_sched_barrier(0)
    Unit cur, nxt; int ui = 0;
    if (!S.next(0, cur)) return;
    f32x4 acc[2][2][4][2];
#pragma unroll
    for (int a = 0; a < 2; ++a)
#pragma unroll
        for (int b = 0; b < 2; ++b)
#pragma unroll
            for (int m = 0; m < 4; ++m)
#pragma unroll
                for (int n = 0; n < 2; ++n) acc[a][b][m][n] = (f32x4){0.f, 0.f, 0.f, 0.f};
    bf16x8 At[4][2], B0[2][2], B1[2][2];
    const char* cA = (const char*)g.A + (size_t)cur.pm * tstepA + (size_t)cur.pn * g.a_pn_step; const char* cB = (const char*)g.Bt + (size_t)cur.pn * tstepB;
    S.a_ready(cur);
    if constexpr (SP2) {
        PG8_STAGE(PG8_SB(0, 0), cB, voffB); PG8_STAGE(PG8_SB(0, 1), cB + hstepB, voffB); PG8_STAGE(PG8_SA(0, 0), cA, voffA); PG8_STAGE(PG8_SA(0, 1), cA + hstepA, voffA);
        if (wr == 1) PG8_BAR;
        PG8_WAIT_V(2); PG8_BAR;
        PG8_STAGE(PG8_SB(1, 0), cB + kstep, voffB); PG8_STAGE(PG8_SA(1, 0), cA + kstep, voffA); PG8_STAGE(PG8_SB(1, 1), cB + hstepB + kstep, voffB);
        PG8_WAIT_V(6); PG8_BAR;
    } else {
        PG8_STAGE(PG8_SB(0, 0), cB, voffB); PG8_STAGE(PG8_SA(0, 0), cA, voffA); PG8_STAGE(PG8_SB(0, 1), cB + hstepB, voffB); PG8_STAGE(PG8_SA(0, 1), cA + hstepA, voffA);
        if (wr == 1) PG8_BAR;
        PG8_WAIT_V(4); PG8_BAR;
        PG8_STAGE(PG8_SB(1, 0), cB + kstep, voffB); PG8_STAGE(PG8_SA(1, 0), cA + kstep, voffA); PG8_STAGE(PG8_SB(1, 1), cB + hstepB + kstep, voffB);
        PG8_WAIT_V(6); PG8_BAR;
    }
    for (;;) {
        const bool has_next = S.next(ui + 1, nxt);
        const char* nA = has_next ? (const char*)g.A + (size_t)nxt.pm * tstepA + (size_t)nxt.pn * g.a_pn_step : cA; const char* nB = has_next ? (const char*)g.Bt + (size_t)nxt.pn * tstepB : cB;
        for (int t = 0; t < nt; t += 2) {
            const bool last = (t == nt - 2);
            const char* a1 = cA + (size_t)(t + 1) * kstep;
            const char* a2 = last ? nA : cA + (size_t)(t + 2) * kstep; const char* b2 = last ? nB : cB + (size_t)(t + 2) * kstep;
            const char* a3 = a2 + kstep; const char* b3 = b2 + kstep;
            if (last && has_next) S.a_ready(nxt);
            if constexpr (SP2) {
            PG8_LDB(B0, 0, 0); PG8_LDB(B1, 0, 1); PG8_SCHED; PG8_LDA(At, 0, 0); PG8_STAGE(PG8_SA(1, 1), a1 + hstepA, voffA);
            PG8_WAIT_V(8); PG8_WAIT_L(0); PG8_BAR; PG8_MMA(0, 0, At, B0); PG8_MMA(0, 1, At, B1); PG8_BAR; PG8_SCHED;
            PG8_LDA(At, 0, 1); PG8_STAGE(PG8_SB(0, 0), b2, voffB); PG8_STAGE(PG8_SB(0, 1), b2 + hstepB, voffB); PG8_STAGE(PG8_SA(0, 0), a2, voffA);
            PG8_WAIT_V(8); PG8_WAIT_L(0); PG8_BAR; PG8_MMA(1, 0, At, B0); PG8_MMA(1, 1, At, B1); PG8_BAR; PG8_SCHED;
            PG8_LDB(B0, 1, 0); PG8_LDB(B1, 1, 1); PG8_SCHED; PG8_LDA(At, 1, 0); PG8_STAGE(PG8_SA(0, 1), a2 + hstepA, voffA);
            PG8_WAIT_V(8); PG8_WAIT_L(0); PG8_BAR; PG8_MMA(0, 0, At, B0); PG8_MMA(0, 1, At, B1); PG8_BAR; PG8_SCHED;
            PG8_LDA(At, 1, 1); PG8_STAGE(PG8_SB(1, 0), b3, voffB); PG8_STAGE(PG8_SB(1, 1), b3 + hstepB, voffB); PG8_STAGE(PG8_SA(1, 0), a3, voffA);
            PG8_WAIT_V(8); PG8_WAIT_L(0); PG8_BAR; PG8_MMA(1, 0, At, B0); PG8_MMA(1, 1, At, B1); PG8_BAR; PG8_SCHED;
            } else {
            PG8_LDB(B0, 0, 0); PG8_SCHED; PG8_LDA(At, 0, 0); PG8_STAGE(PG8_SA(1, 1), a1 + hstepA, voffA);
            PG8_WAIT_L(8); PG8_BAR; PG8_WAIT_L(0); PG8_MMA(0, 0, At, B0); PG8_BAR; PG8_SCHED;
            PG8_LDB(B1, 0, 1); PG8_STAGE(PG8_SB(0, 0), b2, voffB);
            PG8_BAR; PG8_WAIT_L(0); PG8_MMA(0, 1, At, B1); PG8_BAR;
            PG8_LDA(At, 0, 1); PG8_STAGE(PG8_SA(0, 0), a2, voffA);
            PG8_BAR; PG8_WAIT_L(0); PG8_MMA(1, 0, At, B0); PG8_BAR; PG8_SCHED;
            PG8_STAGE(PG8_SB(0, 1), b2 + hstepB, voffB);
            PG8_WAIT_V(6); PG8_BAR; PG8_MMA(1, 1, At, B1); PG8_BAR;
            PG8_LDB(B0, 1, 0); PG8_SCHED; PG8_LDA(At, 1, 0); PG8_STAGE(PG8_SA(0, 1), a2 + hstepA, voffA);
            PG8_WAIT_L(8); PG8_BAR; PG8_WAIT_L(0); PG8_MMA(0, 0, At, B0); PG8_BAR; PG8_SCHED;
            PG8_LDB(B1, 1, 1); PG8_STAGE(PG8_SB(1, 0), b3, voffB);
            PG8_BAR; PG8_WAIT_L(0); PG8_MMA(0, 1, At, B1); PG8_BAR;
            PG8_LDA(At, 1, 1); PG8_STAGE(PG8_SA(1, 0), a3, voffA);
            PG8_BAR; PG8_WAIT_L(0); PG8_MMA(1, 0, At, B0); PG8_BAR; PG8_SCHED;
            PG8_STAGE(PG8_SB(1, 1), b3 + hstepB, voffB);
            PG8_WAIT_V(6); PG8_BAR; PG8_MMA(1, 1, At, B1); PG8_BAR;
            }
        }
        if constexpr (ALIGN_EPI) { if (wr == 0) PG8_BAR; }
        if constexpr (!Epi::AFTER_DRAIN) { E(acc, cur, wr, wc, fr, fq); S.done(cur); }
        if (!has_next) break;
#pragma unroll
        for (int a = 0; a < 2; ++a)
#pragma unroll
            for (int b = 0; b < 2; ++b)
#pragma unroll
                for (int m = 0; m < 4; ++m)
#pragma unroll
                    for (int n = 0; n < 2; ++n) acc[a][b][m][n] = (f32x4){0.f, 0.f, 0.f, 0.f};
        cur = nxt; cA = nA; cB = nB; ++ui;
        if constexpr (ALIGN_EPI) { if (wr == 1) PG8_BAR; }
    }
    PG8_WAIT_V(0);
    if constexpr (!ALIGN_EPI) { if (wr == 0) PG8_BAR; }
    PG8_BAR;
    if constexpr (Epi::AFTER_DRAIN) { E.fused(acc, cur, wr, wc, fr, fq, lds, wid, lane); S.done(cur); }
#undef PG8_SA
#undef PG8_SB
#undef PG8_STAGE
#undef PG8_LDA
#undef PG8_LDB
#undef PG8_MMA
#undef PG8_WAIT_V
#undef PG8_WAIT_L
#undef PG8_BAR
#undef PG8_SCHED
}}

namespace att {
#define ALAS __attribute__((address_space(3)))
using bf16 = unsigned short;
using bf16x8 = __attribute__((ext_vector_type(8))) short;
using s16x4 = __attribute__((ext_vector_type(4))) short;
using f32x16 = __attribute__((ext_vector_type(16))) float;
using f32x4 = __attribute__((ext_vector_type(4))) float;
using u32x4 = __attribute__((ext_vector_type(4))) unsigned;
typedef float f32x2_t __attribute__((ext_vector_type(2))); typedef __bf16 bf16x2_t __attribute__((ext_vector_type(2)));
#ifndef ATT_PREFETCH
#define ATT_PREFETCH 1
#endif
#ifndef ATT_EXIT_LOG2
#define ATT_EXIT_LOG2 -48.f
#endif
#ifndef ATT_EARLY_EXIT
#define ATT_EARLY_EXIT 1
#endif
constexpr int WLDS = 8192 + 4096 + 256 + 256;
__device__ __forceinline__ int crow(int r, int hi) { return (r & 3) + 8 * (r >> 2) + 4 * hi; }
__device__ __forceinline__ unsigned cvtpk_s(float lo, float hi) { f32x2_t v = {lo, hi}; bf16x2_t b = __builtin_convertvector(v, bf16x2_t); return __builtin_bit_cast(unsigned, b); }
__device__ __forceinline__ float bf2f(short s) { return __uint_as_float(((unsigned)(unsigned short)s) << 16); }
typedef short v4i16_t __attribute__((ext_vector_type(4)));
__device__ __forceinline__ s16x4 vtr(const ALAS unsigned char* p) { return __builtin_bit_cast(s16x4, __builtin_amdgcn_ds_read_tr16_b64_v4i16((ALAS v4i16_t*)p)); }
__device__ __forceinline__ void pv(f32x16* o, const ALAS unsigned char* vp, bf16x8 pa0, bf16x8 pa1, bf16x8 pa2, bf16x8 pa3) {
#pragma unroll
    for (int d0 = 0; d0 < 2; ++d0) { s16x4 lo[4], hi[4];
#pragma unroll
        for (int ks = 0; ks < 4; ++ks) { lo[ks] = vtr(vp + d0 * 4096 + ks * 1024); hi[ks] = vtr(vp + d0 * 4096 + ks * 1024 + 512); }
#define PK(k) (bf16x8){lo[k][0], lo[k][1], lo[k][2], lo[k][3], hi[k][0], hi[k][1], hi[k][2], hi[k][3]}
        o[d0] = __builtin_amdgcn_mfma_f32_32x32x16_bf16(pa0, PK(0), o[d0], 0, 0, 0);
        o[d0] = __builtin_amdgcn_mfma_f32_32x32x16_bf16(pa1, PK(1), o[d0], 0, 0, 0);
        o[d0] = __builtin_amdgcn_mfma_f32_32x32x16_bf16(pa2, PK(2), o[d0], 0, 0, 0);
        o[d0] = __builtin_amdgcn_mfma_f32_32x32x16_bf16(pa3, PK(3), o[d0], 0, 0, 0);
#undef PK
    }
}
__device__ __forceinline__ void wave_unit(const bf16* Qp, bf16* Op, const bf16* Kp, const bf16* Vp, const float* ckl, int qpos0, float kmaxn, ALAS unsigned char* wl, int lane) {
    const int r32 = lane & 31, hi = lane >> 5;
    ALAS unsigned char* vt = wl; ALAS bf16* stg = (ALAS bf16*)(wl + 8192); ALAS float* wsf = (ALAS float*)(wl + 8192 + 4096);
    const ALAS unsigned char* vp = vt + ((lane >> 4) & 1) * 32 + (lane & 3) * 8 + (4 * hi + ((lane & 15) >> 2)) * 64;
    bf16x8 qr[4];
#pragma unroll
    for (int d0 = 0; d0 < 4; ++d0) qr[d0] = *(const bf16x8*)(Qp + (size_t)r32 * 1024 + d0 * 16 + hi * 8);
    float qn2 = 0.f;
#pragma unroll
    for (int d0 = 0; d0 < 4; ++d0)
#pragma unroll
        for (int e = 0; e < 8; ++e) { const float v = bf2f(qr[d0][e]); qn2 += v * v; }
    qn2 += __shfl_xor(qn2, 32);
    const float qkb = __builtin_amdgcn_sqrtf(qn2) * kmaxn * 1.03f + 1.0f;
    const float cq = ckl[qpos0 + r32];
    float mref = 0.f, l = 0.f; f32x16 o[2]; o[0] = f32x16{}; o[1] = f32x16{};
    const int jd = (qpos0 + 31) >> 6;
    bf16x8 kf[8]; f32x4 bpre;
    ALAS float* bl = (ALAS float*)(wl + 8192 + 4096 + 256);
#define ATT_LOADK(JT) do { const bf16* kp_ = Kp + (size_t)(64 * (JT) + r32) * 1024 + hi * 8; \
        _Pragma("unroll") for (int d0 = 0; d0 < 4; ++d0) { kf[2 * d0] = *(const bf16x8*)(kp_ + d0 * 16); kf[2 * d0 + 1] = *(const bf16x8*)(kp_ + 32 * 1024 + d0 * 16); } \
        bpre = *(const f32x4*)(ckl + 64 * (JT) + 4 * (lane & 15)); } while (0)
#define ATT_LOADV(JT) do { _Pragma("unroll") for (int w = 0; w < 8; ++w) __builtin_amdgcn_global_load_lds((const unsigned*)(Vp + (size_t)(64 * (JT) + 16 * (w & 3) + (lane >> 2)) * 1024 + 32 * (w >> 2) + 8 * (lane & 3)), \
        (ALAS unsigned*)(vt + w * 1024), 16, 0, 0); } while (0)
    ATT_LOADK(jd); ATT_LOADV(jd);
    for (int j = jd; j >= 0; --j) {
        const int s0 = 64 * j;
        f32x16 p0, p1; const float base = cq - mref;
        if (lane < 16) *(ALAS f32x4*)(bl + 4 * lane) = bpre;
#pragma unroll
        for (int jj = 0; jj < 4; ++jj) { const f32x4 a = *(const ALAS f32x4*)(bl + 8 * jj + 4 * hi), b = *(const ALAS f32x4*)(bl + 32 + 8 * jj + 4 * hi);
#pragma unroll
            for (int e = 0; e < 4; ++e) { p0[4 * jj + e] = base - a[e]; p1[4 * jj + e] = base - b[e]; } }
#pragma unroll
        for (int d0 = 0; d0 < 4; ++d0) { p0 = __builtin_amdgcn_mfma_f32_32x32x16_bf16(kf[2 * d0], qr[d0], p0, 0, 0, 0); p1 = __builtin_amdgcn_mfma_f32_32x32x16_bf16(kf[2 * d0 + 1], qr[d0], p1, 0, 0, 0); }
        if (j > 0) ATT_LOADK(j - 1);
        if (j == jd) { const int qp = qpos0 + r32;
#pragma unroll
            for (int r = 0; r < 16; ++r) { const int kv = s0 + crow(r, hi); if (kv > qp) p0[r] = -INFINITY; if (kv + 32 > qp) p1[r] = -INFINITY; } }
        float rm;
        { float a = fmaxf(p0[0], p1[0]);
#pragma unroll
          for (int r = 1; r < 16; ++r) a = fmaxf(a, fmaxf(p0[r], p1[r]));
          rm = fmaxf(a, __shfl_xor(a, 32)); }
        if (j == jd) {
            mref = rm;
#pragma unroll
            for (int r = 0; r < 16; ++r) { p0[r] -= rm; p1[r] -= rm; }
        } else if (__any(rm > 0.f)) {
            const float dl = fmaxf(rm, 0.f); mref += dl;
#pragma unroll
            for (int r = 0; r < 16; ++r) { p0[r] -= dl; p1[r] -= dl; }
            const float f = __builtin_amdgcn_exp2f(-dl); l *= f; if (hi == 0) wsf[r32] = f;
            asm volatile("s_waitcnt lgkmcnt(0)" ::: "memory");
#pragma unroll
            for (int d_ = 0; d_ < 2; ++d_)
#pragma unroll
                for (int r = 0; r < 16; ++r) o[d_][r] *= wsf[crow(r, hi)];
        }
        float sacc = 0.f;
#pragma unroll
        for (int r = 0; r < 16; ++r) { p0[r] = __builtin_amdgcn_exp2f(p0[r]); p1[r] = __builtin_amdgcn_exp2f(p1[r]); sacc += p0[r] + p1[r]; }
        l += sacc;
        u32x4 pw0, pw1, pw2, pw3;
        pw0 = (u32x4){cvtpk_s(p0[0], p0[1]), cvtpk_s(p0[2], p0[3]), cvtpk_s(p0[4], p0[5]), cvtpk_s(p0[6], p0[7])};
        pw1 = (u32x4){cvtpk_s(p0[8], p0[9]), cvtpk_s(p0[10], p0[11]), cvtpk_s(p0[12], p0[13]), cvtpk_s(p0[14], p0[15])};
        pw2 = (u32x4){cvtpk_s(p1[0], p1[1]), cvtpk_s(p1[2], p1[3]), cvtpk_s(p1[4], p1[5]), cvtpk_s(p1[6], p1[7])};
        pw3 = (u32x4){cvtpk_s(p1[8], p1[9]), cvtpk_s(p1[10], p1[11]), cvtpk_s(p1[12], p1[13]), cvtpk_s(p1[14], p1[15])};
        if (j > 0) asm volatile("s_waitcnt vmcnt(9)" ::: "memory"); else asm volatile("s_waitcnt vmcnt(0)" ::: "memory");
        pv(o, vp, __builtin_bit_cast(bf16x8, pw0), __builtin_bit_cast(bf16x8, pw1), __builtin_bit_cast(bf16x8, pw2), __builtin_bit_cast(bf16x8, pw3));
        asm volatile("s_waitcnt lgkmcnt(0)" ::: "memory");
#if ATT_EARLY_EXIT
        if (j > 0) { const float cl = __uint_as_float(__builtin_amdgcn_readlane(__float_as_uint(bpre[3]), 15));
            const float ub = qkb + (cq - cl) - mref; if (!__any(ub > ATT_EXIT_LOG2)) break; }
#endif
        if (j > 0) ATT_LOADV(j - 1);
    }
    l += __shfl_xor(l, 32);
    if (hi == 0) wsf[32 + r32] = l;
    asm volatile("s_waitcnt lgkmcnt(0)" ::: "memory");
    float rli[16];
#pragma unroll
    for (int r = 0; r < 16; ++r) rli[r] = 1.0f / wsf[32 + crow(r, hi)];
#pragma unroll
    for (int r = 0; r < 16; ++r) { const int orow = crow(r, hi);
#pragma unroll
        for (int d0 = 0; d0 < 2; ++d0) { const unsigned w = cvtpk_s(o[d0][r] * rli[r], 0.f); stg[orow * 64 + d0 * 32 + r32] = (bf16)(w & 0xffffu); } }
    asm volatile("s_waitcnt lgkmcnt(0)" ::: "memory");
#pragma unroll
    for (int i = 0; i < 4; ++i) { const int row = i * 8 + (lane >> 3), ch = lane & 7; const u32x4 v = *(const ALAS u32x4*)(stg + row * 64 + ch * 8); *(u32x4*)(Op + (size_t)row * 1024 + ch * 8) = v; }
    asm volatile("s_waitcnt lgkmcnt(0)" ::: "memory");
}

constexpr int G_K = 0, G_V = 16384, G_PW = 32768, G_PWB = 4096 + 256 + 256, G_FLAG = G_PW + 8 * G_PWB, G_BYTES = G_FLAG + 64;
__device__ __forceinline__ void wg_unit(const bf16* Qb, bf16* Ob, const bf16* Kp, const bf16* Vp, const float* ckl, int qbase, int nact, float kmaxn, ALAS unsigned char* L, int wave, int lane) {
    const int r32 = lane & 31, hi = lane >> 5;
    ALAS unsigned char* pw = L + G_PW + wave * G_PWB;
    ALAS bf16* stg = (ALAS bf16*)pw; ALAS float* wsf = (ALAS float*)(pw + 4096); ALAS float* bl = (ALAS float*)(pw + 4096 + 256);
    ALAS unsigned* flags = (ALAS unsigned*)(L + G_FLAG);
    const bool active = wave < nact;
    const int qpos0 = qbase + 32 * wave, jd = (qpos0 + 31) >> 6, jmax = (qbase + 32 * nact - 1) >> 6;
    __syncthreads();
    if (threadIdx.x < 16) flags[threadIdx.x] = 0u;
    const ALAS unsigned char* vpo = L + G_V + ((lane >> 4) & 1) * 32 + (lane & 3) * 8 + (4 * hi + ((lane & 15) >> 2)) * 64;
#define WG_DMA(JT) do { const int sl_ = ((JT) & 1) * 8192; \
        __builtin_amdgcn_global_load_lds((const unsigned*)(Kp + (size_t)(64 * (JT) + lane) * 1024 + 8 * wave), (ALAS unsigned*)(L + G_K + sl_ + wave * 1024), 16, 0, 0); \
        __builtin_amdgcn_global_load_lds((const unsigned*)(Vp + (size_t)(64 * (JT) + 16 * (wave & 3) + (lane >> 2)) * 1024 + 32 * (wave >> 2) + 8 * (lane & 3)), (ALAS unsigned*)(L + G_V + sl_ + wave * 1024), 16, 0, 0); } while (0)
    WG_DMA(jmax);
    bf16x8 qr[4]; float qkb = 0.f, cq = 0.f;
    if (active) {
#pragma unroll
        for (int d0 = 0; d0 < 4; ++d0) qr[d0] = *(const bf16x8*)(Qb + (size_t)(32 * wave + r32) * 1024 + d0 * 16 + hi * 8);
        float qn2 = 0.f;
#pragma unroll
        for (int d0 = 0; d0 < 4; ++d0)
#pragma unroll
            for (int e = 0; e < 8; ++e) { const float v = bf2f(qr[d0][e]); qn2 += v * v; }
        qn2 += __shfl_xor(qn2, 32);
        qkb = __builtin_amdgcn_sqrtf(qn2) * kmaxn * 1.03f + 1.0f;
        cq = ckl[qpos0 + r32];
    } else {
#pragma unroll
        for (int d0 = 0; d0 < 4; ++d0) qr[d0] = bf16x8{};
    }
    float mref = 0.f, l = 0.f; f32x16 o[2]; o[0] = f32x16{}; o[1] = f32x16{};
    f32x4 bpre = *(const f32x4*)(ckl + 64 * jmax + 4 * (lane & 15));
    bool done = false;
    for (int j = jmax; j >= 0; --j) {
        asm volatile("s_waitcnt vmcnt(0)" ::: "memory");
        __syncthreads();
        { unsigned nd = 0;
#pragma unroll
          for (int w = 0; w < 8; ++w) nd += (w < nact) ? flags[((j + 1) & 1) * 8 + w] : 0u;
          if (nd >= (unsigned)nact) break; }
        if (j > 0) WG_DMA(j - 1);
        const f32x4 bcur = bpre;
        if (j > 0) bpre = *(const f32x4*)(ckl + 64 * (j - 1) + 4 * (lane & 15));
        if (active && !done && j <= jd) {
            const ALAS unsigned char* ks = L + G_K + (j & 1) * 8192 + hi * 1024 + r32 * 16;
            f32x16 p0, p1; const float base = cq - mref;
            if (lane < 16) *(ALAS f32x4*)(bl + 4 * lane) = bcur;
            { f32x4 qa[4], qb[4];
#pragma unroll
              for (int jj = 0; jj < 4; ++jj) { qa[jj] = base - *(const ALAS f32x4*)(bl + 8 * jj + 4 * hi); qb[jj] = base - *(const ALAS f32x4*)(bl + 32 + 8 * jj + 4 * hi); }
              p0 = (f32x16){qa[0][0], qa[0][1], qa[0][2], qa[0][3], qa[1][0], qa[1][1], qa[1][2], qa[1][3], qa[2][0], qa[2][1], qa[2][2], qa[2][3], qa[3][0], qa[3][1], qa[3][2], qa[3][3]};
              p1 = (f32x16){qb[0][0], qb[0][1], qb[0][2], qb[0][3], qb[1][0], qb[1][1], qb[1][2], qb[1][3], qb[2][0], qb[2][1], qb[2][2], qb[2][3], qb[3][0], qb[3][1], qb[3][2], qb[3][3]}; }
#pragma unroll
            for (int d0 = 0; d0 < 4; ++d0) { const bf16x8 k0 = *(const ALAS bf16x8*)(ks + d0 * 2048), k1 = *(const ALAS bf16x8*)(ks + d0 * 2048 + 512);
                p0 = __builtin_amdgcn_mfma_f32_32x32x16_bf16(k0, qr[d0], p0, 0, 0, 0); p1 = __builtin_amdgcn_mfma_f32_32x32x16_bf16(k1, qr[d0], p1, 0, 0, 0); }
            if (j == jd) { const int qp = qpos0 + r32, s0 = 64 * j;
#pragma unroll
                for (int r = 0; r < 16; ++r) { const int kv = s0 + crow(r, hi); if (kv > qp) p0[r] = -INFINITY; if (kv + 32 > qp) p1[r] = -INFINITY; } }
            float rm;
            { float a = fmaxf(p0[0], p1[0]);
#pragma unroll
              for (int r = 1; r < 16; ++r) a = fmaxf(a, fmaxf(p0[r], p1[r]));
              rm = fmaxf(a, __shfl_xor(a, 32)); }
            if (j == jd) {
                mref = rm;
#pragma unroll
                for (int r = 0; r < 16; ++r) { p0[r] -= rm; p1[r] -= rm; }
            } else if (__any(rm > 0.f)) {
                const float dl = fmaxf(rm, 0.f); mref += dl;
#pragma unroll
                for (int r = 0; r < 16; ++r) { p0[r] -= dl; p1[r] -= dl; }
                const float f = __builtin_amdgcn_exp2f(-dl); l *= f; if (hi == 0) wsf[r32] = f;
                asm volatile("s_waitcnt lgkmcnt(0)" ::: "memory");
#pragma unroll
                for (int d_ = 0; d_ < 2; ++d_)
#pragma unroll
                    for (int r = 0; r < 16; ++r) o[d_][r] *= wsf[crow(r, hi)];
            }
#pragma unroll
            for (int r = 0; r < 16; ++r) { p0[r] = __builtin_amdgcn_exp2f(p0[r]); p1[r] = __builtin_amdgcn_exp2f(p1[r]); }
            { const f32x16 ps = p0 + p1;
              const f32x4 s4 = ((f32x4){ps[0], ps[1], ps[2], ps[3]} + (f32x4){ps[4], ps[5], ps[6], ps[7]}) + ((f32x4){ps[8], ps[9], ps[10], ps[11]} + (f32x4){ps[12], ps[13], ps[14], ps[15]});
              l += (s4[0] + s4[1]) + (s4[2] + s4[3]); }
            u32x4 pw0, pw1, pw2, pw3;
            pw0 = (u32x4){cvtpk_s(p0[0], p0[1]), cvtpk_s(p0[2], p0[3]), cvtpk_s(p0[4], p0[5]), cvtpk_s(p0[6], p0[7])};
            pw1 = (u32x4){cvtpk_s(p0[8], p0[9]), cvtpk_s(p0[10], p0[11]), cvtpk_s(p0[12], p0[13]), cvtpk_s(p0[14], p0[15])};
            pw2 = (u32x4){cvtpk_s(p1[0], p1[1]), cvtpk_s(p1[2], p1[3]), cvtpk_s(p1[4], p1[5]), cvtpk_s(p1[6], p1[7])};
            pw3 = (u32x4){cvtpk_s(p1[8], p1[9]), cvtpk_s(p1[10], p1[11]), cvtpk_s(p1[12], p1[13]), cvtpk_s(p1[14], p1[15])};
            pv(o, vpo + (j & 1) * 8192, __builtin_bit_cast(bf16x8, pw0), __builtin_bit_cast(bf16x8, pw1), __builtin_bit_cast(bf16x8, pw2), __builtin_bit_cast(bf16x8, pw3));
            if (j == 0) done = true;
            else { const float cl = __uint_as_float(__builtin_amdgcn_readlane(__float_as_uint(bpre[3]), 15));
                const float ub = qkb + (cq - cl) - mref; if (!__any(ub > ATT_EXIT_LOG2)) done = true; }
        }
        if (lane == 0) flags[(j & 1) * 8 + wave] = done ? 1u : 0u;
        asm volatile("s_waitcnt lgkmcnt(0)" ::: "memory");
    }
    if (active) {
        l += __shfl_xor(l, 32);
        if (hi == 0) wsf[32 + r32] = l;
        asm volatile("s_waitcnt lgkmcnt(0)" ::: "memory");
        float rli[16];
#pragma unroll
        for (int r = 0; r < 16; ++r) rli[r] = 1.0f / wsf[32 + crow(r, hi)];
#pragma unroll
        for (int r = 0; r < 16; ++r) { const int orow = crow(r, hi);
#pragma unroll
            for (int d0 = 0; d0 < 2; ++d0) { const unsigned w = cvtpk_s(o[d0][r] * rli[r], 0.f); stg[orow * 64 + d0 * 32 + r32] = (bf16)(w & 0xffffu); } }
        asm volatile("s_waitcnt lgkmcnt(0)" ::: "memory");
        bf16* Op = Ob + (size_t)(32 * wave) * 1024;
#pragma unroll
        for (int i = 0; i < 4; ++i) { const int row = i * 8 + (lane >> 3), ch = lane & 7; const u32x4 v = *(const ALAS u32x4*)(stg + row * 64 + ch * 8); *(u32x4*)(Op + (size_t)row * 1024 + ch * 8) = v; }
        asm volatile("s_waitcnt lgkmcnt(0)" ::: "memory");
    }
#undef WG_DMA
}
#undef ATT_LOADK
#undef ATT_LOADV
}

constexpr int NWAVES = 8;
constexpr int DM = 1024, FF = 2816, NH = 16;
constexpr int MP = 16384, MS = 512, M = MP + MS;
constexpr int TP = 8192, TS = 64, PAST = 2048, TKS = PAST + TS;
constexpr float C2 = 0.125f * 1.4426950408889634f;
constexpr float LOG2E = 1.4426950408889634f;
#ifndef MK_N_LAUNCHES
#define MK_N_LAUNCHES 1
#endif
constexpr int NPHASE = 15;
#ifndef PROBE_P0_REPS
#define PROBE_P0_REPS 1
#endif
#ifndef PROBE_P3_REPS
#define PROBE_P3_REPS 1
#endif
#ifndef PROBE_P1_REPS
#define PROBE_P1_REPS 1
#endif
#ifndef PROBE_P2_REPS
#define PROBE_P2_REPS 1
#endif
#ifndef PROBE_P9_REPS
#define PROBE_P9_REPS 1
#endif
#ifndef PROBE_P7_REPS
#define PROBE_P7_REPS 1
#endif
#ifndef USE_XCD_BAR
#define USE_XCD_BAR 1
#endif
#ifndef RUNTIME_DELAY
#define RUNTIME_DELAY 0
#endif
#ifndef RUNTIME_USE_CG
#define RUNTIME_USE_CG 0
#endif
#ifndef PROBE_ATT_REPS
#define PROBE_ATT_REPS 1
#endif
constexpr size_t OFF_Y = 0, OFF_POOLP = 17301504, OFF_POOLS = 17332224, OFF_LFP = 51009536, OFF_LFS = 52320256, OUT_TOTAL = 52328448;
constexpr size_t MiB = 1u << 20;
constexpr size_t WS_BAR = 65536, WS_CNT = 131072;
constexpr size_t WS_KMX = 0, WS_SS = 1 * MiB, WS_CKLP = 3 * MiB, WS_CKLS = 4 * MiB, WS_WFG = 6 * MiB, WS_WPOOL = 7 * MiB;
constexpr size_t WS_WKVIN = 8 * MiB  , WS_WIN00 = 23 * MiB, WS_WIN01 = 34 * MiB, WS_WIN11 = 45 * MiB, WS_WOUT = 56 * MiB  ;
constexpr size_t WOUT_BYTES = (size_t)DM * FF * 2;
constexpr size_t WS_WQ = 78 * MiB, WS_WO = 80 * MiB, WS_XB = 82 * MiB, WS_ACT = 115 * MiB, WS_QO = WS_ACT, WS_DP = WS_ACT + 33 * MiB;
constexpr size_t WS_KB = 206 * MiB, WS_VB = 238 * MiB, WS_KS = 270 * MiB, WS_VS = 303 * MiB, WS_END = 336 * MiB;
static_assert(WS_WOUT + 4 * WOUT_BYTES <= WS_WQ && WS_XB + (size_t)M * DM * 2 <= WS_ACT && WS_ACT + (size_t)M * FF * 2 <= WS_KB && WS_DP + (size_t)M * DM * 2 <= WS_KB, "ws map");
static_assert(WS_KS + (size_t)8 * TKS * DM * 2 <= WS_VS && WS_VS + (size_t)8 * TKS * DM * 2 <= WS_END && WS_CKLS + (size_t)8 * 16 * TKS * 4 <= WS_WFG, "ws map 2");
constexpr int RING_BYTES = 131072, LDS_BYTES = 147456;

#define LAS __attribute__((address_space(3)))
typedef unsigned short bf16;
typedef unsigned v4u __attribute__((ext_vector_type(4)));
typedef unsigned v2u __attribute__((ext_vector_type(2)));
typedef float f32x4 __attribute__((ext_vector_type(4)));
typedef float f32x2 __attribute__((ext_vector_type(2)));
typedef short bf16x8 __attribute__((ext_vector_type(8)));
#define LDS_WAIT() asm volatile("s_waitcnt lgkmcnt(0)" ::: "memory")
__device__ __forceinline__ unsigned pk2(float lo, float hi) { return pg8::cvt_pk_bf16(lo, hi); }
__device__ __forceinline__ float wave_sum(float v) {
#pragma unroll
    for (int o = 1; o < 64; o <<= 1) v += __shfl_xor(v, o);
    return v;
}
__device__ __forceinline__ void tr_item(const float* W, int K, int N, bf16* WT, int k0, int n0, int drow0, const float* gain, int lane) {
    const int kg = lane >> 3, nl = lane & 7;
    const float* src = W + (size_t)(k0 + 8 * kg) * N + n0 + 4 * nl;
    f32x4 v[8];
#pragma unroll
    for (int i = 0; i < 8; ++i) v[i] = __builtin_nontemporal_load((const f32x4*)(src + (size_t)i * N));
    if (gain) { const f32x4 g0 = *(const f32x4*)(gain + k0 + 8 * kg), g1 = *(const f32x4*)(gain + k0 + 8 * kg + 4);
#pragma unroll
        for (int i = 0; i < 4; ++i) { v[i] = v[i] * g0[i]; v[4 + i] = v[4 + i] * g1[i]; } }
#pragma unroll
    for (int e = 0; e < 4; ++e) { v4u o; o.x = pk2(v[0][e], v[1][e]); o.y = pk2(v[2][e], v[3][e]); o.z = pk2(v[4][e], v[5][e]); o.w = pk2(v[6][e], v[7][e]);
        *(v4u*)(WT + (size_t)(drow0 + 4 * nl + e) * K + k0 + 8 * kg) = o; }
}
template <int W> __device__ __forceinline__ void pool_emit(const float (&u)[31][2], int posbase, int t0, bf16* dst  ) {
#pragma unroll
    for (int i = 0; i < 16; ++i) {
        float s0 = 0.f, s1 = 0.f;
#pragma unroll
        for (int j = W - 1; j >= 0; --j) { s0 += u[15 + i - j][0]; s1 += u[15 + i - j][1]; }
        const int pos = posbase + t0 + i; const float cnt = (float)(pos + 1 < W ? pos + 1 : W);
        const float d0 = s0 / cnt - u[15 + i][0], d1 = s1 / cnt - u[15 + i][1];
        *(unsigned*)(dst + (size_t)i * 256) = pk2(d0, d1);
    }
}

#define XB_TMO      128
#define XB_XCNT(j)  (256  + 64 * (j))
#define XB_XSUB(j)  (1280 + 64 * (j))
#define XB_XGEN(j)  (2304 + 64 * (j))
#define XB_TOP      3328
#define XB_TOPGEN   3392
#define XCD_BAR_WORDS 3456
#define XB_SPIN_CAP (1u << 18)

__device__ __forceinline__ unsigned xb_ld(unsigned* p)              { return __hip_atomic_load(p, __ATOMIC_RELAXED, __HIP_MEMORY_SCOPE_AGENT); }
__device__ __forceinline__ unsigned xb_add(unsigned* p, unsigned v) { return __hip_atomic_fetch_add(p, v, __ATOMIC_RELAXED, __HIP_MEMORY_SCOPE_AGENT); }
__device__ __forceinline__ unsigned xb_xcc_id() { return (unsigned)__builtin_amdgcn_s_getreg((3 << 11) | 20) & 0xFu; }
#define XB_SPIN(cond, bar) do { unsigned _sp = 0; while (cond) { __builtin_amdgcn_s_sleep(1); \
    if ((++_sp & 255u) == 0u) { if (xb_ld(&(bar)[XB_TMO])) break; if (_sp > XB_SPIN_CAP) { atomicAdd(&(bar)[XB_TMO], 1u); break; } } } } while (0)

struct XcdBarrier {
    unsigned* bar; unsigned x;
    volatile LAS unsigned* st;
};

__device__ __forceinline__ XcdBarrier xcd_barrier_post(unsigned* bar, volatile LAS unsigned* st) {
    XcdBarrier b; b.bar = bar; b.x = xb_xcc_id(); b.st = st;
    if (threadIdx.x == 0) (void)xb_add(&bar[XB_XCNT(b.x)], 1u);
    return b;
}
__device__ __forceinline__ void xcd_barrier_complete(unsigned* bar, unsigned x, unsigned& nloc, unsigned& nx) {
    const unsigned G = gridDim.x * gridDim.y * gridDim.z;
    unsigned sum, cnt, mine, sp = 0u;
    for (;;) {
        sum = 0u; cnt = 0u; mine = 0u;
#pragma unroll
        for (unsigned j = 0; j < 16; ++j) { const unsigned c = xb_ld(&bar[XB_XCNT(j)]); sum += c; cnt += (c > 0u) ? 1u : 0u; mine = (j == x) ? c : mine; }
        if (sum == G) break;
        __builtin_amdgcn_s_sleep(1);
        if ((++sp & 255u) == 0u) { if (xb_ld(&bar[XB_TMO])) break; if (sp > XB_SPIN_CAP) { atomicAdd(&bar[XB_TMO], 1u); break; } }
    }
    nloc = mine > 0u ? mine : 1u; nx = cnt > 0u ? cnt : 1u;
}

__device__ __forceinline__ void xcd_barrier(const XcdBarrier& b) {
    asm volatile("s_waitcnt vmcnt(0)" ::: "memory");
    __syncthreads();
    if (threadIdx.x == 0) {
        unsigned* bar = b.bar;
        __builtin_amdgcn_s_waitcnt(0);
        unsigned nloc = b.st[0], nx = b.st[1];
        if (nloc == 0u) { xcd_barrier_complete(bar, b.x, nloc, nx); b.st[0] = nloc; b.st[1] = nx; }
        const unsigned old = xb_add(&bar[XB_XSUB(b.x)], 1u);
        const unsigned gen = old / nloc;
        if (old + 1u == (gen + 1u) * nloc) {
            __builtin_amdgcn_fence(__ATOMIC_RELEASE, "agent");
            asm volatile("s_waitcnt vmcnt(0)" ::: "memory");
            const unsigned og = xb_add(&bar[XB_TOP], 1u);
            const unsigned tg = og / nx;
            if (og + 1u == (tg + 1u) * nx) xb_add(&bar[XB_TOPGEN], 1u);
            else XB_SPIN(xb_ld(&bar[XB_TOPGEN]) == tg, bar);
            __builtin_amdgcn_fence(__ATOMIC_ACQUIRE, "agent");
            xb_add(&bar[XB_XGEN(b.x)], 1u);
            asm volatile("s_waitcnt vmcnt(0)" ::: "memory");
        } else {
            XB_SPIN(xb_ld(&bar[XB_XGEN(b.x)]) == gen, bar);
            __builtin_amdgcn_fence(__ATOMIC_ACQUIRE, "agent");
            asm volatile("s_waitcnt vmcnt(0)" ::: "memory");
        }
    }
    __syncthreads();
}
#define GB_SUB(g) (64 * (g))
#define GB_GEN(g) (512 + 64 * (g))
#define GB_TOP 1024
#define GB_TOPGEN 1088
__device__ __forceinline__ void grp_barrier(unsigned* gb, int delay) {
    asm volatile("s_waitcnt vmcnt(0)" ::: "memory");
    __syncthreads();
    if (threadIdx.x == 0) {
        __builtin_amdgcn_fence(__ATOMIC_RELEASE, "agent");
        asm volatile("s_waitcnt vmcnt(0)" ::: "memory");
        for (int d_ = 0; d_ < delay; ++d_) __builtin_amdgcn_s_sleep(16);
        const unsigned g = blockIdx.x & 7u, nloc = gridDim.x >> 3;
        const unsigned old = xb_add(&gb[GB_SUB(g)], 1u), gen = old / nloc;
        if (old + 1u == (gen + 1u) * nloc) {
            const unsigned og = xb_add(&gb[GB_TOP], 1u), tg = og >> 3;
            if (og + 1u == (tg + 1u) * 8u) xb_add(&gb[GB_TOPGEN], 1u);
            else { unsigned sp = 0; while (xb_ld(&gb[GB_TOPGEN]) == tg) { __builtin_amdgcn_s_sleep(1); if (++sp > (1u << 24)) break; } }
            xb_add(&gb[GB_GEN(g)], 1u);
        } else { unsigned sp = 0; while (xb_ld(&gb[GB_GEN(g)]) == gen) { __builtin_amdgcn_s_sleep(1); if (++sp > (1u << 24)) break; } }
        __builtin_amdgcn_fence(__ATOMIC_ACQUIRE, "agent");
        asm volatile("s_waitcnt vmcnt(0)" ::: "memory");
    }
    __syncthreads();
}
struct Args { const float* in[20]; float* out; unsigned char* ws; int ph_lo, ph_hi, use_cg, pad; };

__global__ void __launch_bounds__(NWAVES * 64, 2) mega_fwd(Args args) {
    extern __shared__ __attribute__((aligned(16))) unsigned char lds_raw[];
    cg::grid_group grid = cg::this_grid();
    LAS unsigned char* lds = (LAS unsigned char*)lds_raw;
    const int tid = threadIdx.x, lane = tid & 63, wave = __builtin_amdgcn_readfirstlane(tid >> 6);
    const int G = gridDim.x, bx = blockIdx.x;
    const int gw = bx * NWAVES + wave, NGW = G * NWAVES;
    unsigned char* ws = args.ws; float* dout = args.out;
    const float* x_prompt = args.in[0]; const float* x_sample = args.in[1]; const float* cache_pool = args.in[2];
    const float* cache_k = args.in[3]; const float* cache_v = args.in[4]; const float* cache_logf = args.in[5];
    const float* ln_ffn1 = args.in[6]; const float* ln_mix = args.in[7]; const float* ln_ffn2 = args.in[8];
    const float* w_ffn_in = args.in[9]; const float* w_ffn_out = args.in[10]; const float* w_pool = args.in[11]; const float* pool_scale = args.in[12];
    const float* ln_kv = args.in[13]; const float* w_kv = args.in[14]; const float* w_fgate = args.in[15]; const float* b_fgate = args.in[16];
    const float* w_q = args.in[17]; const float* w_o = args.in[18]; const float* ln_final = args.in[19];
    unsigned* KMX = (unsigned*)(ws + WS_KMX); float* SS = (float*)(ws + WS_SS); float* CKLP = (float*)(ws + WS_CKLP); float* CKLS = (float*)(ws + WS_CKLS);
    bf16* WFG = (bf16*)(ws + WS_WFG); bf16* WPOOL = (bf16*)(ws + WS_WPOOL); bf16* WKVIN = (bf16*)(ws + WS_WKVIN);
    bf16* WIN00 = (bf16*)(ws + WS_WIN00); bf16* WIN01 = (bf16*)(ws + WS_WIN01); bf16* WIN11 = (bf16*)(ws + WS_WIN11);
    bf16* WQ = (bf16*)(ws + WS_WQ); bf16* WO = (bf16*)(ws + WS_WO); bf16* XB = (bf16*)(ws + WS_XB); bf16* ACT = (bf16*)(ws + WS_ACT); bf16* QO = (bf16*)(ws + WS_QO); bf16* DP = (bf16*)(ws + WS_DP); bf16* OB = DP;
    bf16* KB = (bf16*)(ws + WS_KB); bf16* VB = (bf16*)(ws + WS_VB); bf16* KS = (bf16*)(ws + WS_KS); bf16* VS = (bf16*)(ws + WS_VS);
    float* X32 = dout + OFF_Y;
    const int lo = args.ph_lo, hi = args.ph_hi;
#define IN(k) (lo <= (k) && (k) < hi)
    volatile LAS unsigned* MISC = (volatile LAS unsigned*)(lds + LDS_BYTES - 256);
    LAS unsigned* LCNT = (LAS unsigned*)(lds + LDS_BYTES - 1024);
    if (tid < 32) MISC[tid] = 0u;
    if (tid == 32) *LCNT = 0u;
    __syncthreads();
    unsigned* barw = (unsigned*)(ws + WS_BAR); unsigned* CNT = (unsigned*)(ws + WS_CNT);
    XcdBarrier bar; bar.bar = barw; bar.x = 0; bar.st = nullptr;
#define SEAM(k) do { if (IN(k) && IN((k) + 1)) { if ((k) == lo) { grid.sync(); bar = xcd_barrier_post(barw, MISC + 8); } else xcd_barrier(bar); } } while (0)
#define GEMM_PHASE(EPI, E, Aptr, Bptr, Kdim, LDA, PNSTEP, NCOLS) do { pg8::Gemm g_{(const pg8::bf16_t*)(Aptr), (const pg8::bf16_t*)(Bptr), (Kdim), (LDA), (size_t)(PNSTEP)}; \
        pg8::StaticOrder S_; S_.init(M, (NCOLS), G, bx); pg8::gemm_phase<EPI, pg8::StaticOrder, true, true>(lds, g_, S_, E); } while (0)

#define RIDE_PHASE(EPI, E, Bptr, NTILES, SLOT, WOUTP, BASE_LO, BASE_HI, OUT32) do {   \
        { pg8::Gemm g_{(const pg8::bf16_t*)XB, (const pg8::bf16_t*)(Bptr), DM, DM, (size_t)0}; pg8::RideOrder S_; S_.init((NTILES), bx); pg8::gemm_phase<EPI, pg8::RideOrder, true, true>(lds, g_, S_, E); } \
        if (bx >= 248) { const int s_ = bx - 248, pan_ = s_ >> 2; unsigned* cw_ = CNT + 128 * (SLOT) + 64 * pan_; \
            if (tid == 0) { unsigned sp_ = 0; while (__hip_atomic_load(cw_, __ATOMIC_RELAXED, __HIP_MEMORY_SCOPE_AGENT) < (unsigned)(NTILES) * 8u) { __builtin_amdgcn_s_sleep(2); if (++sp_ > (1u << 22)) break; } } \
            __syncthreads(); __builtin_amdgcn_fence(__ATOMIC_ACQUIRE, "agent"); asm volatile("s_waitcnt vmcnt(0)" ::: "memory"); \
            pg8::Gemm g2_{(const pg8::bf16_t*)ACT, (const pg8::bf16_t*)(WOUTP), FF, FF, (size_t)0}; pg8::OneUnit S2_{64 + pan_, s_ & 3}; \
            pg8::EpiRes E2_{(BASE_LO), (BASE_HI), (OUT32), XB, SS, nullptr, 0.5f}; pg8::gemm_phase<pg8::EpiRes, pg8::OneUnit, true, true>(lds, g2_, S2_, E2_); } } while (0)
#define GEMM_PROMPT(EPI, E, Aptr, Bptr, Kdim, LDA, NCOLS) do { pg8::Gemm g_{(const pg8::bf16_t*)(Aptr), (const pg8::bf16_t*)(Bptr), (Kdim), (LDA), (size_t)0}; \
        pg8::StaticOrder S_; S_.init(MP, (NCOLS), G, bx); pg8::gemm_phase<EPI, pg8::StaticOrder, true, true>(lds, g_, S_, E); } while (0)

#define FGATE_ROWS(IT0, IT1, W0, NW) do { \
        const int fr = lane & 15, fq = lane >> 4; \
        for (int it = (IT0) + (W0); it < (IT1); it += (NW)) { \
            const int row = it * 16 + fr; f32x4 acc = {0.f, 0.f, 0.f, 0.f}; \
            const bf16* ap = XB + (size_t)row * DM + 8 * fq; const bf16* bp = WFG + (size_t)fr * DM + 8 * fq; \
_Pragma("unroll 16") \
            for (int ks = 0; ks < 32; ++ks) { const bf16x8 av = *(const bf16x8*)(ap + 32 * ks), bv = *(const bf16x8*)(bp + 32 * ks); acc = __builtin_amdgcn_mfma_f32_16x16x32_bf16(bv, av, acc, 0, 0, 0); } \
            const float rs = pg8::row_rstd(SS, row); const f32x4 bb = *(const f32x4*)(b_fgate + 4 * fq); f32x4 lf; \
_Pragma("unroll") \
            for (int e = 0; e < 4; ++e) { const float z = acc[e] * rs + bb[e]; lf[e] = fminf(z, 0.f) - 0.6931471805599453f * __builtin_amdgcn_logf(1.0f + __builtin_amdgcn_exp2f(-1.4426950408889634f * fabsf(z))); }   \
            float* dp = (row < MP) ? dout + OFF_LFP + (size_t)row * 16 : dout + OFF_LFS + (size_t)(row - MP) * 16; \
            *(f32x4*)(dp + 4 * fq) = lf; \
        } \
    } while (0)

    if (IN(0)) for (int rep0 = 0; rep0 < PROBE_P0_REPS; ++rep0) {
        constexpr int I_IN = 16 * 176, I_OUT = 44 * 32, I_KV = 16 * 64, I_Q = 16 * 32, I_P = 4 * 8;
        constexpr int NITEMS = 4 * I_IN + 4 * I_OUT + I_KV + 2 * I_Q + 4 * I_P;
        for (int it = gw; it < NITEMS; it += NGW) {
            int r = it;
            if (r < 4 * I_IN) { const int f = r / I_IN; r -= f * I_IN; const int kb = r / 176, nb = r % 176, n0 = 32 * nb;
                const int drow = (n0 < FF) ? (n0 >> 7) * 256 + (n0 & 127) : ((n0 - FF) >> 7) * 256 + 128 + ((n0 - FF) & 127);
                bf16* dst = (f == 0) ? WIN00 : (f == 1) ? WIN01 : (f == 2) ? WKVIN + (size_t)2048 * DM : WIN11;
                const float* gain = ((f & 1) ? ln_ffn2 : ln_ffn1) + (f >> 1) * DM;
                tr_item(w_ffn_in + (size_t)f * DM * 2 * FF, DM, 2 * FF, dst, 64 * kb, n0, drow, gain, lane); continue; }
            r -= 4 * I_IN;
            if (r < 4 * I_OUT) { const int f = r / I_OUT; r -= f * I_OUT; const int kb = r / 32, nb = r % 32;
                tr_item(w_ffn_out + (size_t)f * FF * DM, FF, DM, (bf16*)(ws + WS_WOUT + f * WOUT_BYTES), 64 * kb, 32 * nb, 32 * nb, nullptr, lane); continue; }
            r -= 4 * I_OUT;
            if (r < I_KV) { const int kb = r / 64, nb = r % 64; tr_item(w_kv, DM, 2048, WKVIN, 64 * kb, 32 * nb, 32 * nb, ln_kv, lane); continue; }
            r -= I_KV;
            if (r < I_Q) { const int kb = r / 32, nb = r % 32; tr_item(w_q, DM, DM, WQ, 64 * kb, 32 * nb, 32 * nb, ln_mix + DM, lane); continue; }
            r -= I_Q;
            if (r < I_Q) { const int kb = r / 32, nb = r % 32; tr_item(w_o, DM, DM, WO, 64 * kb, 32 * nb, 32 * nb, nullptr, lane); continue; }
            r -= I_Q;
            { const int gq = r / I_P; r -= gq * I_P; const int kb = r / 8, nb = r % 8; tr_item(w_pool + (size_t)gq * 65536, 256, 256, WPOOL, 64 * kb, 32 * nb, gq * 256 + 32 * nb, nullptr, lane); }
        }
        for (int i = bx * 512 + tid; i < 16 * DM; i += G * 512) { const int n = i >> 10, k = i & 1023; WFG[i] = (bf16)(pk2(w_fgate[k * 16 + n] * ln_kv[k], 0.f) & 0xffffu); }
        if (bx == 0) { if (tid < 320) KMX[tid] = 0u; for (int i = tid; i < XCD_BAR_WORDS; i += 512) barw[i] = 0u; CNT[tid] = 0u; }
        for (int m0 = gw; m0 < M; m0 += 2 * NGW) {
            const int m1 = (m0 + NGW < M) ? m0 + NGW : m0;
            const float* xr0 = (m0 < MP) ? x_prompt + (size_t)m0 * DM : x_sample + (size_t)(m0 - MP) * DM;
            const float* xr1 = (m1 < MP) ? x_prompt + (size_t)m1 * DM : x_sample + (size_t)(m1 - MP) * DM;
            const f32x4* xv0 = (const f32x4*)xr0 + lane; const f32x4* xv1 = (const f32x4*)xr1 + lane; f32x4 v0[4], v1[4]; float s0 = 0.f, s1 = 0.f;
#pragma unroll
            for (int j = 0; j < 4; ++j) { v0[j] = __builtin_nontemporal_load(xv0 + 64 * j); v1[j] = __builtin_nontemporal_load(xv1 + 64 * j); }
#pragma unroll
            for (int j = 0; j < 4; ++j) { s0 += (v0[j].x * v0[j].x + v0[j].y * v0[j].y) + (v0[j].z * v0[j].z + v0[j].w * v0[j].w); s1 += (v1[j].x * v1[j].x + v1[j].y * v1[j].y) + (v1[j].z * v1[j].z + v1[j].w * v1[j].w); }
            s0 = wave_sum(s0); s1 = wave_sum(s1);
            v2u* o0 = (v2u*)(XB + (size_t)m0 * DM) + lane; v2u* o1 = (v2u*)(XB + (size_t)m1 * DM) + lane;
#pragma unroll
            for (int j = 0; j < 4; ++j) { v2u w; w.x = pk2(v0[j].x, v0[j].y); w.y = pk2(v0[j].z, v0[j].w); o0[64 * j] = w; w.x = pk2(v1[j].x, v1[j].y); w.y = pk2(v1[j].z, v1[j].w); o1[64 * j] = w; }
            if (lane < 16) { SS[(size_t)m0 * 16 + lane] = (lane == 0) ? s0 : 0.f; SS[(size_t)m1 * 16 + lane] = (lane == 0) ? s1 : 0.f; }
        }
    }
    SEAM(0);
    if (IN(1) && PROBE_P1_REPS > 1) { pg8::EpiSwiglu E{ACT, SS, 0, nullptr, LCNT}; GEMM_PROMPT(pg8::EpiSwiglu, E, XB, WIN00, DM, DM, 2 * FF); }
    if (IN(1)) { pg8::EpiSwiglu E{ACT, SS, 0, CNT + 128 * 0, LCNT}; RIDE_PHASE(pg8::EpiSwiglu, E, WIN00, 22, 0, ws + WS_WOUT, x_prompt, x_sample, (float*)nullptr); }
    SEAM(1);
    if (IN(2) && PROBE_P2_REPS > 1) { pg8::EpiRes E{x_prompt, x_sample, nullptr, XB, SS, nullptr, 0.5f}; GEMM_PROMPT(pg8::EpiRes, E, ACT, ws + WS_WOUT, FF, FF, DM); }
    if (IN(2)) { pg8::EpiRes E{x_prompt, x_sample, nullptr, XB, SS, nullptr, 0.5f}; GEMM_PROMPT(pg8::EpiRes, E, ACT, ws + WS_WOUT, FF, FF, DM); }
    SEAM(2);
    if (IN(3)) for (int rep3 = 0; rep3 < PROBE_P3_REPS; ++rep3) {
        LAS float* rsl = (LAS float*)lds;
        for (int item = bx; item < 1024 + 32; item += G) {
            int sb, ch; if (item < 1024) { sb = item >> 9; ch = item & 511; } else { const int r = item - 1024; sb = 2 + (r >> 2); ch = r & 3; }
            const bool prompt = sb < 2; const int T = prompt ? TP : TS, t0 = ch * 16, grow0 = prompt ? sb * TP : MP + (sb - 2) * TS;
            if (tid < 31) { const int t = t0 - 15 + tid; rsl[tid] = (t >= 0) ? pg8::row_rstd(SS, grow0 + t) : 0.f; }
            __syncthreads();
            const int c = 2 * tid; const float g0 = ln_mix[c], g1 = ln_mix[c + 1];
            float u[31][2];
#pragma unroll
            for (int i = 0; i < 31; ++i) { const int t = t0 - 15 + i;
                if (t >= 0) { const unsigned xw = *(const unsigned*)(XB + (size_t)(grow0 + t) * DM + c); const float rs = rsl[i]; u[i][0] = __uint_as_float(xw << 16) * rs * g0; u[i][1] = __uint_as_float(xw & 0xffff0000u) * rs * g1; }
                else if (!prompt) { const f32x2 hv = *(const f32x2*)(cache_pool + (size_t)((sb - 2) * 15 + 15 + t) * DM + c); u[i][0] = hv.x; u[i][1] = hv.y; }
                else { u[i][0] = 0.f; u[i][1] = 0.f; } }
            const int gq = c >> 8, posbase = prompt ? 0 : PAST;
            bf16* dst = DP + (size_t)gq * M * 256 + (size_t)(grow0 + t0) * 256 + (c & 255);
            if (gq == 0) pool_emit<2>(u, posbase, t0, dst); else if (gq == 1) pool_emit<4>(u, posbase, t0, dst); else if (gq == 2) pool_emit<8>(u, posbase, t0, dst); else pool_emit<16>(u, posbase, t0, dst);
            float* pout = dout + (prompt ? OFF_POOLP + (size_t)sb * 15 * DM : OFF_POOLS + (size_t)(sb - 2) * 15 * DM);
#pragma unroll
            for (int i = 0; i < 16; ++i) { const int t = t0 + i; if (t >= T - 15) { f32x2 o; o.x = u[15 + i][0]; o.y = u[15 + i][1]; *(f32x2*)(pout + (size_t)(t - (T - 15)) * DM + c) = o; } }
            __syncthreads();
        }
    }
    SEAM(3);
    if (IN(4)) { pg8::EpiRes E{nullptr, nullptr, nullptr, XB, SS, pool_scale, 1.0f}; GEMM_PHASE(pg8::EpiRes, E, DP, WPOOL, 256, 256, (size_t)M * 256 * 2, DM); }
    SEAM(4);
    if (IN(5)) { pg8::EpiSwiglu E{ACT, SS, 0, CNT + 128 * 1, LCNT}; RIDE_PHASE(pg8::EpiSwiglu, E, WIN01, 22, 1, ws + WS_WOUT + WOUT_BYTES, (const float*)nullptr, (const float*)nullptr, (float*)nullptr); }
    SEAM(5);
    if (IN(6)) { pg8::EpiRes E{nullptr, nullptr, nullptr, XB, SS, nullptr, 0.5f}; GEMM_PROMPT(pg8::EpiRes, E, ACT, ws + WS_WOUT + WOUT_BYTES, FF, FF, DM);
        FGATE_ROWS(MP / 16, M / 16, gw, NGW); }
    SEAM(6);
    if (IN(7) && PROBE_P7_REPS > 1) { pg8::EpiKVSwiglu E{pg8::EpiKV{dout, KB, VB, KS, VS, SS, KMX, nullptr}, pg8::EpiSwiglu{ACT, SS, 8, nullptr, LCNT}}; GEMM_PROMPT(pg8::EpiKVSwiglu, E, XB, WKVIN, DM, DM, 2048 + 2 * FF); }
    if (IN(7)) {
        pg8::EpiKVSwiglu E{pg8::EpiKV{dout, KB, VB, KS, VS, SS, KMX, CNT + 128 * 2}, pg8::EpiSwiglu{ACT, SS, 8, CNT + 128 * 2, LCNT}};
        RIDE_PHASE(pg8::EpiKVSwiglu, E, WKVIN, 30, 2, ws + WS_WOUT + 2 * WOUT_BYTES, (const float*)nullptr, (const float*)nullptr, (float*)nullptr);
        FGATE_ROWS(0, MP / 16, gw, NGW);
    }
    SEAM(7);
    if (IN(8)) {
        pg8::EpiRes E{nullptr, nullptr, nullptr, XB, SS, nullptr, 0.5f}; GEMM_PROMPT(pg8::EpiRes, E, ACT, ws + WS_WOUT + 2 * WOUT_BYTES, FF, FF, DM);
    }
    SEAM(8);
    if (IN(9)) for (int rep9 = 0; rep9 < PROBE_P9_REPS; ++rep9) { { pg8::EpiQ E{QO, SS, C2}; GEMM_PHASE(pg8::EpiQ, E, XB, WQ, DM, DM, 0, DM); }
        if (bx >= 8 && bx < 246) {
            LAS float* red = (LAS float*)lds;
            for (int ch = bx - 8; ch < 512; ch += 238) {
                const int b = ch >> 6; float mx[4] = {0.f, 0.f, 0.f, 0.f};
                for (int i = 0; i < 4; ++i) {
                    const int r = ch * 32 + wave * 4 + i, s = r & 2047;
                    const f32x4* kx = (const f32x4*)(cache_k + (size_t)r * DM) + lane; const f32x4* vx = (const f32x4*)(cache_v + (size_t)r * DM) + lane;
                    f32x4 kv[4], vv[4];
#pragma unroll
                    for (int j = 0; j < 4; ++j) { kv[j] = __builtin_nontemporal_load(kx + 64 * j); vv[j] = __builtin_nontemporal_load(vx + 64 * j); }
                    v2u* ko = (v2u*)(KS + (size_t)(b * TKS + s) * DM) + lane; v2u* vo = (v2u*)(VS + (size_t)(b * TKS + s) * DM) + lane;
#pragma unroll
                    for (int j = 0; j < 4; ++j) { v2u w; w.x = pk2(kv[j].x, kv[j].y); w.y = pk2(kv[j].z, kv[j].w); ko[64 * j] = w; w.x = pk2(vv[j].x, vv[j].y); w.y = pk2(vv[j].z, vv[j].w); vo[64 * j] = w;
                        float n2 = (kv[j].x * kv[j].x + kv[j].y * kv[j].y) + (kv[j].z * kv[j].z + kv[j].w * kv[j].w); n2 += __shfl_xor(n2, 1); n2 += __shfl_xor(n2, 2); n2 += __shfl_xor(n2, 4);
                        mx[j] = fmaxf(mx[j], n2); }
                }
                if ((lane & 7) == 0) {
#pragma unroll
                    for (int j = 0; j < 4; ++j) red[(wave * 4 + j) * 8 + (lane >> 3)] = mx[j]; }
                __syncthreads();
                if (tid < 32) { float v = red[tid];
#pragma unroll
                    for (int w = 1; w < 8; ++w) v = fmaxf(v, red[w * 32 + tid]);
                    atomicMax(KMX + ((2 + b) * 16 + 4 * (tid >> 3) + ((tid & 7) >> 1)) * 2 + (tid & 1), __float_as_uint(v)); }
                __syncthreads();
            }
        }
        LAS f32x4* part4 = (LAS f32x4*)lds;
        for (int sb = G - 1 - bx; sb < 10; sb += G) {
            const bool prompt = sb < 2; const int b = prompt ? 0 : sb - 2, T = prompt ? TP : TKS, NCH = prompt ? 128 : 66, CH = prompt ? 64 : 32, c = tid >> 2, hq = tid & 3;
            const float* srcA = prompt ? dout + OFF_LFP + (size_t)sb * TP * 16 : cache_logf + (size_t)b * PAST * 16;
            const float* srcB = dout + OFF_LFS + (size_t)b * TS * 16 - (size_t)PAST * 16;
#define LF4_AT(t) (*(const f32x4*)((((prompt) || (t) < PAST) ? srcA : srcB) + (size_t)(t) * 16 + 4 * hq))
            f32x4 s = {0.f, 0.f, 0.f, 0.f};
            if (c < NCH) for (int t0 = c * CH; t0 < (c + 1) * CH; t0 += 16) { f32x4 v[16];
#pragma unroll
                for (int i = 0; i < 16; ++i) v[i] = LF4_AT(t0 + i);
#pragma unroll
                for (int i = 0; i < 16; ++i) s += v[i]; }
            part4[c * 4 + hq] = s; __syncthreads();
            if (c < NCH) {
                f32x4 run = {0.f, 0.f, 0.f, 0.f}; for (int cc = 0; cc < c; ++cc) run += part4[cc * 4 + hq];
                float* dst = (prompt ? CKLP + (size_t)(sb * 16 + 4 * hq) * TP : CKLS + (size_t)(b * 16 + 4 * hq) * TKS);
                for (int t0 = c * CH; t0 < (c + 1) * CH; t0 += 16) { f32x4 v[16];
#pragma unroll
                    for (int i = 0; i < 16; ++i) v[i] = LF4_AT(t0 + i);
#pragma unroll
                    for (int i = 0; i < 16; ++i) { run += v[i]; v[i] = run * LOG2E; }
#pragma unroll
                    for (int e = 0; e < 4; ++e)
#pragma unroll
                        for (int i = 0; i < 4; ++i) *(f32x4*)(dst + (size_t)e * T + t0 + 4 * i) = (f32x4){v[4 * i][e], v[4 * i + 1][e], v[4 * i + 2][e], v[4 * i + 3][e]}; }
            }
#undef LF4_AT
            __syncthreads();
        }
    }
    SEAM(9);
    if (IN(10)) {
        for (int rep = 0; rep < PROBE_ATT_REPS; ++rep)
        for (int gi = bx; gi < 1024 + 128; gi += G) {
            int qrow0, qbase, sb, h, nact; const bf16 *Kp, *Vp; const float* ckl;
            if (gi < 1024) { const int bh = gi >> 5, qb = gi & 31, b = bh >> 4; h = bh & 15; sb = b; qrow0 = b * TP + 256 * qb; qbase = 256 * qb; nact = 8;
                Kp = KB + (size_t)b * TP * DM + h * 64; Vp = VB + (size_t)b * TP * DM + h * 64; ckl = CKLP + (size_t)bh * TP; }
            else { const int bh = gi - 1024, b = bh >> 4; h = bh & 15; sb = 2 + b; qrow0 = MP + b * TS; qbase = PAST; nact = 2;
                Kp = KS + (size_t)b * TKS * DM + h * 64; Vp = VS + (size_t)b * TKS * DM + h * 64; ckl = CKLS + (size_t)bh * TKS; }
            const float kmaxn = __builtin_amdgcn_sqrtf(__uint_as_float(KMX[(sb * 16 + h) * 2]) + __uint_as_float(KMX[(sb * 16 + h) * 2 + 1]));
            att::wg_unit(QO + (size_t)qrow0 * DM + h * 64, OB + (size_t)qrow0 * DM + h * 64, Kp, Vp, ckl, qbase, nact, kmaxn, lds, wave, lane);
        }
        __syncthreads();
    }
    SEAM(10);
    if (IN(11)) { pg8::EpiRes E{nullptr, nullptr, nullptr, XB, SS, nullptr, 1.0f}; GEMM_PHASE(pg8::EpiRes, E, OB, WO, DM, DM, 0, DM); }
    SEAM(11);
    if (IN(12)) { pg8::EpiSwiglu E{ACT, SS, 0, CNT + 128 * 3, LCNT}; RIDE_PHASE(pg8::EpiSwiglu, E, WIN11, 22, 3, ws + WS_WOUT + 3 * WOUT_BYTES, (const float*)nullptr, (const float*)nullptr, (float*)nullptr); }
    SEAM(12);
    if (IN(13)) { pg8::EpiRes E{nullptr, nullptr, nullptr, XB, SS, nullptr, 0.5f}; GEMM_PROMPT(pg8::EpiRes, E, ACT, ws + WS_WOUT + 3 * WOUT_BYTES, FF, FF, DM); }
    SEAM(13);
    if (IN(14)) {
        for (int m0 = gw; m0 < M; m0 += 2 * NGW) {
            const int m1 = (m0 + NGW < M) ? m0 + NGW : m0;
            const v2u* xa = (const v2u*)(XB + (size_t)m0 * DM) + lane; const v2u* xb = (const v2u*)(XB + (size_t)m1 * DM) + lane; const f32x4* gv = (const f32x4*)ln_final + lane;
            v2u wa[4], wb[4];
#pragma unroll
            for (int j = 0; j < 4; ++j) { wa[j] = xa[64 * j]; wb[j] = xb[64 * j]; }
            const float ra = pg8::row_rstd(SS, m0), rb = pg8::row_rstd(SS, m1);
            f32x4* ya = (f32x4*)(X32 + (size_t)m0 * DM) + lane; f32x4* yb = (f32x4*)(X32 + (size_t)m1 * DM) + lane;
#pragma unroll
            for (int j = 0; j < 4; ++j) { const f32x4 g = gv[64 * j];
                __builtin_nontemporal_store((f32x4){__uint_as_float(wa[j].x << 16) * ra * g.x, __uint_as_float(wa[j].x & 0xffff0000u) * ra * g.y, __uint_as_float(wa[j].y << 16) * ra * g.z, __uint_as_float(wa[j].y & 0xffff0000u) * ra * g.w}, ya + 64 * j);
                __builtin_nontemporal_store((f32x4){__uint_as_float(wb[j].x << 16) * rb * g.x, __uint_as_float(wb[j].x & 0xffff0000u) * rb * g.y, __uint_as_float(wb[j].y << 16) * rb * g.z, __uint_as_float(wb[j].y & 0xffff0000u) * rb * g.w}, yb + 64 * j); }
        }
    }
#undef IN
#undef SEAM
#undef GEMM_PHASE
#undef GEMM_PROMPT
#undef RIDE_PHASE
#undef FGATE_ROWS
}

extern "C" void kernel_launch(void* const* d_in, const int* in_sizes, int n_in, void* d_out, int out_size, void* d_ws, size_t ws_size, hipStream_t stream) {
    static int grid = 0;
    if (grid == 0) {
        if (n_in != 20 || (size_t)out_size != OUT_TOTAL || ws_size < WS_END) { fprintf(stderr, "kernel_launch: unexpected shapes (n_in %d out %d ws %zu)\n", n_in, out_size, ws_size); grid = -1; return; }
        int dev = 0, cus = 0, per_cu = 0;
        if (hipGetDevice(&dev) != hipSuccess || hipDeviceGetAttribute(&cus, hipDeviceAttributeMultiprocessorCount, dev) != hipSuccess) { grid = -1; return; }
        if (hipFuncSetAttribute((const void*)mega_fwd, hipFuncAttributeMaxDynamicSharedMemorySize, LDS_BYTES) != hipSuccess) { fprintf(stderr, "kernel_launch: hipFuncSetAttribute failed\n"); grid = -1; return; }
        if (hipOccupancyMaxActiveBlocksPerMultiprocessor(&per_cu, (const void*)mega_fwd, NWAVES * 64, LDS_BYTES) != hipSuccess || per_cu < 1) { fprintf(stderr, "kernel_launch: occupancy query says %d\n", per_cu); (void)hipGetLastError(); grid = -1; return; }
        if (cus != 256) { fprintf(stderr, "kernel_launch: built for a 256-CU device (got %d)\n", cus); grid = -1; return; }
        grid = cus * 1;
    }
    if (grid < 0) return;
    Args a{};
    for (int i = 0; i < 20; ++i) a.in[i] = (const float*)d_in[i];
    a.out = (float*)d_out; a.ws = (unsigned char*)d_ws; a.use_cg = RUNTIME_USE_CG; a.pad = RUNTIME_DELAY;
#if MK_N_LAUNCHES == 1
    a.ph_lo = 0; a.ph_hi = NPHASE;
    void* kargs[] = {&a};
    hipError_t e = hipLaunchCooperativeKernel((const void*)mega_fwd, dim3(grid), dim3(NWAVES * 64), kargs, LDS_BYTES, stream);
    if (e != hipSuccess) fprintf(stderr, "cooperative launch failed: %s (grid %d)\n", hipGetErrorString(e), grid);
#else
    for (int p = 0; p < NPHASE; ++p) { a.ph_lo = p; a.ph_hi = p + 1; hipLaunchKernelGGL(mega_fwd, dim3(grid), dim3(NWAVES * 64), LDS_BYTES, stream, a); }
#endif
}
```

```cpp
#include <hip/hip_runtime.h>
#include <hip/hip_cooperative_groups.h>
#include <cstdio>
#include <cstdint>
#include <cmath>
namespace cg = cooperative_groups;
namespace pg8 {
#define PG8_LAS __attribute__((address_space(3)))
typedef unsigned short bf16_t;
typedef short bf16x8 __attribute__((ext_vector_type(8)));
typedef float f32x4 __attribute__((ext_vector_type(4)));
typedef unsigned u32x4 __attribute__((ext_vector_type(4)));
constexpr int BM = 256, BK = 64, HALF = 128, HTB = HALF * BK * 2  , STAGE_BYTES = 8 * HTB, NXCD = 8, WGM = 8;

__host__ __device__ __forceinline__ int lds_byte(int r, int c) { const int st = (r >> 4) * 2 + (c >> 5), rr = r & 15, cc = c & 31, ob = rr * 64 + cc * 2; return st * 1024 + (ob ^ (((ob >> 9) & 1) << 5)); }
__host__ __device__ __forceinline__ void stage_rc(int b, int& R, int& C) { const int st = b / 1024, sb = b % 1024, swz = sb ^ (((sb >> 9) & 1) << 5); R = (st >> 1) * 16 + swz / 64; C = (st & 1) * 32 + (swz % 64) / 2; }
__host__ __device__ __forceinline__ int perm32(int rho) { const int n = rho >> 4, i = rho & 15; return 8 * (i >> 2) + 4 * n + (i & 3); }

struct Unit { int pm, pn; };
struct Gemm { const bf16_t* A; const bf16_t* Bt; int K; int lda; size_t a_pn_step; };

struct StaticOrder {
    int nM, nN, nwg, G, c;
    __host__ __device__ void init(int M, int N, int G_, int c_) { nM = M / BM; nN = N / BM; nwg = nM * nN; G = G_; c = c_; }
    __host__ __device__ bool next(int i, Unit& u) const {
        const long L = (long)i * G + c; if (L >= nwg) return false;
        int wgid = (int)L; { const int q = nwg / NXCD, r = nwg % NXCD, xcd = wgid % NXCD, off = wgid / NXCD; wgid = (xcd < r ? xcd * (q + 1) : r * (q + 1) + (xcd - r) * q) + off; }
        const int nig = WGM * nN, gid = wgid / nig, fm = gid * WGM, gsz = (nM - fm) < WGM ? (nM - fm) : WGM;
        u.pm = fm + ((wgid % nig) % gsz); u.pn = (wgid % nig) / gsz; return true;
    }
    __device__ __forceinline__ void a_ready(const Unit&) const {}
    __device__ __forceinline__ void done(const Unit&) const {}
};

__device__ __forceinline__ void map_tile(long L, int nM, int nN, Unit& u) {
    const int nwg = nM * nN; int wgid = (int)L; { const int q = nwg / NXCD, r = nwg % NXCD, xcd = wgid % NXCD, off = wgid / NXCD; wgid = (xcd < r ? xcd * (q + 1) : r * (q + 1) + (xcd - r) * q) + off; }
    const int nig = WGM * nN, gid = wgid / nig, fm = gid * WGM, gsz = (nM - fm) < WGM ? (nM - fm) : WGM;
    u.pm = fm + ((wgid % nig) % gsz); u.pn = ((wgid % nig) / gsz + 4 * gid) % nN;
}
struct RideOrder {
    static constexpr int GIVE = 3;
    int nN, c, nP, sample_e, orphanL;
    __device__ __forceinline__ void init(int nN_, int c_) {
        nN = nN_; c = c_; const int nwgP = 64 * nN, nS = 2 * nN;
        nP = (nwgP - c + 255) / 256; sample_e = (c >= 128 && c < 128 + nS) ? c - 128 : -1; orphanL = -1;
        if (c >= 248) nP -= GIVE;
        else if (c >= 128 + nS && c < 128 + nS + 8 * GIVE) { const int o = c - 128 - nS, sc = 248 + o / GIVE; orphanL = ((nwgP - sc + 255) / 256 - 1 - o % GIVE) * 256 + sc; }
    }
    __device__ __forceinline__ bool next(int i, Unit& u) const {
        if (sample_e >= 0) { if (i == 0) { u.pm = 64 + (sample_e & 1); u.pn = sample_e >> 1; return true; } --i; }
        long L; if (i < nP) L = (long)i * 256 + c; else if (i == nP && orphanL >= 0) L = orphanL; else return false;
        map_tile(L, 64, nN, u); return true;
    }
    __device__ __forceinline__ void a_ready(const Unit&) const {}
    __device__ __forceinline__ void done(const Unit&) const {}
};
struct OneUnit {
    int pm, pn;
    __device__ __forceinline__ bool next(int i, Unit& u) const { if (i != 0 || pm < 0) return false; u.pm = pm; u.pn = pn; return true; }
    __device__ __forceinline__ void a_ready(const Unit&) const {}
    __device__ __forceinline__ void done(const Unit&) const {}
};

constexpr int ROWS_P = 16384;
constexpr int DM_ = 1024, FF_ = 2816;
constexpr size_t OFF_KP = 17455104, OFF_VP = 34232320, OFF_KS = 51271680, OFF_VS = 51795968;
__device__ __forceinline__ unsigned cvt_pk_bf16(float lo, float hi) { unsigned r; asm volatile("v_cvt_pk_bf16_f32 %0, %1, %2" : "=v"(r) : "v"(lo), "v"(hi)); return r; }
__device__ __forceinline__ u32x4 pack8(const f32x4 a, const f32x4 b) { u32x4 w; w.x = cvt_pk_bf16(a[0], a[1]); w.y = cvt_pk_bf16(a[2], a[3]); w.z = cvt_pk_bf16(b[0], b[1]); w.w = cvt_pk_bf16(b[2], b[3]); return w; }
__device__ __forceinline__ float row_rstd(const float* SS, int row) {
    const f32x4* p = (const f32x4*)(SS + (size_t)row * 16);
    const f32x4 a = p[0], b = p[1], c = p[2], d = p[3];
    const float s = (((a[0] + a[1]) + (a[2] + a[3])) + ((b[0] + b[1]) + (b[2] + b[3]))) + (((c[0] + c[1]) + (c[2] + c[3])) + ((d[0] + d[1]) + (d[2] + d[3])));
    return rsqrtf(s * (1.0f / 1024.0f) + 1e-6f);
}
__device__ __forceinline__ void rows_rstd(const float* SS, int row0, int fq, float (&rs)[2][4]) {
    f32x4 t[2][4];
#pragma unroll
    for (int ai = 0; ai < 2; ++ai)
#pragma unroll
        for (int m = 0; m < 4; ++m) t[ai][m] = *(const f32x4*)(SS + (size_t)(row0 + ai * HALF + m * 16) * 16 + 4 * fq);
#pragma unroll
    for (int ai = 0; ai < 2; ++ai)
#pragma unroll
        for (int m = 0; m < 4; ++m) { float s = (t[ai][m][0] + t[ai][m][1]) + (t[ai][m][2] + t[ai][m][3]); s += __shfl_xor(s, 16); s += __shfl_xor(s, 32); rs[ai][m] = rsqrtf(s * (1.0f / 1024.0f) + 1e-6f); }
}
__device__ __forceinline__ float silu_mul(float g, float u) { return g * __builtin_amdgcn_rcpf(1.0f + __builtin_amdgcn_exp2f(-1.4426950408889634f * g)) * u; }

struct EpiSwiglu {
    static constexpr bool PERM = true, AFTER_DRAIN = false;
    bf16_t* ACT; const float* SS; int pn0; unsigned* cnt; PG8_LAS unsigned* lcnt;
    __device__ __forceinline__ void operator()(const f32x4 (&acc)[2][2][4][2], const Unit& u, int wr, int wc, int fr, int fq) const {
        const int row0 = u.pm * BM + wr * 64 + fr, col0 = (u.pn - pn0) * 128 + wc * 32 + 8 * fq;
        float rsv[2][4]; rows_rstd(SS, row0, fq, rsv);
#pragma unroll
        for (int ai = 0; ai < 2; ++ai)
#pragma unroll
            for (int m = 0; m < 4; ++m) {
                const int row = row0 + ai * HALF + m * 16; const float rs = rsv[ai][m];
                const float k1 = -1.4426950408889634f * rs, k2 = rs * rs;
                f32x4 h[2];
#pragma unroll
                for (int n = 0; n < 2; ++n) { const f32x4 g = acc[ai][0][m][n], uu = acc[ai][1][m][n]; const f32x4 t = g * k1; f32x4 ex;
#pragma unroll
                    for (int e = 0; e < 4; ++e) ex[e] = __builtin_amdgcn_exp2f(t[e]);
                    const f32x4 d = ex + 1.0f; f32x4 r;
#pragma unroll
                    for (int e = 0; e < 4; ++e) r[e] = __builtin_amdgcn_rcpf(d[e]);
                    h[n] = ((g * uu) * k2) * r; }
                *(u32x4*)(ACT + (size_t)row * FF_ + col0) = pack8(h[0], h[1]);
            }
        if (cnt && u.pm >= 64) {
            asm volatile("s_waitcnt vmcnt(0)" ::: "memory");
            unsigned old = 0u;
            if ((fr | fq) == 0) old = __hip_atomic_fetch_add(lcnt, 1u, __ATOMIC_RELAXED, __HIP_MEMORY_SCOPE_WORKGROUP);
            old = (unsigned)__builtin_amdgcn_readfirstlane((int)old);
            if (old == 7u) {
                if ((fr | fq) == 0) __hip_atomic_store(lcnt, 0u, __ATOMIC_RELAXED, __HIP_MEMORY_SCOPE_WORKGROUP);
                __builtin_amdgcn_fence(__ATOMIC_RELEASE, "agent");
                if ((fr | fq) == 0) __hip_atomic_fetch_add(cnt + 64 * (u.pm - 64), 8u, __ATOMIC_RELAXED, __HIP_MEMORY_SCOPE_AGENT);
            }
        }
    }
};
struct EpiRes {
    static constexpr bool PERM = true, AFTER_DRAIN = false;
    const float* in_lo; const float* in_hi;
    float* out32; bf16_t* XB; float* SS; const float* colscale; float alpha;
    __device__ __forceinline__ void operator()(const f32x4 (&acc)[2][2][4][2], const Unit& u, int wr, int wc, int fr, int fq) const {
        const int row0 = u.pm * BM + wr * 64 + fr, colw = u.pn * BM + wc * 32 + 8 * fq;
        f32x4 sc[2][2];
#pragma unroll
        for (int bj = 0; bj < 2; ++bj)
#pragma unroll
            for (int n = 0; n < 2; ++n) sc[bj][n] = colscale ? *(const f32x4*)(colscale + colw + bj * HALF + 4 * n) : (f32x4){alpha, alpha, alpha, alpha};
#define EPIRES_ROW(B0, B1, M_, BJ_) do { const int row = row0 + ai * HALF + (M_) * 16, col = colw + (BJ_) * HALF; \
            const f32x4 o0 = (B0) + sc[BJ_][0] * acc[ai][BJ_][M_][0], o1 = (B1) + sc[BJ_][1] * acc[ai][BJ_][M_][1]; \
            if (out32) { float* op = out32 + (size_t)row * DM_ + col; *(f32x4*)op = o0; *(f32x4*)(op + 4) = o1; } \
            *(u32x4*)(XB + (size_t)row * DM_ + col) = pack8(o0, o1); \
            ssq[M_] += ((o0[0] * o0[0] + o0[1] * o0[1]) + (o0[2] * o0[2] + o0[3] * o0[3])) + ((o1[0] * o1[0] + o1[1] * o1[1]) + (o1[2] * o1[2] + o1[3] * o1[3])); } while (0)
#pragma unroll
        for (int ai = 0; ai < 2; ++ai) {
            float ssq[4] = {0.f, 0.f, 0.f, 0.f};
            if (in_lo) {
#pragma unroll
                for (int mh = 0; mh < 2; ++mh) { f32x4 bq[2][2][2];
#pragma unroll
                    for (int mm = 0; mm < 2; ++mm) { const int row = row0 + ai * HALF + (2 * mh + mm) * 16; const float* bp = (row < ROWS_P) ? in_lo + (size_t)row * DM_ : in_hi + (size_t)(row - ROWS_P) * DM_;
#pragma unroll
                        for (int bj = 0; bj < 2; ++bj) { bq[mm][bj][0] = *(const f32x4*)(bp + colw + bj * HALF); bq[mm][bj][1] = *(const f32x4*)(bp + colw + bj * HALF + 4); } }
#pragma unroll
                    for (int mm = 0; mm < 2; ++mm)
#pragma unroll
                        for (int bj = 0; bj < 2; ++bj) EPIRES_ROW(bq[mm][bj][0], bq[mm][bj][1], 2 * mh + mm, bj); }
            } else {
                u32x4 bw[4][2];
#pragma unroll
                for (int m = 0; m < 4; ++m)
#pragma unroll
                    for (int bj = 0; bj < 2; ++bj) bw[m][bj] = *(const u32x4*)(XB + (size_t)(row0 + ai * HALF + m * 16) * DM_ + colw + bj * HALF);
#pragma unroll
                for (int m = 0; m < 4; ++m)
#pragma unroll
                    for (int bj = 0; bj < 2; ++bj) { const u32x4 w = bw[m][bj];
                        const f32x4 b0 = (f32x4){__uint_as_float(w.x << 16), __uint_as_float(w.x & 0xffff0000u), __uint_as_float(w.y << 16), __uint_as_float(w.y & 0xffff0000u)};
                        const f32x4 b1 = (f32x4){__uint_as_float(w.z << 16), __uint_as_float(w.z & 0xffff0000u), __uint_as_float(w.w << 16), __uint_as_float(w.w & 0xffff0000u)};
                        EPIRES_ROW(b0, b1, m, bj); }
            }
#pragma unroll
            for (int m = 0; m < 4; ++m) { float s = ssq[m]; s += __shfl_xor(s, 16); s += __shfl_xor(s, 32);
                if (fq == 0) SS[(size_t)(row0 + ai * HALF + m * 16) * 16 + u.pn * 4 + wc] = s; }
        }
#undef EPIRES_ROW
    }
};
struct EpiKV {
    static constexpr bool PERM = true, AFTER_DRAIN = false;
    float* dout; bf16_t* KBp; bf16_t* VBp; bf16_t* KSp; bf16_t* VSp; const float* SS; unsigned* KMX; unsigned* cnt;
    __device__ __forceinline__ void operator()(const f32x4 (&acc)[2][2][4][2], const Unit& u, int wr, int wc, int fr, int fq) const {
        const bool isV = u.pn >= 4, samp = u.pm >= 64; const int ct = (u.pn & 3) * BM;
        const int row0 = u.pm * BM + wr * 64 + fr, colw = ct + wc * 32 + 8 * fq;
        float rsv[2][4]; rows_rstd(SS, row0, fq, rsv);
#pragma unroll
        for (int ai = 0; ai < 2; ++ai) {
            float mx[2] = {0.f, 0.f};
#pragma unroll
            for (int m = 0; m < 4; ++m) {
                const int row = row0 + ai * HALF + m * 16; const float rs = rsv[ai][m];
                float* fp; bf16_t* bp;
                if (!samp) { fp = dout + (isV ? OFF_VP : OFF_KP) + (size_t)row * DM_; bp = (isV ? VBp : KBp) + (size_t)row * DM_; }
                else { const int r2 = row - ROWS_P, b = r2 >> 6, t = r2 & 63; fp = dout + (isV ? OFF_VS : OFF_KS) + (size_t)r2 * DM_; bp = (isV ? VSp : KSp) + (size_t)(b * 2112 + 2048 + t) * DM_; }
#pragma unroll
                for (int bj = 0; bj < 2; ++bj) {
                    const int col = colw + bj * HALF;
                    const f32x4 v0 = acc[ai][bj][m][0] * rs, v1 = acc[ai][bj][m][1] * rs;
                    __builtin_nontemporal_store(v0, (f32x4*)(fp + col)); __builtin_nontemporal_store(v1, (f32x4*)(fp + col + 4));
                    *(u32x4*)(bp + col) = pack8(v0, v1);
                    if (!isV) {
                        float n2 = ((v0[0] * v0[0] + v0[1] * v0[1]) + (v0[2] * v0[2] + v0[3] * v0[3])) + ((v1[0] * v1[0] + v1[1] * v1[1]) + (v1[2] * v1[2] + v1[3] * v1[3]));
                        n2 += __shfl_xor(n2, 16); n2 += __shfl_xor(n2, 32);
                        mx[bj] = fmaxf(mx[bj], n2);
                    }
                }
            }
            if (!isV) {
#pragma unroll
                for (int bj = 0; bj < 2; ++bj) {
                    float v = mx[bj];
                    v = fmaxf(v, __shfl_xor(v, 1)); v = fmaxf(v, __shfl_xor(v, 2)); v = fmaxf(v, __shfl_xor(v, 4)); v = fmaxf(v, __shfl_xor(v, 8));
                    const int sb = samp ? 2 + (u.pm - 64) * 4 + 2 * ai + wr : (u.pm >> 5);
                    const int head = (ct + bj * HALF + wc * 32) >> 6, half = wc & 1;
                    if (fr == 0 && fq == 0) atomicMax(KMX + (sb * 16 + head) * 2 + half, __float_as_uint(v));
                }
            }
        }
        if (cnt && samp) {
            if ((fr | fq) == 0) __hip_atomic_fetch_add(cnt + 64 * (u.pm - 64), 1u, __ATOMIC_RELAXED, __HIP_MEMORY_SCOPE_AGENT);
        }
    }
};
struct EpiQ {
    static constexpr bool PERM = true, AFTER_DRAIN = false;
    bf16_t* Q; const float* SS; float c2;
    __device__ __forceinline__ void operator()(const f32x4 (&acc)[2][2][4][2], const Unit& u, int wr, int wc, int fr, int fq) const {
        const int row0 = u.pm * BM + wr * 64 + fr, colw = u.pn * BM + wc * 32 + 8 * fq;
        float rsv[2][4]; rows_rstd(SS, row0, fq, rsv);
#pragma unroll
        for (int ai = 0; ai < 2; ++ai)
#pragma unroll
            for (int m = 0; m < 4; ++m) {
                const int row = row0 + ai * HALF + m * 16; const float rs = rsv[ai][m] * c2;
#pragma unroll
                for (int bj = 0; bj < 2; ++bj) *(u32x4*)(Q + (size_t)row * DM_ + colw + bj * HALF) = pack8(acc[ai][bj][m][0] * rs, acc[ai][bj][m][1] * rs);
            }
    }
};
struct EpiKVSwiglu {
    static constexpr bool PERM = true, AFTER_DRAIN = false;
    EpiKV kv; EpiSwiglu sw;
    __device__ __forceinline__ void operator()(const f32x4 (&acc)[2][2][4][2], const Unit& u, int wr, int wc, int fr, int fq) const {
        if (u.pn < 8) kv(acc, u, wr, wc, fr, fq); else sw(acc, u, wr, wc, fr, fq);
    }
};
template <class Epi, class Sched, bool ALIGN_EPI = false, bool SP2 = false>
__device__ __forceinline__ void gemm_phase(PG8_LAS unsigned char* lds, const Gemm g, const Sched& S, const Epi& E) {
    const int tid = threadIdx.x, wid = __builtin_amdgcn_readfirstlane(tid >> 6), lane = tid & 63, wr = wid >> 2, wc = wid & 3, fr = lane & 15, fq = lane >> 4;
    const int K = g.K, nt = K / BK;
    unsigned voffA[2], voffB[2];
#pragma unroll
    for (int i = 0; i < 2; ++i) { int R, C; stage_rc(tid * 16 + i * 8192, R, C); const int Rb = Epi::PERM ? ((R & ~31) + perm32(R & 31)) : R;
        voffA[i] = (unsigned)(R * g.lda + C) * 2u; voffB[i] = (unsigned)(Rb * K + C) * 2u; }
    const size_t kstep = (size_t)(BK * 2);
    const size_t hstepA = (size_t)HALF * g.lda * 2, hstepB = (size_t)HALF * K * 2;
    const size_t tstepA = 2 * hstepA, tstepB = 2 * hstepB;
    const unsigned ldsw = (unsigned)wid * 1024u;
    const int aoff = lds_byte(wr * 64 + fr, fq * 8), boff = lds_byte(wc * 32 + fr, fq * 8);
#define PG8_SA(b, h) (((b) * 2 + (h)) * HTB)
#define PG8_SB(b, h) ((4 + (b) * 2 + (h)) * HTB)
#define PG8_STAGE(bufoff, gbase, voff) do { _Pragma("unroll") for (int _i = 0; _i < 2; ++_i) \
        __builtin_amdgcn_global_load_lds((const unsigned*)((const char*)(gbase) + (voff)[_i]), (PG8_LAS unsigned*)(lds + (bufoff) + ldsw + _i * 8192), 16, 0, 0); } while (0)
#define PG8_LDA(dst, b, h) do { _Pragma("unroll") for (int m = 0; m < 4; ++m) _Pragma("unroll") for (int k = 0; k < 2; ++k) dst[m][k] = *(const PG8_LAS bf16x8*)(lds + PG8_SA(b, h) + aoff + m * 2048 + k * 1024); } while (0)
#define PG8_LDB(dst, b, h) do { _Pragma("unroll") for (int n = 0; n < 2; ++n) _Pragma("unroll") for (int k = 0; k < 2; ++k) dst[n][k] = *(const PG8_LAS bf16x8*)(lds + PG8_SB(b, h) + boff + n * 2048 + k * 1024); } while (0)
#define PG8_MMA(ai, bj, At, Bt) do { __builtin_amdgcn_s_setprio(1); _Pragma("unroll") for (int m = 0; m < 4; ++m) _Pragma("unroll") for (int n = 0; n < 2; ++n) _Pragma("unroll") for (int k = 0; k < 2; ++k) \
        acc[ai][bj][m][n] = __builtin_amdgcn_mfma_f32_16x16x32_bf16(Bt[n][k], At[m][k], acc[ai][bj][m][n], 0, 0, 0); __builtin_amdgcn_s_setprio(0); } while (0)
#define PG8_WAIT_V(n) asm volatile("s_waitcnt vmcnt(" #n ")" ::: "memory")
#define PG8_WAIT_L(n) asm volatile("s_waitcnt lgkmcnt(" #n ")" ::: "memory")
#define PG8_BAR __builtin_amdgcn_s_barrier()
#define PG8_SCHED __builtin_amdgcn_sched_barrier(0)
    Unit cur, nxt; int ui = 0;
    if (!S.next(0, cur)) return;
    f32x4 acc[2][2][4][2];
#pragma unroll
    for (int a = 0; a < 2; ++a)
#pragma unroll
        for (int b = 0; b < 2; ++b)
#pragma unroll
            for (int m = 0; m < 4; ++m)
#pragma unroll
                for (int n = 0; n < 2; ++n) acc[a][b][m][n] = (f32x4){0.f, 0.f, 0.f, 0.f};
    bf16x8 At[4][2], B0[2][2], B1[2][2];
    const char* cA = (const char*)g.A + (size_t)cur.pm * tstepA + (size_t)cur.pn * g.a_pn_step; const char* cB = (const char*)g.Bt + (size_t)cur.pn * tstepB;
    S.a_ready(cur);
    if constexpr (SP2) {
        PG8_STAGE(PG8_SB(0, 0), cB, voffB); PG8_STAGE(PG8_SB(0, 1), cB + hstepB, voffB); PG8_STAGE(PG8_SA(0, 0), cA, voffA); PG8_STAGE(PG8_SA(0, 1), cA + hstepA, voffA);
        if (wr == 1) PG8_BAR;
        PG8_WAIT_V(2); PG8_BAR;
        PG8_STAGE(PG8_SB(1, 0), cB + kstep, voffB); PG8_STAGE(PG8_SA(1, 0), cA + kstep, voffA); PG8_STAGE(PG8_SB(1, 1), cB + hstepB + kstep, voffB);
        PG8_WAIT_V(6); PG8_BAR;
    } else {
        PG8_STAGE(PG8_SB(0, 0), cB, voffB); PG8_STAGE(PG8_SA(0, 0), cA, voffA); PG8_STAGE(PG8_SB(0, 1), cB + hstepB, voffB); PG8_STAGE(PG8_SA(0, 1), cA + hstepA, voffA);
        if (wr == 1) PG8_BAR;
        PG8_WAIT_V(4); PG8_BAR;
        PG8_STAGE(PG8_SB(1, 0), cB + kstep, voffB); PG8_STAGE(PG8_SA(1, 0), cA + kstep, voffA); PG8_STAGE(PG8_SB(1, 1), cB + hstepB + kstep, voffB);
        PG8_WAIT_V(6); PG8_BAR;
    }
    for (;;) {
        const bool has_next = S.next(ui + 1, nxt);
        const char* nA = has_next ? (const char*)g.A + (size_t)nxt.pm * tstepA + (size_t)nxt.pn * g.a_pn_step : cA; const char* nB = has_next ? (const char*)g.Bt + (size_t)nxt.pn * tstepB : cB;
        for (int t = 0; t < nt; t += 2) {
            const bool last = (t == nt - 2);
            const char* a1 = cA + (size_t)(t + 1) * kstep;
            const char* a2 = last ? nA : cA + (size_t)(t + 2) * kstep; const char* b2 = last ? nB : cB + (size_t)(t + 2) * kstep;
            const char* a3 = a2 + kstep; const char* b3 = b2 + kstep;
            if (last && has_next) S.a_ready(nxt);
            if constexpr (SP2) {
            PG8_LDB(B0, 0, 0); PG8_LDB(B1, 0, 1); PG8_SCHED; PG8_LDA(At, 0, 0); PG8_STAGE(PG8_SA(1, 1), a1 + hstepA, voffA);
            PG8_WAIT_V(8); PG8_WAIT_L(0); PG8_BAR; PG8_MMA(0, 0, At, B0); PG8_MMA(0, 1, At, B1); PG8_BAR; PG8_SCHED;
            PG8_LDA(At, 0, 1); PG8_STAGE(PG8_SB(0, 0), b2, voffB); PG8_STAGE(PG8_SB(0, 1), b2 + hstepB, voffB); PG8_STAGE(PG8_SA(0, 0), a2, voffA);
            PG8_WAIT_V(8); PG8_WAIT_L(0); PG8_BAR; PG8_MMA(1, 0, At, B0); PG8_MMA(1, 1, At, B1); PG8_BAR; PG8_SCHED;
            PG8_LDB(B0, 1, 0); PG8_LDB(B1, 1, 1); PG8_SCHED; PG8_LDA(At, 1, 0); PG8_STAGE(PG8_SA(0, 1), a2 + hstepA, voffA);
            PG8_WAIT_V(8); PG8_WAIT_L(0); PG8_BAR; PG8_MMA(0, 0, At, B0); PG8_MMA(0, 1, At, B1); PG8_BAR; PG8_SCHED;
            PG8_LDA(At, 1, 1); PG8_STAGE(PG8_SB(1, 0), b3, voffB); PG8_STAGE(PG8_SB(1, 1), b3 + hstepB, voffB); PG8_STAGE(PG8_SA(1, 0), a3, voffA);
            PG8_WAIT_V(8); PG8_WAIT_L(0); PG8_BAR; PG8_MMA(1, 0, At, B0); PG8_MMA(1, 1, At, B1); PG8_BAR; PG8_SCHED;
            } else {
            PG8_LDB(B0, 0, 0); PG8_SCHED; PG8_LDA(At, 0, 0); PG8_STAGE(PG8_SA(1, 1), a1 + hstepA, voffA);
            PG8_WAIT_L(8); PG8_BAR; PG8_WAIT_L(0); PG8_MMA(0, 0, At, B0); PG8_BAR; PG8_SCHED;
            PG8_LDB(B1, 0, 1); PG8_STAGE(PG8_SB(0, 0), b2, voffB);
            PG8_BAR; PG8_WAIT_L(0); PG8_MMA(0, 1, At, B1); PG8_BAR;
            PG8_LDA(At, 0, 1); PG8_STAGE(PG8_SA(0, 0), a2, voffA);
            PG8_BAR; PG8_WAIT_L(0); PG8_MMA(1, 0, At, B0); PG8_BAR; PG8_SCHED;
            PG8_STAGE(PG8_SB(0, 1), b2 + hstepB, voffB);
            PG8_WAIT_V(6); PG8_BAR; PG8_MMA(1, 1, At, B1); PG8_BAR;
            PG8_LDB(B0, 1, 0); PG8_SCHED; PG8_LDA(At, 1, 0); PG8_STAGE(PG8_SA(0, 1), a2 + hstepA, voffA);
            PG8_WAIT_L(8); PG8_BAR; PG8_WAIT_L(0); PG8_MMA(0, 0, At, B0); PG8_BAR; PG8_SCHED;
            PG8_LDB(B1, 1, 1); PG8_STAGE(PG8_SB(1, 0), b3, voffB);
            PG8_BAR; PG8_WAIT_L(0); PG8_MMA(0, 1, At, B1); PG8_BAR;
            PG8_LDA(At, 1, 1); PG8_STAGE(PG8_SA(1, 0), a3, voffA);
            PG8_BAR; PG8_WAIT_L(0); PG8_MMA(1, 0, At, B0); PG8_BAR; PG8_SCHED;
            PG8_STAGE(PG8_SB(1, 1), b3 + hstepB, voffB);
            PG8_WAIT_V(6); PG8_BAR; PG8_MMA(1, 1, At, B1); PG8_BAR;
            }
        }
        if constexpr (ALIGN_EPI) { if (wr == 0) PG8_BAR; }
        if constexpr (!Epi::AFTER_DRAIN) { E(acc, cur, wr, wc, fr, fq); S.done(cur); }
        if (!has_next) break;
#pragma unroll
        for (int a = 0; a < 2; ++a)
#pragma unroll
            for (int b = 0; b < 2; ++b)
#pragma unroll
                for (int m = 0; m < 4; ++m)
#pragma unroll
                    for (int n = 0; n < 2; ++n) acc[a][b][m][n] = (f32x4){0.f, 0.f, 0.f, 0.f};
        cur = nxt; cA = nA; cB = nB; ++ui;
        if constexpr (ALIGN_EPI) { if (wr == 1) PG8_BAR; }
    }
    PG8_WAIT_V(0);
    if constexpr (!ALIGN_EPI) { if (wr == 0) PG8_BAR; }
    PG8_BAR;
    if constexpr (Epi::AFTER_DRAIN) { E.fused(acc, cur, wr, wc, fr, fq, lds, wid, lane); S.done(cur); }
#undef PG8_SA
#undef PG8_SB
#undef PG8_STAGE
#undef PG8_LDA
#undef PG8_LDB
#undef PG8_MMA
#undef PG8_WAIT_V
#undef PG8_WAIT_L
#undef PG8_BAR
#undef PG8_SCHED
}}

namespace att {
#define ALAS __attribute__((address_space(3)))
using bf16 = unsigned short;
using bf16x8 = __attribute__((ext_vector_type(8))) short;
using s16x4 = __attribute__((ext_vector_type(4))) short;
using f32x16 = __attribute__((ext_vector_type(16))) float;
using f32x4 = __attribute__((ext_vector_type(4))) float;
using u32x4 = __attribute__((ext_vector_type(4))) unsigned;
typedef float f32x2_t __attribute__((ext_vector_type(2))); typedef __bf16 bf16x2_t __attribute__((ext_vector_type(2)));
#ifndef ATT_PREFETCH
#define ATT_PREFETCH 1
#endif
#ifndef ATT_EXIT_LOG2
#define ATT_EXIT_LOG2 -48.f
#endif
#ifndef ATT_EARLY_EXIT
#define ATT_EARLY_EXIT 1
#endif
constexpr int WLDS = 8192 + 4096 + 256 + 256;
__device__ __forceinline__ int crow(int r, int hi) { return (r & 3) + 8 * (r >> 2) + 4 * hi; }
__device__ __forceinline__ unsigned cvtpk_s(float lo, float hi) { f32x2_t v = {lo, hi}; bf16x2_t b = __builtin_convertvector(v, bf16x2_t); return __builtin_bit_cast(unsigned, b); }
__device__ __forceinline__ float bf2f(short s) { return __uint_as_float(((unsigned)(unsigned short)s) << 16); }
typedef short v4i16_t __attribute__((ext_vector_type(4)));
__device__ __forceinline__ s16x4 vtr(const ALAS unsigned char* p) { return __builtin_bit_cast(s16x4, __builtin_amdgcn_ds_read_tr16_b64_v4i16((ALAS v4i16_t*)p)); }
__device__ __forceinline__ void pv(f32x16* o, const ALAS unsigned char* vp, bf16x8 pa0, bf16x8 pa1, bf16x8 pa2, bf16x8 pa3) {
#pragma unroll
    for (int d0 = 0; d0 < 2; ++d0) { s16x4 lo[4], hi[4];
#pragma unroll
        for (int ks = 0; ks < 4; ++ks) { lo[ks] = vtr(vp + d0 * 4096 + ks * 1024); hi[ks] = vtr(vp + d0 * 4096 + ks * 1024 + 512); }
#define PK(k) (bf16x8){lo[k][0], lo[k][1], lo[k][2], lo[k][3], hi[k][0], hi[k][1], hi[k][2], hi[k][3]}
        o[d0] = __builtin_amdgcn_mfma_f32_32x32x16_bf16(pa0, PK(0), o[d0], 0, 0, 0);
        o[d0] = __builtin_amdgcn_mfma_f32_32x32x16_bf16(pa1, PK(1), o[d0], 0, 0, 0);
        o[d0] = __builtin_amdgcn_mfma_f32_32x32x16_bf16(pa2, PK(2), o[d0], 0, 0, 0);
        o[d0] = __builtin_amdgcn_mfma_f32_32x32x16_bf16(pa3, PK(3), o[d0], 0, 0, 0);
#undef PK
    }
}
__device__ __forceinline__ void wave_unit(const bf16* Qp, bf16* Op, const bf16* Kp, const bf16* Vp, const float* ckl, int qpos0, float kmaxn, ALAS unsigned char* wl, int lane) {
    const int r32 = lane & 31, hi = lane >> 5;
    ALAS unsigned char* vt = wl; ALAS bf16* stg = (ALAS bf16*)(wl + 8192); ALAS float* wsf = (ALAS float*)(wl + 8192 + 4096);
    const ALAS unsigned char* vp = vt + ((lane >> 4) & 1) * 32 + (lane & 3) * 8 + (4 * hi + ((lane & 15) >> 2)) * 64;
    bf16x8 qr[4];
#pragma unroll
    for (int d0 = 0; d0 < 4; ++d0) qr[d0] = *(const bf16x8*)(Qp + (size_t)r32 * 1024 + d0 * 16 + hi * 8);
    float qn2 = 0.f;
#pragma unroll
    for (int d0 = 0; d0 < 4; ++d0)
#pragma unroll
        for (int e = 0; e < 8; ++e) { const float v = bf2f(qr[d0][e]); qn2 += v * v; }
    qn2 += __shfl_xor(qn2, 32);
    const float qkb = __builtin_amdgcn_sqrtf(qn2) * kmaxn * 1.03f + 1.0f;
    const float cq = ckl[qpos0 + r32];
    float mref = 0.f, l = 0.f; f32x16 o[2]; o[0] = f32x16{}; o[1] = f32x16{};
    const int jd = (qpos0 + 31) >> 6;
    bf16x8 kf[8]; f32x4 bpre;
    ALAS float* bl = (ALAS float*)(wl + 8192 + 4096 + 256);
#define ATT_LOADK(JT) do { const bf16* kp_ = Kp + (size_t)(64 * (JT) + r32) * 1024 + hi * 8; \
        _Pragma("unroll") for (int d0 = 0; d0 < 4; ++d0) { kf[2 * d0] = *(const bf16x8*)(kp_ + d0 * 16); kf[2 * d0 + 1] = *(const bf16x8*)(kp_ + 32 * 1024 + d0 * 16); } \
        bpre = *(const f32x4*)(ckl + 64 * (JT) + 4 * (lane & 15)); } while (0)
#define ATT_LOADV(JT) do { _Pragma("unroll") for (int w = 0; w < 8; ++w) __builtin_amdgcn_global_load_lds((const unsigned*)(Vp + (size_t)(64 * (JT) + 16 * (w & 3) + (lane >> 2)) * 1024 + 32 * (w >> 2) + 8 * (lane & 3)), \
        (ALAS unsigned*)(vt + w * 1024), 16, 0, 0); } while (0)
    ATT_LOADK(jd); ATT_LOADV(jd);
    for (int j = jd; j >= 0; --j) {
        const int s0 = 64 * j;
        f32x16 p0, p1; const float base = cq - mref;
        if (lane < 16) *(ALAS f32x4*)(bl + 4 * lane) = bpre;
#pragma unroll
        for (int jj = 0; jj < 4; ++jj) { const f32x4 a = *(const ALAS f32x4*)(bl + 8 * jj + 4 * hi), b = *(const ALAS f32x4*)(bl + 32 + 8 * jj + 4 * hi);
#pragma unroll
            for (int e = 0; e < 4; ++e) { p0[4 * jj + e] = base - a[e]; p1[4 * jj + e] = base - b[e]; } }
#pragma unroll
        for (int d0 = 0; d0 < 4; ++d0) { p0 = __builtin_amdgcn_mfma_f32_32x32x16_bf16(kf[2 * d0], qr[d0], p0, 0, 0, 0); p1 = __builtin_amdgcn_mfma_f32_32x32x16_bf16(kf[2 * d0 + 1], qr[d0], p1, 0, 0, 0); }
        if (j > 0) ATT_LOADK(j - 1);
        if (j == jd) { const int qp = qpos0 + r32;
#pragma unroll
            for (int r = 0; r < 16; ++r) { const int kv = s0 + crow(r, hi); if (kv > qp) p0[r] = -INFINITY; if (kv + 32 > qp) p1[r] = -INFINITY; } }
        float rm;
        { float a = fmaxf(p0[0], p1[0]);
#pragma unroll
          for (int r = 1; r < 16; ++r) a = fmaxf(a, fmaxf(p0[r], p1[r]));
          rm = fmaxf(a, __shfl_xor(a, 32)); }
        if (j == jd) {
            mref = rm;
#pragma unroll
            for (int r = 0; r < 16; ++r) { p0[r] -= rm; p1[r] -= rm; }
        } else if (__any(rm > 0.f)) {
            const float dl = fmaxf(rm, 0.f); mref += dl;
#pragma unroll
            for (int r = 0; r < 16; ++r) { p0[r] -= dl; p1[r] -= dl; }
            const float f = __builtin_amdgcn_exp2f(-dl); l *= f; if (hi == 0) wsf[r32] = f;
            asm volatile("s_waitcnt lgkmcnt(0)" ::: "memory");
#pragma unroll
            for (int d_ = 0; d_ < 2; ++d_)
#pragma unroll
                for (int r = 0; r < 16; ++r) o[d_][r] *= wsf[crow(r, hi)];
        }
        float sacc = 0.f;
#pragma unroll
        for (int r = 0; r < 16; ++r) { p0[r] = __builtin_amdgcn_exp2f(p0[r]); p1[r] = __builtin_amdgcn_exp2f(p1[r]); sacc += p0[r] + p1[r]; }
        l += sacc;
        u32x4 pw0, pw1, pw2, pw3;
        pw0 = (u32x4){cvtpk_s(p0[0], p0[1]), cvtpk_s(p0[2], p0[3]), cvtpk_s(p0[4], p0[5]), cvtpk_s(p0[6], p0[7])};
        pw1 = (u32x4){cvtpk_s(p0[8], p0[9]), cvtpk_s(p0[10], p0[11]), cvtpk_s(p0[12], p0[13]), cvtpk_s(p0[14], p0[15])};
        pw2 = (u32x4){cvtpk_s(p1[0], p1[1]), cvtpk_s(p1[2], p1[3]), cvtpk_s(p1[4], p1[5]), cvtpk_s(p1[6], p1[7])};
        pw3 = (u32x4){cvtpk_s(p1[8], p1[9]), cvtpk_s(p1[10], p1[11]), cvtpk_s(p1[12], p1[13]), cvtpk_s(p1[14], p1[15])};
        if (j > 0) asm volatile("s_waitcnt vmcnt(9)" ::: "memory"); else asm volatile("s_waitcnt vmcnt(0)" ::: "memory");
        pv(o, vp, __builtin_bit_cast(bf16x8, pw0), __builtin_bit_cast(bf16x8, pw1), __builtin_bit_cast(bf16x8, pw2), __builtin_bit_cast(bf16x8, pw3));
        asm volatile("s_waitcnt lgkmcnt(0)" ::: "memory");
#if ATT_EARLY_EXIT
        if (j > 0) { const float cl = __uint_as_float(__builtin_amdgcn_readlane(__float_as_uint(bpre[3]), 15));
            const float ub = qkb + (cq - cl) - mref; if (!__any(ub > ATT_EXIT_LOG2)) break; }
#endif
        if (j > 0) ATT_LOADV(j - 1);
    }
    l += __shfl_xor(l, 32);
    if (hi == 0) wsf[32 + r32] = l;
    asm volatile("s_waitcnt lgkmcnt(0)" ::: "memory");
    float rli[16];
#pragma unroll
    for (int r = 0; r < 16; ++r) rli[r] = 1.0f / wsf[32 + crow(r, hi)];
#pragma unroll
    for (int r = 0; r < 16; ++r) { const int orow = crow(r, hi);
#pragma unroll
        for (int d0 = 0; d0 < 2; ++d0) { const unsigned w = cvtpk_s(o[d0][r] * rli[r], 0.f); stg[orow * 64 + d0 * 32 + r32] = (bf16)(w & 0xffffu); } }
    asm volatile("s_waitcnt lgkmcnt(0)" ::: "memory");
#pragma unroll
    for (int i = 0; i < 4; ++i) { const int row = i * 8 + (lane >> 3), ch = lane & 7; const u32x4 v = *(const ALAS u32x4*)(stg + row * 64 + ch * 8); *(u32x4*)(Op + (size_t)row * 1024 + ch * 8) = v; }
    asm volatile("s_waitcnt lgkmcnt(0)" ::: "memory");
}

constexpr int G_K = 0, G_V = 16384, G_PW = 32768, G_PWB = 4096 + 256 + 256, G_FLAG = G_PW + 8 * G_PWB, G_BYTES = G_FLAG + 64;
__device__ __forceinline__ void wg_unit(const bf16* Qb, bf16* Ob, const bf16* Kp, const bf16* Vp, const float* ckl, int qbase, int nact, float kmaxn, ALAS unsigned char* L, int wave, int lane) {
    const int r32 = lane & 31, hi = lane >> 5;
    ALAS unsigned char* pw = L + G_PW + wave * G_PWB;
    ALAS bf16* stg = (ALAS bf16*)pw; ALAS float* wsf = (ALAS float*)(pw + 4096); ALAS float* bl = (ALAS float*)(pw + 4096 + 256);
    ALAS unsigned* flags = (ALAS unsigned*)(L + G_FLAG);
    const bool active = wave < nact;
    const int qpos0 = qbase + 32 * wave, jd = (qpos0 + 31) >> 6, jmax = (qbase + 32 * nact - 1) >> 6;
    __syncthreads();
    if (threadIdx.x < 16) flags[threadIdx.x] = 0u;
    const ALAS unsigned char* vpo = L + G_V + ((lane >> 4) & 1) * 32 + (lane & 3) * 8 + (4 * hi + ((lane & 15) >> 2)) * 64;
#define WG_DMA(JT) do { const int sl_ = ((JT) & 1) * 8192; \
        __builtin_amdgcn_global_load_lds((const unsigned*)(Kp + (size_t)(64 * (JT) + lane) * 1024 + 8 * wave), (ALAS unsigned*)(L + G_K + sl_ + wave * 1024), 16, 0, 0); \
        __builtin_amdgcn_global_load_lds((const unsigned*)(Vp + (size_t)(64 * (JT) + 16 * (wave & 3) + (lane >> 2)) * 1024 + 32 * (wave >> 2) + 8 * (lane & 3)), (ALAS unsigned*)(L + G_V + sl_ + wave * 1024), 16, 0, 0); } while (0)
    WG_DMA(jmax);
    bf16x8 qr[4]; float qkb = 0.f, cq = 0.f;
    if (active) {
#pragma unroll
        for (int d0 = 0; d0 < 4; ++d0) qr[d0] = *(const bf16x8*)(Qb + (size_t)(32 * wave + r32) * 1024 + d0 * 16 + hi * 8);
        float qn2 = 0.f;
#pragma unroll
        for (int d0 = 0; d0 < 4; ++d0)
#pragma unroll
            for (int e = 0; e < 8; ++e) { const float v = bf2f(qr[d0][e]); qn2 += v * v; }
        qn2 += __shfl_xor(qn2, 32);
        qkb = __builtin_amdgcn_sqrtf(qn2) * kmaxn * 1.03f + 1.0f;
        cq = ckl[qpos0 + r32];
    } else {
#pragma unroll
        for (int d0 = 0; d0 < 4; ++d0) qr[d0] = bf16x8{};
    }
    float mref = 0.f, l = 0.f; f32x16 o[2]; o[0] = f32x16{}; o[1] = f32x16{};
    f32x4 bpre = *(const f32x4*)(ckl + 64 * jmax + 4 * (lane & 15));
    bool done = false;
    for (int j = jmax; j >= 0; --j) {
        asm volatile("s_waitcnt vmcnt(0)" ::: "memory");
        __syncthreads();
        { unsigned nd = 0;
#pragma unroll
          for (int w = 0; w < 8; ++w) nd += (w < nact) ? flags[((j + 1) & 1) * 8 + w] : 0u;
          if (nd >= (unsigned)nact) break; }
        if (j > 0) WG_DMA(j - 1);
        const f32x4 bcur = bpre;
        if (j > 0) bpre = *(const f32x4*)(ckl + 64 * (j - 1) + 4 * (lane & 15));
        if (active && !done && j <= jd) {
            const ALAS unsigned char* ks = L + G_K + (j & 1) * 8192 + hi * 1024 + r32 * 16;
            f32x16 p0, p1; const float base = cq - mref;
            if (lane < 16) *(ALAS f32x4*)(bl + 4 * lane) = bcur;
            { f32x4 qa[4], qb[4];
#pragma unroll
              for (int jj = 0; jj < 4; ++jj) { qa[jj] = base - *(const ALAS f32x4*)(bl + 8 * jj + 4 * hi); qb[jj] = base - *(const ALAS f32x4*)(bl + 32 + 8 * jj + 4 * hi); }
              p0 = (f32x16){qa[0][0], qa[0][1], qa[0][2], qa[0][3], qa[1][0], qa[1][1], qa[1][2], qa[1][3], qa[2][0], qa[2][1], qa[2][2], qa[2][3], qa[3][0], qa[3][1], qa[3][2], qa[3][3]};
              p1 = (f32x16){qb[0][0], qb[0][1], qb[0][2], qb[0][3], qb[1][0], qb[1][1], qb[1][2], qb[1][3], qb[2][0], qb[2][1], qb[2][2], qb[2][3], qb[3][0], qb[3][1], qb[3][2], qb[3][3]}; }
#pragma unroll
            for (int d0 = 0; d0 < 4; ++d0) { const bf16x8 k0 = *(const ALAS bf16x8*)(ks + d0 * 2048), k1 = *(const ALAS bf16x8*)(ks + d0 * 2048 + 512);
                p0 = __builtin_amdgcn_mfma_f32_32x32x16_bf16(k0, qr[d0], p0, 0, 0, 0); p1 = __builtin_amdgcn_mfma_f32_32x32x16_bf16(k1, qr[d0], p1, 0, 0, 0); }
            if (j == jd) { const int qp = qpos0 + r32, s0 = 64 * j;
#pragma unroll
                for (int r = 0; r < 16; ++r) { const int kv = s0 + crow(r, hi); if (kv > qp) p0[r] = -INFINITY; if (kv + 32 > qp) p1[r] = -INFINITY; } }
            float rm;
            { float a = fmaxf(p0[0], p1[0]);
#pragma unroll
              for (int r = 1; r < 16; ++r) a = fmaxf(a, fmaxf(p0[r], p1[r]));
              rm = fmaxf(a, __shfl_xor(a, 32)); }
            if (j == jd) {
                mref = rm;
#pragma unroll
                for (int r = 0; r < 16; ++r) { p0[r] -= rm; p1[r] -= rm; }
            } else if (__any(rm > 0.f)) {
                const float dl = fmaxf(rm, 0.f); mref += dl;
#pragma unroll
                for (int r = 0; r < 16; ++r) { p0[r] -= dl; p1[r] -= dl; }
                const float f = __builtin_amdgcn_exp2f(-dl); l *= f; if (hi == 0) wsf[r32] = f;
                asm volatile("s_waitcnt lgkmcnt(0)" ::: "memory");
#pragma unroll
                for (int d_ = 0; d_ < 2; ++d_)
#pragma unroll
                    for (int r = 0; r < 16; ++r) o[d_][r] *= wsf[crow(r, hi)];
            }
#pragma unroll
            for (int r = 0; r < 16; ++r) { p0[r] = __builtin_amdgcn_exp2f(p0[r]); p1[r] = __builtin_amdgcn_exp2f(p1[r]); }
            { const f32x16 ps = p0 + p1;
              const f32x4 s4 = ((f32x4){ps[0], ps[1], ps[2], ps[3]} + (f32x4){ps[4], ps[5], ps[6], ps[7]}) + ((f32x4){ps[8], ps[9], ps[10], ps[11]} + (f32x4){ps[12], ps[13], ps[14], ps[15]});
              l += (s4[0] + s4[1]) + (s4[2] + s4[3]); }
            u32x4 pw0, pw1, pw2, pw3;
            pw0 = (u32x4){cvtpk_s(p0[0], p0[1]), cvtpk_s(p0[2], p0[3]), cvtpk_s(p0[4], p0[5]), cvtpk_s(p0[6], p0[7])};
            pw1 = (u32x4){cvtpk_s(p0[8], p0[9]), cvtpk_s(p0[10], p0[11]), cvtpk_s(p0[12], p0[13]), cvtpk_s(p0[14], p0[15])};
            pw2 = (u32x4){cvtpk_s(p1[0], p1[1]), cvtpk_s(p1[2], p1[3]), cvtpk_s(p1[4], p1[5]), cvtpk_s(p1[6], p1[7])};
            pw3 = (u32x4){cvtpk_s(p1[8], p1[9]), cvtpk_s(p1[10], p1[11]), cvtpk_s(p1[12], p1[13]), cvtpk_s(p1[14], p1[15])};
            pv(o, vpo + (j & 1) * 8192, __builtin_bit_cast(bf16x8, pw0), __builtin_bit_cast(bf16x8, pw1), __builtin_bit_cast(bf16x8, pw2), __builtin_bit_cast(bf16x8, pw3));
            if (j == 0) done = true;
            else { const float cl = __uint_as_float(__builtin_amdgcn_readlane(__float_as_uint(bpre[3]), 15));
                const float ub = qkb + (cq - cl) - mref; if (!__any(ub > ATT_EXIT_LOG2)) done = true; }
        }
        if (lane == 0) flags[(j & 1) * 8 + wave] = done ? 1u : 0u;
        asm volatile("s_waitcnt lgkmcnt(0)" ::: "memory");
    }
    if (active) {
        l += __shfl_xor(l, 32);
        if (hi == 0) wsf[32 + r32] = l;
        asm volatile("s_waitcnt lgkmcnt(0)" ::: "memory");
        float rli[16];
#pragma unroll
        for (int r = 0; r < 16; ++r) rli[r] = 1.0f / wsf[32 + crow(r, hi)];
#pragma unroll
        for (int r = 0; r < 16; ++r) { const int orow = crow(r, hi);
#pragma unroll
            for (int d0 = 0; d0 < 2; ++d0) { const unsigned w = cvtpk_s(o[d0][r] * rli[r], 0.f); stg[orow * 64 + d0 * 32 + r32] = (bf16)(w & 0xffffu); } }
        asm volatile("s_waitcnt lgkmcnt(0)" ::: "memory");
        bf16* Op = Ob + (size_t)(32 * wave) * 1024;
#pragma unroll
        for (int i = 0; i < 4; ++i) { const int row = i * 8 + (lane >> 3), ch = lane & 7; const u32x4 v = *(const ALAS u32x4*)(stg + row * 64 + ch * 8); *(u32x4*)(Op + (size_t)row * 1024 + ch * 8) = v; }
        asm volatile("s_waitcnt lgkmcnt(0)" ::: "memory");
    }
#undef WG_DMA
}
#undef ATT_LOADK
#undef ATT_LOADV
}

constexpr int NWAVES = 8;
constexpr int DM = 1024, FF = 2816, NH = 16;
constexpr int MP = 16384, MS = 512, M = MP + MS;
constexpr int TP = 8192, TS = 64, PAST = 2048, TKS = PAST + TS;
constexpr float C2 = 0.125f * 1.4426950408889634f;
constexpr float LOG2E = 1.4426950408889634f;
#ifndef MK_N_LAUNCHES
#define MK_N_LAUNCHES 1
#endif
constexpr int NPHASE = 15;
#ifndef PROBE_P0_REPS
#define PROBE_P0_REPS 1
#endif
#ifndef PROBE_P3_REPS
#define PROBE_P3_REPS 1
#endif
#ifndef PROBE_P1_REPS
#define PROBE_P1_REPS 1
#endif
#ifndef PROBE_P2_REPS
#define PROBE_P2_REPS 1
#endif
#ifndef PROBE_P9_REPS
#define PROBE_P9_REPS 1
#endif
#ifndef PROBE_P7_REPS
#define PROBE_P7_REPS 1
#endif
#ifndef USE_XCD_BAR
#define USE_XCD_BAR 1
#endif
#ifndef RUNTIME_DELAY
#define RUNTIME_DELAY 0
#endif
#ifndef RUNTIME_USE_CG
#define RUNTIME_USE_CG 0
#endif
#ifndef PROBE_ATT_REPS
#define PROBE_ATT_REPS 1
#endif
constexpr size_t OFF_Y = 0, OFF_POOLP = 17301504, OFF_POOLS = 17332224, OFF_LFP = 51009536, OFF_LFS = 52320256, OUT_TOTAL = 52328448;
constexpr size_t MiB = 1u << 20;
constexpr size_t WS_BAR = 65536, WS_CNT = 131072;
constexpr size_t WS_KMX = 0, WS_SS = 1 * MiB, WS_CKLP = 3 * MiB, WS_CKLS = 4 * MiB, WS_WFG = 6 * MiB, WS_WPOOL = 7 * MiB;
constexpr size_t WS_WKVIN = 8 * MiB  , WS_WIN00 = 23 * MiB, WS_WIN01 = 34 * MiB, WS_WIN11 = 45 * MiB, WS_WOUT = 56 * MiB  ;
constexpr size_t WOUT_BYTES = (size_t)DM * FF * 2;
constexpr size_t WS_WQ = 78 * MiB, WS_WO = 80 * MiB, WS_XB = 82 * MiB, WS_ACT = 115 * MiB, WS_QO = WS_ACT, WS_DP = WS_ACT + 33 * MiB;
constexpr size_t WS_KB = 206 * MiB, WS_VB = 238 * MiB, WS_KS = 270 * MiB, WS_VS = 303 * MiB, WS_END = 336 * MiB;
static_assert(WS_WOUT + 4 * WOUT_BYTES <= WS_WQ && WS_XB + (size_t)M * DM * 2 <= WS_ACT && WS_ACT + (size_t)M * FF * 2 <= WS_KB && WS_DP + (size_t)M * DM * 2 <= WS_KB, "ws map");
static_assert(WS_KS + (size_t)8 * TKS * DM * 2 <= WS_VS && WS_VS + (size_t)8 * TKS * DM * 2 <= WS_END && WS_CKLS + (size_t)8 * 16 * TKS * 4 <= WS_WFG, "ws map 2");
constexpr int RING_BYTES = 131072, LDS_BYTES = 147456;

#define LAS __attribute__((address_space(3)))
typedef unsigned short bf16;
typedef unsigned v4u __attribute__((ext_vector_type(4)));
typedef unsigned v2u __attribute__((ext_vector_type(2)));
typedef float f32x4 __attribute__((ext_vector_type(4)));
typedef float f32x2 __attribute__((ext_vector_type(2)));
typedef short bf16x8 __attribute__((ext_vector_type(8)));
#define LDS_WAIT() asm volatile("s_waitcnt lgkmcnt(0)" ::: "memory")
__device__ __forceinline__ unsigned pk2(float lo, float hi) { return pg8::cvt_pk_bf16(lo, hi); }
__device__ __forceinline__ float wave_sum(float v) {
#pragma unroll
    for (int o = 1; o < 64; o <<= 1) v += __shfl_xor(v, o);
    return v;
}
__device__ __forceinline__ void tr_item(const float* W, int K, int N, bf16* WT, int k0, int n0, int drow0, const float* gain, int lane) {
    const int kg = lane >> 3, nl = lane & 7;
    const float* src = W + (size_t)(k0 + 8 * kg) * N + n0 + 4 * nl;
    f32x4 v[8];
#pragma unroll
    for (int i = 0; i < 8; ++i) v[i] = __builtin_nontemporal_load((const f32x4*)(src + (size_t)i * N));
    if (gain) { const f32x4 g0 = *(const f32x4*)(gain + k0 + 8 * kg), g1 = *(const f32x4*)(gain + k0 + 8 * kg + 4);
#pragma unroll
        for (int i = 0; i < 4; ++i) { v[i] = v[i] * g0[i]; v[4 + i] = v[4 + i] * g1[i]; } }
#pragma unroll
    for (int e = 0; e < 4; ++e) { v4u o; o.x = pk2(v[0][e], v[1][e]); o.y = pk2(v[2][e], v[3][e]); o.z = pk2(v[4][e], v[5][e]); o.w = pk2(v[6][e], v[7][e]);
        *(v4u*)(WT + (size_t)(drow0 + 4 * nl + e) * K + k0 + 8 * kg) = o; }
}
template <int W> __device__ __forceinline__ void pool_emit(const float (&u)[31][2], int posbase, int t0, bf16* dst  ) {
#pragma unroll
    for (int i = 0; i < 16; ++i) {
        float s0 = 0.f, s1 = 0.f;
#pragma unroll
        for (int j = W - 1; j >= 0; --j) { s0 += u[15 + i - j][0]; s1 += u[15 + i - j][1]; }
        const int pos = posbase + t0 + i; const float cnt = (float)(pos + 1 < W ? pos + 1 : W);
        const float d0 = s0 / cnt - u[15 + i][0], d1 = s1 / cnt - u[15 + i][1];
        *(unsigned*)(dst + (size_t)i * 256) = pk2(d0, d1);
    }
}

#define XB_TMO      128
#define XB_XCNT(j)  (256  + 64 * (j))
#define XB_XSUB(j)  (1280 + 64 * (j))
#define XB_XGEN(j)  (2304 + 64 * (j))
#define XB_TOP      3328
#define XB_TOPGEN   3392
#define XCD_BAR_WORDS 3456
#define XB_SPIN_CAP (1u << 18)

__device__ __forceinline__ unsigned xb_ld(unsigned* p)              { return __hip_atomic_load(p, __ATOMIC_RELAXED, __HIP_MEMORY_SCOPE_AGENT); }
__device__ __forceinline__ unsigned xb_add(unsigned* p, unsigned v) { return __hip_atomic_fetch_add(p, v, __ATOMIC_RELAXED, __HIP_MEMORY_SCOPE_AGENT); }
__device__ __forceinline__ unsigned xb_xcc_id() { return (unsigned)__builtin_amdgcn_s_getreg((3 << 11) | 20) & 0xFu; }
#define XB_SPIN(cond, bar) do { unsigned _sp = 0; while (cond) { __builtin_amdgcn_s_sleep(1); \
    if ((++_sp & 255u) == 0u) { if (xb_ld(&(bar)[XB_TMO])) break; if (_sp > XB_SPIN_CAP) { atomicAdd(&(bar)[XB_TMO], 1u); break; } } } } while (0)

struct XcdBarrier {
    unsigned* bar; unsigned x;
    volatile LAS unsigned* st;
};

__device__ __forceinline__ XcdBarrier xcd_barrier_post(unsigned* bar, volatile LAS unsigned* st) {
    XcdBarrier b; b.bar = bar; b.x = xb_xcc_id(); b.st = st;
    if (threadIdx.x == 0) (void)xb_add(&bar[XB_XCNT(b.x)], 1u);
    return b;
}
__device__ __forceinline__ void xcd_barrier_complete(unsigned* bar, unsigned x, unsigned& nloc, unsigned& nx) {
    const unsigned G = gridDim.x * gridDim.y * gridDim.z;
    unsigned sum, cnt, mine, sp = 0u;
    for (;;) {
        sum = 0u; cnt = 0u; mine = 0u;
#pragma unroll
        for (unsigned j = 0; j < 16; ++j) { const unsigned c = xb_ld(&bar[XB_XCNT(j)]); sum += c; cnt += (c > 0u) ? 1u : 0u; mine = (j == x) ? c : mine; }
        if (sum == G) break;
        __builtin_amdgcn_s_sleep(1);
        if ((++sp & 255u) == 0u) { if (xb_ld(&bar[XB_TMO])) break; if (sp > XB_SPIN_CAP) { atomicAdd(&bar[XB_TMO], 1u); break; } }
    }
    nloc = mine > 0u ? mine : 1u; nx = cnt > 0u ? cnt : 1u;
}

__device__ __forceinline__ void xcd_barrier(const XcdBarrier& b) {
    asm volatile("s_waitcnt vmcnt(0)" ::: "memory");
    __syncthreads();
    if (threadIdx.x == 0) {
        unsigned* bar = b.bar;
        __builtin_amdgcn_s_waitcnt(0);
        unsigned nloc = b.st[0], nx = b.st[1];
        if (nloc == 0u) { xcd_barrier_complete(bar, b.x, nloc, nx); b.st[0] = nloc; b.st[1] = nx; }
        const unsigned old = xb_add(&bar[XB_XSUB(b.x)], 1u);
        const unsigned gen = old / nloc;
        if (old + 1u == (gen + 1u) * nloc) {
            __builtin_amdgcn_fence(__ATOMIC_RELEASE, "agent");
            asm volatile("s_waitcnt vmcnt(0)" ::: "memory");
            const unsigned og = xb_add(&bar[XB_TOP], 1u);
            const unsigned tg = og / nx;
            if (og + 1u == (tg + 1u) * nx) xb_add(&bar[XB_TOPGEN], 1u);
            else XB_SPIN(xb_ld(&bar[XB_TOPGEN]) == tg, bar);
            __builtin_amdgcn_fence(__ATOMIC_ACQUIRE, "agent");
            xb_add(&bar[XB_XGEN(b.x)], 1u);
            asm volatile("s_waitcnt vmcnt(0)" ::: "memory");
        } else {
            XB_SPIN(xb_ld(&bar[XB_XGEN(b.x)]) == gen, bar);
            __builtin_amdgcn_fence(__ATOMIC_ACQUIRE, "agent");
            asm volatile("s_waitcnt vmcnt(0)" ::: "memory");
        }
    }
    __syncthreads();
}
#define GB_SUB(g) (64 * (g))
#define GB_GEN(g) (512 + 64 * (g))
#define GB_TOP 1024
#define GB_TOPGEN 1088
__device__ __forceinline__ void grp_barrier(unsigned* gb, int delay) {
    asm volatile("s_waitcnt vmcnt(0)" ::: "memory");
    __syncthreads();
    if (threadIdx.x == 0) {
        __builtin_amdgcn_fence(__ATOMIC_RELEASE, "agent");
        asm volatile("s_waitcnt vmcnt(0)" ::: "memory");
        for (int d_ = 0; d_ < delay; ++d_) __builtin_amdgcn_s_sleep(16);
        const unsigned g = blockIdx.x & 7u, nloc = gridDim.x >> 3;
        const unsigned old = xb_add(&gb[GB_SUB(g)], 1u), gen = old / nloc;
        if (old + 1u == (gen + 1u) * nloc) {
            const unsigned og = xb_add(&gb[GB_TOP], 1u), tg = og >> 3;
            if (og + 1u == (tg + 1u) * 8u) xb_add(&gb[GB_TOPGEN], 1u);
            else { unsigned sp = 0; while (xb_ld(&gb[GB_TOPGEN]) == tg) { __builtin_amdgcn_s_sleep(1); if (++sp > (1u << 24)) break; } }
            xb_add(&gb[GB_GEN(g)], 1u);
        } else { unsigned sp = 0; while (xb_ld(&gb[GB_GEN(g)]) == gen) { __builtin_amdgcn_s_sleep(1); if (++sp > (1u << 24)) break; } }
        __builtin_amdgcn_fence(__ATOMIC_ACQUIRE, "agent");
        asm volatile("s_waitcnt vmcnt(0)" ::: "memory");
    }
    __syncthreads();
}
struct Args { const float* in[20]; float* out; unsigned char* ws; int ph_lo, ph_hi, use_cg, pad; };

__global__ void __launch_bounds__(NWAVES * 64, 2) mega_fwd(Args args) {
    extern __shared__ __attribute__((aligned(16))) unsigned char lds_raw[];
    cg::grid_group grid = cg::this_grid();
    LAS unsigned char* lds = (LAS unsigned char*)lds_raw;
    const int tid = threadIdx.x, lane = tid & 63, wave = __builtin_amdgcn_readfirstlane(tid >> 6);
    const int G = gridDim.x, bx = blockIdx.x;
    const int gw = bx * NWAVES + wave, NGW = G * NWAVES;
    unsigned char* ws = args.ws; float* dout = args.out;
    const float* x_prompt = args.in[0]; const float* x_sample = args.in[1]; const float* cache_pool = args.in[2];
    const float* cache_k = args.in[3]; const float* cache_v = args.in[4]; const float* cache_logf = args.in[5];
    const float* ln_ffn1 = args.in[6]; const float* ln_mix = args.in[7]; const float* ln_ffn2 = args.in[8];
    const float* w_ffn_in = args.in[9]; const float* w_ffn_out = args.in[10]; const float* w_pool = args.in[11]; const float* pool_scale = args.in[12];
    const float* ln_kv = args.in[13]; const float* w_kv = args.in[14]; const float* w_fgate = args.in[15]; const float* b_fgate = args.in[16];
    const float* w_q = args.in[17]; const float* w_o = args.in[18]; const float* ln_final = args.in[19];
    unsigned* KMX = (unsigned*)(ws + WS_KMX); float* SS = (float*)(ws + WS_SS); float* CKLP = (float*)(ws + WS_CKLP); float* CKLS = (float*)(ws + WS_CKLS);
    bf16* WFG = (bf16*)(ws + WS_WFG); bf16* WPOOL = (bf16*)(ws + WS_WPOOL); bf16* WKVIN = (bf16*)(ws + WS_WKVIN);
    bf16* WIN00 = (bf16*)(ws + WS_WIN00); bf16* WIN01 = (bf16*)(ws + WS_WIN01); bf16* WIN11 = (bf16*)(ws + WS_WIN11);
    bf16* WQ = (bf16*)(ws + WS_WQ); bf16* WO = (bf16*)(ws + WS_WO); bf16* XB = (bf16*)(ws + WS_XB); bf16* ACT = (bf16*)(ws + WS_ACT); bf16* QO = (bf16*)(ws + WS_QO); bf16* DP = (bf16*)(ws + WS_DP); bf16* OB = DP;
    bf16* KB = (bf16*)(ws + WS_KB); bf16* VB = (bf16*)(ws + WS_VB); bf16* KS = (bf16*)(ws + WS_KS); bf16* VS = (bf16*)(ws + WS_VS);
    float* X32 = dout + OFF_Y;
    const int lo = args.ph_lo, hi = args.ph_hi;
#define IN(k) (lo <= (k) && (k) < hi)
    volatile LAS unsigned* MISC = (volatile LAS unsigned*)(lds + LDS_BYTES - 256);
    LAS unsigned* LCNT = (LAS unsigned*)(lds + LDS_BYTES - 1024);
    if (tid < 32) MISC[tid] = 0u;
    if (tid == 32) *LCNT = 0u;
    __syncthreads();
    unsigned* barw = (unsigned*)(ws + WS_BAR); unsigned* CNT = (unsigned*)(ws + WS_CNT);
    XcdBarrier bar; bar.bar = barw; bar.x = 0; bar.st = nullptr;
#define SEAM(k) do { if (IN(k) && IN((k) + 1)) { if ((k) == lo) { grid.sync(); bar = xcd_barrier_post(barw, MISC + 8); } else xcd_barrier(bar); } } while (0)
#define GEMM_PHASE(EPI, E, Aptr, Bptr, Kdim, LDA, PNSTEP, NCOLS) do { pg8::Gemm g_{(const pg8::bf16_t*)(Aptr), (const pg8::bf16_t*)(Bptr), (Kdim), (LDA), (size_t)(PNSTEP)}; \
        pg8::StaticOrder S_; S_.init(M, (NCOLS), G, bx); pg8::gemm_phase<EPI, pg8::StaticOrder, true, true>(lds, g_, S_, E); } while (0)

#define RIDE_PHASE(EPI, E, Bptr, NTILES, SLOT, WOUTP, BASE_LO, BASE_HI, OUT32) do {   \
        { pg8::Gemm g_{(const pg8::bf16_t*)XB, (const pg8::bf16_t*)(Bptr), DM, DM, (size_t)0}; pg8::RideOrder S_; S_.init((NTILES), bx); pg8::gemm_phase<EPI, pg8::RideOrder, true, true>(lds, g_, S_, E); } \
        if (bx >= 248) { const int s_ = bx - 248, pan_ = s_ >> 2; unsigned* cw_ = CNT + 128 * (SLOT) + 64 * pan_; \
            if (tid == 0) { unsigned sp_ = 0; while (__hip_atomic_load(cw_, __ATOMIC_RELAXED, __HIP_MEMORY_SCOPE_AGENT) < (unsigned)(NTILES) * 8u) { __builtin_amdgcn_s_sleep(2); if (++sp_ > (1u << 22)) break; } } \
            __syncthreads(); __builtin_amdgcn_fence(__ATOMIC_ACQUIRE, "agent"); asm volatile("s_waitcnt vmcnt(0)" ::: "memory"); \
            pg8::Gemm g2_{(const pg8::bf16_t*)ACT, (const pg8::bf16_t*)(WOUTP), FF, FF, (size_t)0}; pg8::OneUnit S2_{64 + pan_, s_ & 3}; \
            pg8::EpiRes E2_{(BASE_LO), (BASE_HI), (OUT32), XB, SS, nullptr, 0.5f}; pg8::gemm_phase<pg8::EpiRes, pg8::OneUnit, true, true>(lds, g2_, S2_, E2_); } } while (0)
#define GEMM_PROMPT(EPI, E, Aptr, Bptr, Kdim, LDA, NCOLS) do { pg8::Gemm g_{(const pg8::bf16_t*)(Aptr), (const pg8::bf16_t*)(Bptr), (Kdim), (LDA), (size_t)0}; \
        pg8::StaticOrder S_; S_.init(MP, (NCOLS), G, bx); pg8::gemm_phase<EPI, pg8::StaticOrder, true, true>(lds, g_, S_, E); } while (0)

#define FGATE_ROWS(IT0, IT1, W0, NW) do { \
        const int fr = lane & 15, fq = lane >> 4; \
        for (int it = (IT0) + (W0); it < (IT1); it += (NW)) { \
            const int row = it * 16 + fr; f32x4 acc = {0.f, 0.f, 0.f, 0.f}; \
            const bf16* ap = XB + (size_t)row * DM + 8 * fq; const bf16* bp = WFG + (size_t)fr * DM + 8 * fq; \
_Pragma("unroll 16") \
            for (int ks = 0; ks < 32; ++ks) { const bf16x8 av = *(const bf16x8*)(ap + 32 * ks), bv = *(const bf16x8*)(bp + 32 * ks); acc = __builtin_amdgcn_mfma_f32_16x16x32_bf16(bv, av, acc, 0, 0, 0); } \
            const float rs = pg8::row_rstd(SS, row); const f32x4 bb = *(const f32x4*)(b_fgate + 4 * fq); f32x4 lf; \
_Pragma("unroll") \
            for (int e = 0; e < 4; ++e) { const float z = acc[e] * rs + bb[e]; lf[e] = fminf(z, 0.f) - 0.6931471805599453f * __builtin_amdgcn_logf(1.0f + __builtin_amdgcn_exp2f(-1.4426950408889634f * fabsf(z))); }   \
            float* dp = (row < MP) ? dout + OFF_LFP + (size_t)row * 16 : dout + OFF_LFS + (size_t)(row - MP) * 16; \
            *(f32x4*)(dp + 4 * fq) = lf; \
        } \
    } while (0)

    if (IN(0)) for (int rep0 = 0; rep0 < PROBE_P0_REPS; ++rep0) {
        constexpr int I_IN = 16 * 176, I_OUT = 44 * 32, I_KV = 16 * 64, I_Q = 16 * 32, I_P = 4 * 8;
        constexpr int NITEMS = 4 * I_IN + 4 * I_OUT + I_KV + 2 * I_Q + 4 * I_P;
        for (int it = gw; it < NITEMS; it += NGW) {
            int r = it;
            if (r < 4 * I_IN) { const int f = r / I_IN; r -= f * I_IN; const int kb = r / 176, nb = r % 176, n0 = 32 * nb;
                const int drow = (n0 < FF) ? (n0 >> 7) * 256 + (n0 & 127) : ((n0 - FF) >> 7) * 256 + 128 + ((n0 - FF) & 127);
                bf16* dst = (f == 0) ? WIN00 : (f == 1) ? WIN01 : (f == 2) ? WKVIN + (size_t)2048 * DM : WIN11;
                const float* gain = ((f & 1) ? ln_ffn2 : ln_ffn1) + (f >> 1) * DM;
                tr_item(w_ffn_in + (size_t)f * DM * 2 * FF, DM, 2 * FF, dst, 64 * kb, n0, drow, gain, lane); continue; }
            r -= 4 * I_IN;
            if (r < 4 * I_OUT) { const int f = r / I_OUT; r -= f * I_OUT; const int kb = r / 32, nb = r % 32;
                tr_item(w_ffn_out + (size_t)f * FF * DM, FF, DM, (bf16*)(ws + WS_WOUT + f * WOUT_BYTES), 64 * kb, 32 * nb, 32 * nb, nullptr, lane); continue; }
            r -= 4 * I_OUT;
            if (r < I_KV) { const int kb = r / 64, nb = r % 64; tr_item(w_kv, DM, 2048, WKVIN, 64 * kb, 32 * nb, 32 * nb, ln_kv, lane); continue; }
            r -= I_KV;
            if (r < I_Q) { const int kb = r / 32, nb = r % 32; tr_item(w_q, DM, DM, WQ, 64 * kb, 32 * nb, 32 * nb, ln_mix + DM, lane); continue; }
            r -= I_Q;
            if (r < I_Q) { const int kb = r / 32, nb = r % 32; tr_item(w_o, DM, DM, WO, 64 * kb, 32 * nb, 32 * nb, nullptr, lane); continue; }
            r -= I_Q;
            { const int gq = r / I_P; r -= gq * I_P; const int kb = r / 8, nb = r % 8; tr_item(w_pool + (size_t)gq * 65536, 256, 256, WPOOL, 64 * kb, 32 * nb, gq * 256 + 32 * nb, nullptr, lane); }
        }
        for (int i = bx * 512 + tid; i < 16 * DM; i += G * 512) { const int n = i >> 10, k = i & 1023; WFG[i] = (bf16)(pk2(w_fgate[k * 16 + n] * ln_kv[k], 0.f) & 0xffffu); }
        if (bx == 0) { if (tid < 320) KMX[tid] = 0u; for (int i = tid; i < XCD_BAR_WORDS; i += 512) barw[i] = 0u; CNT[tid] = 0u; }
        for (int m0 = gw; m0 < M; m0 += 2 * NGW) {
            const int m1 = (m0 + NGW < M) ? m0 + NGW : m0;
            const float* xr0 = (m0 < MP) ? x_prompt + (size_t)m0 * DM : x_sample + (size_t)(m0 - MP) * DM;
            const float* xr1 = (m1 < MP) ? x_prompt + (size_t)m1 * DM : x_sample + (size_t)(m1 - MP) * DM;
            const f32x4* xv0 = (const f32x4*)xr0 + lane; const f32x4* xv1 = (const f32x4*)xr1 + lane; f32x4 v0[4], v1[4]; float s0 = 0.f, s1 = 0.f;
#pragma unroll
            for (int j = 0; j < 4; ++j) { v0[j] = __builtin_nontemporal_load(xv0 + 64 * j); v1[j] = __builtin_nontemporal_load(xv1 + 64 * j); }
#pragma unroll
            for (int j = 0; j < 4; ++j) { s0 += (v0[j].x * v0[j].x + v0[j].y * v0[j].y) + (v0[j].z * v0[j].z + v0[j].w * v0[j].w); s1 += (v1[j].x * v1[j].x + v1[j].y * v1[j].y) + (v1[j].z * v1[j].z + v1[j].w * v1[j].w); }
            s0 = wave_sum(s0); s1 = wave_sum(s1);
            v2u* o0 = (v2u*)(XB + (size_t)m0 * DM) + lane; v2u* o1 = (v2u*)(XB + (size_t)m1 * DM) + lane;
#pragma unroll
            for (int j = 0; j < 4; ++j) { v2u w; w.x = pk2(v0[j].x, v0[j].y); w.y = pk2(v0[j].z, v0[j].w); o0[64 * j] = w; w.x = pk2(v1[j].x, v1[j].y); w.y = pk2(v1[j].z, v1[j].w); o1[64 * j] = w; }
            if (lane < 16) { SS[(size_t)m0 * 16 + lane] = (lane == 0) ? s0 : 0.f; SS[(size_t)m1 * 16 + lane] = (lane == 0) ? s1 : 0.f; }
        }
    }
    SEAM(0);
    if (IN(1) && PROBE_P1_REPS > 1) { pg8::EpiSwiglu E{ACT, SS, 0, nullptr, LCNT}; GEMM_PROMPT(pg8::EpiSwiglu, E, XB, WIN00, DM, DM, 2 * FF); }
    if (IN(1)) { pg8::EpiSwiglu E{ACT, SS, 0, CNT + 128 * 0, LCNT}; RIDE_PHASE(pg8::EpiSwiglu, E, WIN00, 22, 0, ws + WS_WOUT, x_prompt, x_sample, (float*)nullptr); }
    SEAM(1);
    if (IN(2) && PROBE_P2_REPS > 1) { pg8::EpiRes E{x_prompt, x_sample, nullptr, XB, SS, nullptr, 0.5f}; GEMM_PROMPT(pg8::EpiRes, E, ACT, ws + WS_WOUT, FF, FF, DM); }
    if (IN(2)) { pg8::EpiRes E{x_prompt, x_sample, nullptr, XB, SS, nullptr, 0.5f}; GEMM_PROMPT(pg8::EpiRes, E, ACT, ws + WS_WOUT, FF, FF, DM); }
    SEAM(2);
    if (IN(3)) for (int rep3 = 0; rep3 < PROBE_P3_REPS; ++rep3) {
        LAS float* rsl = (LAS float*)lds;
        for (int item = bx; item < 1024 + 32; item += G) {
            int sb, ch; if (item < 1024) { sb = item >> 9; ch = item & 511; } else { const int r = item - 1024; sb = 2 + (r >> 2); ch = r & 3; }
            const bool prompt = sb < 2; const int T = prompt ? TP : TS, t0 = ch * 16, grow0 = prompt ? sb * TP : MP + (sb - 2) * TS;
            if (tid < 31) { const int t = t0 - 15 + tid; rsl[tid] = (t >= 0) ? pg8::row_rstd(SS, grow0 + t) : 0.f; }
            __syncthreads();
            const int c = 2 * tid; const float g0 = ln_mix[c], g1 = ln_mix[c + 1];
            float u[31][2];
#pragma unroll
            for (int i = 0; i < 31; ++i) { const int t = t0 - 15 + i;
                if (t >= 0) { const unsigned xw = *(const unsigned*)(XB + (size_t)(grow0 + t) * DM + c); const float rs = rsl[i]; u[i][0] = __uint_as_float(xw << 16) * rs * g0; u[i][1] = __uint_as_float(xw & 0xffff0000u) * rs * g1; }
                else if (!prompt) { const f32x2 hv = *(const f32x2*)(cache_pool + (size_t)((sb - 2) * 15 + 15 + t) * DM + c); u[i][0] = hv.x; u[i][1] = hv.y; }
                else { u[i][0] = 0.f; u[i][1] = 0.f; } }
            const int gq = c >> 8, posbase = prompt ? 0 : PAST;
            bf16* dst = DP + (size_t)gq * M * 256 + (size_t)(grow0 + t0) * 256 + (c & 255);
            if (gq == 0) pool_emit<2>(u, posbase, t0, dst); else if (gq == 1) pool_emit<4>(u, posbase, t0, dst); else if (gq == 2) pool_emit<8>(u, posbase, t0, dst); else pool_emit<16>(u, posbase, t0, dst);
            float* pout = dout + (prompt ? OFF_POOLP + (size_t)sb * 15 * DM : OFF_POOLS + (size_t)(sb - 2) * 15 * DM);
#pragma unroll
            for (int i = 0; i < 16; ++i) { const int t = t0 + i; if (t >= T - 15) { f32x2 o; o.x = u[15 + i][0]; o.y = u[15 + i][1]; *(f32x2*)(pout + (size_t)(t - (T - 15)) * DM + c) = o; } }
            __syncthreads();
        }
    }
    SEAM(3);
    if (IN(4)) { pg8::EpiRes E{nullptr, nullptr, nullptr, XB, SS, pool_scale, 1.0f}; GEMM_PHASE(pg8::EpiRes, E, DP, WPOOL, 256, 256, (size_t)M * 256 * 2, DM); }
    SEAM(4);
    if (IN(5)) { pg8::EpiSwiglu E{ACT, SS, 0, CNT + 128 * 1, LCNT}; RIDE_PHASE(pg8::EpiSwiglu, E, WIN01, 22, 1, ws + WS_WOUT + WOUT_BYTES, (const float*)nullptr, (const float*)nullptr, (float*)nullptr); }
    SEAM(5);
    if (IN(6)) { pg8::EpiRes E{nullptr, nullptr, nullptr, XB, SS, nullptr, 0.5f}; GEMM_PROMPT(pg8::EpiRes, E, ACT, ws + WS_WOUT + WOUT_BYTES, FF, FF, DM);
        FGATE_ROWS(MP / 16, M / 16, gw, NGW); }
    SEAM(6);
    if (IN(7) && PROBE_P7_REPS > 1) { pg8::EpiKVSwiglu E{pg8::EpiKV{dout, KB, VB, KS, VS, SS, KMX, nullptr}, pg8::EpiSwiglu{ACT, SS, 8, nullptr, LCNT}}; GEMM_PROMPT(pg8::EpiKVSwiglu, E, XB, WKVIN, DM, DM, 2048 + 2 * FF); }
    if (IN(7)) {
        pg8::EpiKVSwiglu E{pg8::EpiKV{dout, KB, VB, KS, VS, SS, KMX, CNT + 128 * 2}, pg8::EpiSwiglu{ACT, SS, 8, CNT + 128 * 2, LCNT}};
        RIDE_PHASE(pg8::EpiKVSwiglu, E, WKVIN, 30, 2, ws + WS_WOUT + 2 * WOUT_BYTES, (const float*)nullptr, (const float*)nullptr, (float*)nullptr);
        FGATE_ROWS(0, MP / 16, gw, NGW);
    }
    SEAM(7);
    if (IN(8)) {
        pg8::EpiRes E{nullptr, nullptr, nullptr, XB, SS, nullptr, 0.5f}; GEMM_PROMPT(pg8::EpiRes, E, ACT, ws + WS_WOUT + 2 * WOUT_BYTES, FF, FF, DM);
    }
    SEAM(8);
    if (IN(9)) for (int rep9 = 0; rep9 < PROBE_P9_REPS; ++rep9) { { pg8::EpiQ E{QO, SS, C2}; GEMM_PHASE(pg8::EpiQ, E, XB, WQ, DM, DM, 0, DM); }
        if (bx >= 8 && bx < 246) {
            LAS float* red = (LAS float*)lds;
            for (int ch = bx - 8; ch < 512; ch += 238) {
                const int b = ch >> 6; float mx[4] = {0.f, 0.f, 0.f, 0.f};
                for (int i = 0; i < 4; ++i) {
                    const int r = ch * 32 + wave * 4 + i, s = r & 2047;
                    const f32x4* kx = (const f32x4*)(cache_k + (size_t)r * DM) + lane; const f32x4* vx = (const f32x4*)(cache_v + (size_t)r * DM) + lane;
                    f32x4 kv[4], vv[4];
#pragma unroll
                    for (int j = 0; j < 4; ++j) { kv[j] = __builtin_nontemporal_load(kx + 64 * j); vv[j] = __builtin_nontemporal_load(vx + 64 * j); }
                    v2u* ko = (v2u*)(KS + (size_t)(b * TKS + s) * DM) + lane; v2u* vo = (v2u*)(VS + (size_t)(b * TKS + s) * DM) + lane;
#pragma unroll
                    for (int j = 0; j < 4; ++j) { v2u w; w.x = pk2(kv[j].x, kv[j].y); w.y = pk2(kv[j].z, kv[j].w); ko[64 * j] = w; w.x = pk2(vv[j].x, vv[j].y); w.y = pk2(vv[j].z, vv[j].w); vo[64 * j] = w;
                        float n2 = (kv[j].x * kv[j].x + kv[j].y * kv[j].y) + (kv[j].z * kv[j].z + kv[j].w * kv[j].w); n2 += __shfl_xor(n2, 1); n2 += __shfl_xor(n2, 2); n2 += __shfl_xor(n2, 4);
                        mx[j] = fmaxf(mx[j], n2); }
                }
                if ((lane & 7) == 0) {
#pragma unroll
                    for (int j = 0; j < 4; ++j) red[(wave * 4 + j) * 8 + (lane >> 3)] = mx[j]; }
                __syncthreads();
                if (tid < 32) { float v = red[tid];
#pragma unroll
                    for (int w = 1; w < 8; ++w) v = fmaxf(v, red[w * 32 + tid]);
                    atomicMax(KMX + ((2 + b) * 16 + 4 * (tid >> 3) + ((tid & 7) >> 1)) * 2 + (tid & 1), __float_as_uint(v)); }
                __syncthreads();
            }
        }
        LAS f32x4* part4 = (LAS f32x4*)lds;
        for (int sb = G - 1 - bx; sb < 10; sb += G) {
            const bool prompt = sb < 2; const int b = prompt ? 0 : sb - 2, T = prompt ? TP : TKS, NCH = prompt ? 128 : 66, CH = prompt ? 64 : 32, c = tid >> 2, hq = tid & 3;
            const float* srcA = prompt ? dout + OFF_LFP + (size_t)sb * TP * 16 : cache_logf + (size_t)b * PAST * 16;
            const float* srcB = dout + OFF_LFS + (size_t)b * TS * 16 - (size_t)PAST * 16;
#define LF4_AT(t) (*(const f32x4*)((((prompt) || (t) < PAST) ? srcA : srcB) + (size_t)(t) * 16 + 4 * hq))
            f32x4 s = {0.f, 0.f, 0.f, 0.f};
            if (c < NCH) for (int t0 = c * CH; t0 < (c + 1) * CH; t0 += 16) { f32x4 v[16];
#pragma unroll
                for (int i = 0; i < 16; ++i) v[i] = LF4_AT(t0 + i);
#pragma unroll
                for (int i = 0; i < 16; ++i) s += v[i]; }
            part4[c * 4 + hq] = s; __syncthreads();
            if (c < NCH) {
                f32x4 run = {0.f, 0.f, 0.f, 0.f}; for (int cc = 0; cc < c; ++cc) run += part4[cc * 4 + hq];
                float* dst = (prompt ? CKLP + (size_t)(sb * 16 + 4 * hq) * TP : CKLS + (size_t)(b * 16 + 4 * hq) * TKS);
                for (int t0 = c * CH; t0 < (c + 1) * CH; t0 += 16) { f32x4 v[16];
#pragma unroll
                    for (int i = 0; i < 16; ++i) v[i] = LF4_AT(t0 + i);
#pragma unroll
                    for (int i = 0; i < 16; ++i) { run += v[i]; v[i] = run * LOG2E; }
#pragma unroll
                    for (int e = 0; e < 4; ++e)
#pragma unroll
                        for (int i = 0; i < 4; ++i) *(f32x4*)(dst + (size_t)e * T + t0 + 4 * i) = (f32x4){v[4 * i][e], v[4 * i + 1][e], v[4 * i + 2][e], v[4 * i + 3][e]}; }
            }
#undef LF4_AT
            __syncthreads();
        }
    }
    SEAM(9);
    if (IN(10)) {
        for (int rep = 0; rep < PROBE_ATT_REPS; ++rep)
        for (int gi = bx; gi < 1024 + 128; gi += G) {
            int qrow0, qbase, sb, h, nact; const bf16 *Kp, *Vp; const float* ckl;
            if (gi < 1024) { const int bh = gi >> 5, qb = gi & 31, b = bh >> 4; h = bh & 15; sb = b; qrow0 = b * TP + 256 * qb; qbase = 256 * qb; nact = 8;
                Kp = KB + (size_t)b * TP * DM + h * 64; Vp = VB + (size_t)b * TP * DM + h * 64; ckl = CKLP + (size_t)bh * TP; }
            else { const int bh = gi - 1024, b = bh >> 4; h = bh & 15; sb = 2 + b; qrow0 = MP + b * TS; qbase = PAST; nact = 2;
                Kp = KS + (size_t)b * TKS * DM + h * 64; Vp = VS + (size_t)b * TKS * DM + h * 64; ckl = CKLS + (size_t)bh * TKS; }
            const float kmaxn = __builtin_amdgcn_sqrtf(__uint_as_float(KMX[(sb * 16 + h) * 2]) + __uint_as_float(KMX[(sb * 16 + h) * 2 + 1]));
            att::wg_unit(QO + (size_t)qrow0 * DM + h * 64, OB + (size_t)qrow0 * DM + h * 64, Kp, Vp, ckl, qbase, nact, kmaxn, lds, wave, lane);
        }
        __syncthreads();
    }
    SEAM(10);
    if (IN(11)) { pg8::EpiRes E{nullptr, nullptr, nullptr, XB, SS, nullptr, 1.0f}; GEMM_PHASE(pg8::EpiRes, E, OB, WO, DM, DM, 0, DM); }
    SEAM(11);
    if (IN(12)) { pg8::EpiSwiglu E{ACT, SS, 0, CNT + 128 * 3, LCNT}; RIDE_PHASE(pg8::EpiSwiglu, E, WIN11, 22, 3, ws + WS_WOUT + 3 * WOUT_BYTES, (const float*)nullptr, (const float*)nullptr, (float*)nullptr); }
    SEAM(12);
    if (IN(13)) { pg8::EpiRes E{nullptr, nullptr, nullptr, XB, SS, nullptr, 0.5f}; GEMM_PROMPT(pg8::EpiRes, E, ACT, ws + WS_WOUT + 3 * WOUT_BYTES, FF, FF, DM); }
    SEAM(13);
    if (IN(14)) {
        for (int m0 = gw; m0 < M; m0 += 2 * NGW) {
            const int m1 = (m0 + NGW < M) ? m0 + NGW : m0;
            const v2u* xa = (const v2u*)(XB + (size_t)m0 * DM) + lane; const v2u* xb = (const v2u*)(XB + (size_t)m1 * DM) + lane; const f32x4* gv = (const f32x4*)ln_final + lane;
            v2u wa[4], wb[4];
#pragma unroll
            for (int j = 0; j < 4; ++j) { wa[j] = xa[64 * j]; wb[j] = xb[64 * j]; }
            const float ra = pg8::row_rstd(SS, m0), rb = pg8::row_rstd(SS, m1);
            f32x4* ya = (f32x4*)(X32 + (size_t)m0 * DM) + lane; f32x4* yb = (f32x4*)(X32 + (size_t)m1 * DM) + lane;
#pragma unroll
            for (int j = 0; j < 4; ++j) { const f32x4 g = gv[64 * j];
                __builtin_nontemporal_store((f32x4){__uint_as_float(wa[j].x << 16) * ra * g.x, __uint_as_float(wa[j].x & 0xffff0000u) * ra * g.y, __uint_as_float(wa[j].y << 16) * ra * g.z, __uint_as_float(wa[j].y & 0xffff0000u) * ra * g.w}, ya + 64 * j);
                __builtin_nontemporal_store((f32x4){__uint_as_float(wb[j].x << 16) * rb * g.x, __uint_as_float(wb[j].x & 0xffff0000u) * rb * g.y, __uint_as_float(wb[j].y << 16) * rb * g.z, __uint_as_float(wb[j].y & 0xffff0000u) * rb * g.w}, yb + 64 * j); }
        }
    }
#undef IN
#undef SEAM
#undef GEMM_PHASE
#undef GEMM_PROMPT
#undef RIDE_PHASE
#undef FGATE_ROWS
}

extern "C" void kernel_launch(void* const* d_in, const int* in_sizes, int n_in, void* d_out, int out_size, void* d_ws, size_t ws_size, hipStream_t stream) {
    static int grid = 0;
    if (grid == 0) {
        if (n_in != 20 || (size_t)out_size != OUT_TOTAL || ws_size < WS_END) { fprintf(stderr, "kernel_launch: unexpected shapes (n_in %d out %d ws %zu)\n", n_in, out_size, ws_size); grid = -1; return; }
        int dev = 0, cus = 0, per_cu = 0;
        if (hipGetDevice(&dev) != hipSuccess || hipDeviceGetAttribute(&cus, hipDeviceAttributeMultiprocessorCount, dev) != hipSuccess) { grid = -1; return; }
        if (hipFuncSetAttribute((const void*)mega_fwd, hipFuncAttributeMaxDynamicSharedMemorySize, LDS_BYTES) != hipSuccess) { fprintf(stderr, "kernel_launch: hipFuncSetAttribute failed\n"); grid = -1; return; }
        if (hipOccupancyMaxActiveBlocksPerMultiprocessor(&per_cu, (const void*)mega_fwd, NWAVES * 64, LDS_BYTES) != hipSuccess || per_cu < 1) { fprintf(stderr, "kernel_launch: occupancy query says %d\n", per_cu); (void)hipGetLastError(); grid = -1; return; }
        if (cus != 256) { fprintf(stderr, "kernel_launch: built for a 256-CU device (got %d)\n", cus); grid = -1; return; }
        grid = cus * 1;
    }
    if (grid < 0) return;
    Args a{};
    for (int i = 0; i < 20; ++i) a.in[i] = (const float*)d_in[i];
    a.out = (float*)d_out; a.ws = (unsigned char*)d_ws; a.use_cg = RUNTIME_USE_CG; a.pad = RUNTIME_DELAY;
#if MK_N_LAUNCHES == 1
    a.ph_lo = 0; a.ph_hi = NPHASE;
    void* kargs[] = {&a};
    hipError_t e = hipLaunchCooperativeKernel((const void*)mega_fwd, dim3(grid), dim3(NWAVES * 64), kargs, LDS_BYTES, stream);
    if (e != hipSuccess) fprintf(stderr, "cooperative launch failed: %s (grid %d)\n", hipGetErrorString(e), grid);
#else
    for (int p = 0; p < NPHASE; ++p) { a.ph_lo = p; a.ph_hi = p + 1; hipLaunchKernelGGL(mega_fwd, dim3(grid), dim3(NWAVES * 64), LDS_BYTES, stream, a); }
#endif
}
```

```cpp
#include <hip/hip_runtime.h>
#include <hip/hip_cooperative_groups.h>
#include <cstdio>
#include <cstdint>
#include <cmath>
namespace cg = cooperative_groups;
namespace pg8 {
#define PG8_LAS __attribute__((address_space(3)))
typedef unsigned short bf16_t;
typedef short bf16x8 __attribute__((ext_vector_type(8)));
typedef float f32x4 __attribute__((ext_vector_type(4)));
typedef unsigned u32x4 __attribute__((ext_vector_type(4)));
constexpr int BM = 256, BK = 64, HALF = 128, HTB = HALF * BK * 2  , STAGE_BYTES = 8 * HTB, NXCD = 8, WGM = 8;

__host__ __device__ __forceinline__ int lds_byte(int r, int c) { const int st = (r >> 4) * 2 + (c >> 5), rr = r & 15, cc = c & 31, ob = rr * 64 + cc * 2; return st * 1024 + (ob ^ (((ob >> 9) & 1) << 5)); }
__host__ __device__ __forceinline__ void stage_rc(int b, int& R, int& C) { const int st = b / 1024, sb = b % 1024, swz = sb ^ (((sb >> 9) & 1) << 5); R = (st >> 1) * 16 + swz / 64; C = (st & 1) * 32 + (swz % 64) / 2; }
__host__ __device__ __forceinline__ int perm32(int rho) { const int n = rho >> 4, i = rho & 15; return 8 * (i >> 2) + 4 * n + (i & 3); }

struct Unit { int pm, pn; };
struct Gemm { const bf16_t* A; const bf16_t* Bt; int K; int lda; size_t a_pn_step; };

struct StaticOrder {
    int nM, nN, nwg, G, c;
    __host__ __device__ void init(int M, int N, int G_, int c_) { nM = M / BM; nN = N / BM; nwg = nM * nN; G = G_; c = c_; }
    __host__ __device__ bool next(int i, Unit& u) const {
        const long L = (long)i * G + c; if (L >= nwg) return false;
        int wgid = (int)L; { const int q = nwg / NXCD, r = nwg % NXCD, xcd = wgid % NXCD, off = wgid / NXCD; wgid = (xcd < r ? xcd * (q + 1) : r * (q + 1) + (xcd - r) * q) + off; }
        const int nig = WGM * nN, gid = wgid / nig, fm = gid * WGM, gsz = (nM - fm) < WGM ? (nM - fm) : WGM;
        u.pm = fm + ((wgid % nig) % gsz); u.pn = (wgid % nig) / gsz; return true;
    }
    __device__ __forceinline__ void a_ready(const Unit&) const {}
    __device__ __forceinline__ void done(const Unit&) const {}
};

__device__ __forceinline__ void map_tile(long L, int nM, int nN, Unit& u) {
    const int nwg = nM * nN; int wgid = (int)L; { const int q = nwg / NXCD, r = nwg % NXCD, xcd = wgid % NXCD, off = wgid / NXCD; wgid = (xcd < r ? xcd * (q + 1) : r * (q + 1) + (xcd - r) * q) + off; }
    const int nig = WGM * nN, gid = wgid / nig, fm = gid * WGM, gsz = (nM - fm) < WGM ? (nM - fm) : WGM;
    u.pm = fm + ((wgid % nig) % gsz); u.pn = ((wgid % nig) / gsz + 4 * gid) % nN;
}
struct RideOrder {
    static constexpr int GIVE = 3;
    int nN, c, nP, sample_e, orphanL;
    __device__ __forceinline__ void init(int nN_, int c_) {
        nN = nN_; c = c_; const int nwgP = 64 * nN, nS = 2 * nN;
        nP = (nwgP - c + 255) / 256; sample_e = (c >= 128 && c < 128 + nS) ? c - 128 : -1; orphanL = -1;
        if (c >= 248) nP -= GIVE;
        else if (c >= 128 + nS && c < 128 + nS + 8 * GIVE) { const int o = c - 128 - nS, sc = 248 + o / GIVE; orphanL = ((nwgP - sc + 255) / 256 - 1 - o % GIVE) * 256 + sc; }
    }
    __device__ __forceinline__ bool next(int i, Unit& u) const {
        if (sample_e >= 0) { if (i == 0) { u.pm = 64 + (sample_e & 1); u.pn = sample_e >> 1; return true; } --i; }
        long L; if (i < nP) L = (long)i * 256 + c; else if (i == nP && orphanL >= 0) L = orphanL; else return false;
        map_tile(L, 64, nN, u); return true;
    }
    __device__ __forceinline__ void a_ready(const Unit&) const {}
    __device__ __forceinline__ void done(const Unit&) const {}
};
struct OneUnit {
    int pm, pn;
    __device__ __forceinline__ bool next(int i, Unit& u) const { if (i != 0 || pm < 0) return false; u.pm = pm; u.pn = pn; return true; }
    __device__ __forceinline__ void a_ready(const Unit&) const {}
    __device__ __forceinline__ void done(const Unit&) const {}
};

constexpr int ROWS_P = 16384;
constexpr int DM_ = 1024, FF_ = 2816;
constexpr size_t OFF_KP = 17455104, OFF_VP = 34232320, OFF_KS = 51271680, OFF_VS = 51795968;
__device__ __forceinline__ unsigned cvt_pk_bf16(float lo, float hi) { unsigned r; asm volatile("v_cvt_pk_bf16_f32 %0, %1, %2" : "=v"(r) : "v"(lo), "v"(hi)); return r; }
__device__ __forceinline__ u32x4 pack8(const f32x4 a, const f32x4 b) { u32x4 w; w.x = cvt_pk_bf16(a[0], a[1]); w.y = cvt_pk_bf16(a[2], a[3]); w.z = cvt_pk_bf16(b[0], b[1]); w.w = cvt_pk_bf16(b[2], b[3]); return w; }
__device__ __forceinline__ float row_rstd(const float* SS, int row) {
    const f32x4* p = (const f32x4*)(SS + (size_t)row * 16);
    const f32x4 a = p[0], b = p[1], c = p[2], d = p[3];
    const float s = (((a[0] + a[1]) + (a[2] + a[3])) + ((b[0] + b[1]) + (b[2] + b[3]))) + (((c[0] + c[1]) + (c[2] + c[3])) + ((d[0] + d[1]) + (d[2] + d[3])));
    return rsqrtf(s * (1.0f / 1024.0f) + 1e-6f);
}
__device__ __forceinline__ void rows_rstd(const float* SS, int row0, int fq, float (&rs)[2][4]) {
    f32x4 t[2][4];
#pragma unroll
    for (int ai = 0; ai < 2; ++ai)
#pragma unroll
        for (int m = 0; m < 4; ++m) t[ai][m] = *(const f32x4*)(SS + (size_t)(row0 + ai * HALF + m * 16) * 16 + 4 * fq);
#pragma unroll
    for (int ai = 0; ai < 2; ++ai)
#pragma unroll
        for (int m = 0; m < 4; ++m) { float s = (t[ai][m][0] + t[ai][m][1]) + (t[ai][m][2] + t[ai][m][3]); s += __shfl_xor(s, 16); s += __shfl_xor(s, 32); rs[ai][m] = rsqrtf(s * (1.0f / 1024.0f) + 1e-6f); }
}
__device__ __forceinline__ float silu_mul(float g, float u) { return g * __builtin_amdgcn_rcpf(1.0f + __builtin_amdgcn_exp2f(-1.4426950408889634f * g)) * u; }

struct EpiSwiglu {
    static constexpr bool PERM = true, AFTER_DRAIN = false;
    bf16_t* ACT; const float* SS; int pn0; unsigned* cnt; PG8_LAS unsigned* lcnt;
    __device__ __forceinline__ void operator()(const f32x4 (&acc)[2][2][4][2], const Unit& u, int wr, int wc, int fr, int fq) const {
        const int row0 = u.pm * BM + wr * 64 + fr, col0 = (u.pn - pn0) * 128 + wc * 32 + 8 * fq;
        float rsv[2][4]; rows_rstd(SS, row0, fq, rsv);
#pragma unroll
        for (int ai = 0; ai < 2; ++ai)
#pragma unroll
            for (int m = 0; m < 4; ++m) {
                const int row = row0 + ai * HALF + m * 16; const float rs = rsv[ai][m];
                const float k1 = -1.4426950408889634f * rs, k2 = rs * rs;
                f32x4 h[2];
#pragma unroll
                for (int n = 0; n < 2; ++n) { const f32x4 g = acc[ai][0][m][n], uu = acc[ai][1][m][n]; const f32x4 t = g * k1; f32x4 ex;
#pragma unroll
                    for (int e = 0; e < 4; ++e) ex[e] = __builtin_amdgcn_exp2f(t[e]);
                    const f32x4 d = ex + 1.0f; f32x4 r;
#pragma unroll
                    for (int e = 0; e < 4; ++e) r[e] = __builtin_amdgcn_rcpf(d[e]);
                    h[n] = ((g * uu) * k2) * r; }
                *(u32x4*)(ACT + (size_t)row * FF_ + col0) = pack8(h[0], h[1]);
            }
        if (cnt && u.pm >= 64) {
            asm volatile("s_waitcnt vmcnt(0)" ::: "memory");
            unsigned old = 0u;
            if ((fr | fq) == 0) old = __hip_atomic_fetch_add(lcnt, 1u, __ATOMIC_RELAXED, __HIP_MEMORY_SCOPE_WORKGROUP);
            old = (unsigned)__builtin_amdgcn_readfirstlane((int)old);
            if (old == 7u) {
                if ((fr | fq) == 0) __hip_atomic_store(lcnt, 0u, __ATOMIC_RELAXED, __HIP_MEMORY_SCOPE_WORKGROUP);
                __builtin_amdgcn_fence(__ATOMIC_RELEASE, "agent");
                if ((fr | fq) == 0) __hip_atomic_fetch_add(cnt + 64 * (u.pm - 64), 8u, __ATOMIC_RELAXED, __HIP_MEMORY_SCOPE_AGENT);
            }
        }
    }
};
struct EpiRes {
    static constexpr bool PERM = true, AFTER_DRAIN = false;
    const float* in_lo; const float* in_hi;
    float* out32; bf16_t* XB; float* SS; const float* colscale; float alpha;
    __device__ __forceinline__ void operator()(const f32x4 (&acc)[2][2][4][2], const Unit& u, int wr, int wc, int fr, int fq) const {
        const int row0 = u.pm * BM + wr * 64 + fr, colw = u.pn * BM + wc * 32 + 8 * fq;
        f32x4 sc[2][2];
#pragma unroll
        for (int bj = 0; bj < 2; ++bj)
#pragma unroll
            for (int n = 0; n < 2; ++n) sc[bj][n] = colscale ? *(const f32x4*)(colscale + colw + bj * HALF + 4 * n) : (f32x4){alpha, alpha, alpha, alpha};
#define EPIRES_ROW(B0, B1, M_, BJ_) do { const int row = row0 + ai * HALF + (M_) * 16, col = colw + (BJ_) * HALF; \
            const f32x4 o0 = (B0) + sc[BJ_][0] * acc[ai][BJ_][M_][0], o1 = (B1) + sc[BJ_][1] * acc[ai][BJ_][M_][1]; \
            if (out32) { float* op = out32 + (size_t)row * DM_ + col; *(f32x4*)op = o0; *(f32x4*)(op + 4) = o1; } \
            *(u32x4*)(XB + (size_t)row * DM_ + col) = pack8(o0, o1); \
            ssq[M_] += ((o0[0] * o0[0] + o0[1] * o0[1]) + (o0[2] * o0[2] + o0[3] * o0[3])) + ((o1[0] * o1[0] + o1[1] * o1[1]) + (o1[2] * o1[2] + o1[3] * o1[3])); } while (0)
#pragma unroll
        for (int ai = 0; ai < 2; ++ai) {
            float ssq[4] = {0.f, 0.f, 0.f, 0.f};
            if (in_lo) {
#pragma unroll
                for (int mh = 0; mh < 2; ++mh) { f32x4 bq[2][2][2];
#pragma unroll
                    for (int mm = 0; mm < 2; ++mm) { const int row = row0 + ai * HALF + (2 * mh + mm) * 16; const float* bp = (row < ROWS_P) ? in_lo + (size_t)row * DM_ : in_hi + (size_t)(row - ROWS_P) * DM_;
#pragma unroll
                        for (int bj = 0; bj < 2; ++bj) { bq[mm][bj][0] = *(const f32x4*)(bp + colw + bj * HALF); bq[mm][bj][1] = *(const f32x4*)(bp + colw + bj * HALF + 4); } }
#pragma unroll
                    for (int mm = 0; mm < 2; ++mm)
#pragma unroll
                        for (int bj = 0; bj < 2; ++bj) EPIRES_ROW(bq[mm][bj][0], bq[mm][bj][1], 2 * mh + mm, bj); }
            } else {
                u32x4 bw[4][2];
#pragma unroll
                for (int m = 0; m < 4; ++m)
#pragma unroll
                    for (int bj = 0; bj < 2; ++bj) bw[m][bj] = *(const u32x4*)(XB + (size_t)(row0 + ai * HALF + m * 16) * DM_ + colw + bj * HALF);
#pragma unroll
                for (int m = 0; m < 4; ++m)
#pragma unroll
                    for (int bj = 0; bj < 2; ++bj) { const u32x4 w = bw[m][bj];
                        const f32x4 b0 = (f32x4){__uint_as_float(w.x << 16), __uint_as_float(w.x & 0xffff0000u), __uint_as_float(w.y << 16), __uint_as_float(w.y & 0xffff0000u)};
                        const f32x4 b1 = (f32x4){__uint_as_float(w.z << 16), __uint_as_float(w.z & 0xffff0000u), __uint_as_float(w.w << 16), __uint_as_float(w.w & 0xffff0000u)};
                        EPIRES_ROW(b0, b1, m, bj); }
            }
#pragma unroll
            for (int m = 0; m < 4; ++m) { float s = ssq[m]; s += __shfl_xor(s, 16); s += __shfl_xor(s, 32);
                if (fq == 0) SS[(size_t)(row0 + ai * HALF + m * 16) * 16 + u.pn * 4 + wc] = s; }
        }
#undef EPIRES_ROW
    }
};
struct EpiKV {
    static constexpr bool PERM = true, AFTER_DRAIN = false;
    float* dout; bf16_t* KBp; bf16_t* VBp; bf16_t* KSp; bf16_t* VSp; const float* SS; unsigned* KMX; unsigned* cnt;
    __device__ __forceinline__ void operator()(const f32x4 (&acc)[2][2][4][2], const Unit& u, int wr, int wc, int fr, int fq) const {
        const bool isV = u.pn >= 4, samp = u.pm >= 64; const int ct = (u.pn & 3) * BM;
        const int row0 = u.pm * BM + wr * 64 + fr, colw = ct + wc * 32 + 8 * fq;
        float rsv[2][4]; rows_rstd(SS, row0, fq, rsv);
#pragma unroll
        for (int ai = 0; ai < 2; ++ai) {
            float mx[2] = {0.f, 0.f};
#pragma unroll
            for (int m = 0; m < 4; ++m) {
                const int row = row0 + ai * HALF + m * 16; const float rs = rsv[ai][m];
                float* fp; bf16_t* bp;
                if (!samp) { fp = dout + (isV ? OFF_VP : OFF_KP) + (size_t)row * DM_; bp = (isV ? VBp : KBp) + (size_t)row * DM_; }
                else { const int r2 = row - ROWS_P, b = r2 >> 6, t = r2 & 63; fp = dout + (isV ? OFF_VS : OFF_KS) + (size_t)r2 * DM_; bp = (isV ? VSp : KSp) + (size_t)(b * 2112 + 2048 + t) * DM_; }
#pragma unroll
                for (int bj = 0; bj < 2; ++bj) {
                    const int col = colw + bj * HALF;
                    const f32x4 v0 = acc[ai][bj][m][0] * rs, v1 = acc[ai][bj][m][1] * rs;
                    __builtin_nontemporal_store(v0, (f32x4*)(fp + col)); __builtin_nontemporal_store(v1, (f32x4*)(fp + col + 4));
                    *(u32x4*)(bp + col) = pack8(v0, v1);
                    if (!isV) {
                        float n2 = ((v0[0] * v0[0] + v0[1] * v0[1]) + (v0[2] * v0[2] + v0[3] * v0[3])) + ((v1[0] * v1[0] + v1[1] * v1[1]) + (v1[2] * v1[2] + v1[3] * v1[3]));
                        n2 += __shfl_xor(n2, 16); n2 += __shfl_xor(n2, 32);
                        mx[bj] = fmaxf(mx[bj], n2);
                    }
                }
            }
            if (!isV) {
#pragma unroll
                for (int bj = 0; bj < 2; ++bj) {
                    float v = mx[bj];
                    v = fmaxf(v, __shfl_xor(v, 1)); v = fmaxf(v, __shfl_xor(v, 2)); v = fmaxf(v, __shfl_xor(v, 4)); v = fmaxf(v, __shfl_xor(v, 8));
                    const int sb = samp ? 2 + (u.pm - 64) * 4 + 2 * ai + wr : (u.pm >> 5);
                    const int head = (ct + bj * HALF + wc * 32) >> 6, half = wc & 1;
                    if (fr == 0 && fq == 0) atomicMax(KMX + (sb * 16 + head) * 2 + half, __float_as_uint(v));
                }
            }
        }
        if (cnt && samp) {
            if ((fr | fq) == 0) __hip_atomic_fetch_add(cnt + 64 * (u.pm - 64), 1u, __ATOMIC_RELAXED, __HIP_MEMORY_SCOPE_AGENT);
        }
    }
};
struct EpiQ {
    static constexpr bool PERM = true, AFTER_DRAIN = false;
    bf16_t* Q; const float* SS; float c2;
    __device__ __forceinline__ void operator()(const f32x4 (&acc)[2][2][4][2], const Unit& u, int wr, int wc, int fr, int fq) const {
        const int row0 = u.pm * BM + wr * 64 + fr, colw = u.pn * BM + wc * 32 + 8 * fq;
        float rsv[2][4]; rows_rstd(SS, row0, fq, rsv);
#pragma unroll
        for (int ai = 0; ai < 2; ++ai)
#pragma unroll
            for (int m = 0; m < 4; ++m) {
                const int row = row0 + ai * HALF + m * 16; const float rs = rsv[ai][m] * c2;
#pragma unroll
                for (int bj = 0; bj < 2; ++bj) *(u32x4*)(Q + (size_t)row * DM_ + colw + bj * HALF) = pack8(acc[ai][bj][m][0] * rs, acc[ai][bj][m][1] * rs);
            }
    }
};
struct EpiKVSwiglu {
    static constexpr bool PERM = true, AFTER_DRAIN = false;
    EpiKV kv; EpiSwiglu sw;
    __device__ __forceinline__ void operator()(const f32x4 (&acc)[2][2][4][2], const Unit& u, int wr, int wc, int fr, int fq) const {
        if (u.pn < 8) kv(acc, u, wr, wc, fr, fq); else sw(acc, u, wr, wc, fr, fq);
    }
};
template <class Epi, class Sched, bool ALIGN_EPI = false, bool SP2 = false>
__device__ __forceinline__ void gemm_phase(PG8_LAS unsigned char* lds, const Gemm g, const Sched& S, const Epi& E) {
    const int tid = threadIdx.x, wid = __builtin_amdgcn_readfirstlane(tid >> 6), lane = tid & 63, wr = wid >> 2, wc = wid & 3, fr = lane & 15, fq = lane >> 4;
    const int K = g.K, nt = K / BK;
    unsigned voffA[2], voffB[2];
#pragma unroll
    for (int i = 0; i < 2; ++i) { int R, C; stage_rc(tid * 16 + i * 8192, R, C); const int Rb = Epi::PERM ? ((R & ~31) + perm32(R & 31)) : R;
        voffA[i] = (unsigned)(R * g.lda + C) * 2u; voffB[i] = (unsigned)(Rb * K + C) * 2u; }
    const size_t kstep = (size_t)(BK * 2);
    const size_t hstepA = (size_t)HALF * g.lda * 2, hstepB = (size_t)HALF * K * 2;
    const size_t tstepA = 2 * hstepA, tstepB = 2 * hstepB;
    const unsigned ldsw = (unsigned)wid * 1024u;
    const int aoff = lds_byte(wr * 64 + fr, fq * 8), boff = lds_byte(wc * 32 + fr, fq * 8);
#define PG8_SA(b, h) (((b) * 2 + (h)) * HTB)
#define PG8_SB(b, h) ((4 + (b) * 2 + (h)) * HTB)
#define PG8_STAGE(bufoff, gbase, voff) do { _Pragma("unroll") for (int _i = 0; _i < 2; ++_i) \
        __builtin_amdgcn_global_load_lds((const unsigned*)((const char*)(gbase) + (voff)[_i]), (PG8_LAS unsigned*)(lds + (bufoff) + ldsw + _i * 8192), 16, 0, 0); } while (0)
#define PG8_LDA(dst, b, h) do { _Pragma("unroll") for (int m = 0; m < 4; ++m) _Pragma("unroll") for (int k = 0; k < 2; ++k) dst[m][k] = *(const PG8_LAS bf16x8*)(lds + PG8_SA(b, h) + aoff + m * 2048 + k * 1024); } while (0)
#define PG8_LDB(dst, b, h) do { _Pragma("unroll") for (int n = 0; n < 2; ++n) _Pragma("unroll") for (int k = 0; k < 2; ++k) dst[n][k] = *(const PG8_LAS bf16x8*)(lds + PG8_SB(b, h) + boff + n * 2048 + k * 1024); } while (0)
#define PG8_MMA(ai, bj, At, Bt) do { __builtin_amdgcn_s_setprio(1); _Pragma("unroll") for (int m = 0; m < 4; ++m) _Pragma("unroll") for (int n = 0; n < 2; ++n) _Pragma("unroll") for (int k = 0; k < 2; ++k) \
        acc[ai][bj][m][n] = __builtin_amdgcn_mfma_f32_16x16x32_bf16(Bt[n][k], At[m][k], acc[ai][bj][m][n], 0, 0, 0); __builtin_amdgcn_s_setprio(0); } while (0)
#define PG8_WAIT_V(n) asm volatile("s_waitcnt vmcnt(" #n ")" ::: "memory")
#define PG8_WAIT_L(n) asm volatile("s_waitcnt lgkmcnt(" #n ")" ::: "memory")
#define PG8_BAR __builtin_amdgcn_s_barrier()
#define PG8_SCHED __builtin_amdgcn_sched_barrier(0)
    Unit cur, nxt; int ui = 0;
    if (!S.next(0, cur)) return;
    f32x4 acc[2][2][4][2];
#pragma unroll
    for (int a = 0; a < 2; ++a)
#pragma unroll
        for (int b = 0; b < 2; ++b)
#pragma unroll
            for (int m = 0; m < 4; ++m)
#pragma unroll
                for (int n = 0; n < 2; ++n) acc[a][b][m][n] = (f32x4){0.f, 0.f, 0.f, 0.f};
    bf16x8 At[4][2], B0[2][2], B1[2][2];
    const char* cA = (const char*)g.A + (size_t)cur.pm * tstepA + (size_t)cur.pn * g.a_pn_step; const char* cB = (const char*)g.Bt + (size_t)cur.pn * tstepB;
    S.a_ready(cur);
    if constexpr (SP2) {
        PG8_STAGE(PG8_SB(0, 0), cB, voffB); PG8_STAGE(PG8_SB(0, 1), cB + hstepB, voffB); PG8_STAGE(PG8_SA(0, 0), cA, voffA); PG8_STAGE(PG8_SA(0, 1), cA + hstepA, voffA);
        if (wr == 1) PG8_BAR;
        PG8_WAIT_V(2); PG8_BAR;
        PG8_STAGE(PG8_SB(1, 0), cB + kstep, voffB); PG8_STAGE(PG8_SA(1, 0), cA + kstep, voffA); PG8_STAGE(PG8_SB(1, 1), cB + hstepB + kstep, voffB);
        PG8_WAIT_V(6); PG8_BAR;
    } else {
        PG8_STAGE(PG8_SB(0, 0), cB, voffB); PG8_STAGE(PG8_SA(0, 0), cA, voffA); PG8_STAGE(PG8_SB(0, 1), cB + hstepB, voffB); PG8_STAGE(PG8_SA(0, 1), cA + hstepA, voffA);
        if (wr == 1) PG8_BAR;
        PG8_WAIT_V(4); PG8_BAR;
        PG8_STAGE(PG8_SB(1, 0), cB + kstep, voffB); PG8_STAGE(PG8_SA(1, 0), cA + kstep, voffA); PG8_STAGE(PG8_SB(1, 1), cB + hstepB + kstep, voffB);
        PG8_WAIT_V(6); PG8_BAR;
    }
    for (;;) {
        const bool has_next = S.next(ui + 1, nxt);
        const char* nA = has_next ? (const char*)g.A + (size_t)nxt.pm * tstepA + (size_t)nxt.pn * g.a_pn_step : cA; const char* nB = has_next ? (const char*)g.Bt + (size_t)nxt.pn * tstepB : cB;
        for (int t = 0; t < nt; t += 2) {
            const bool last = (t == nt - 2);
            const char* a1 = cA + (size_t)(t + 1) * kstep;
            const char* a2 = last ? nA : cA + (size_t)(t + 2) * kstep; const char* b2 = last ? nB : cB + (size_t)(t + 2) * kstep;
            const char* a3 = a2 + kstep; const char* b3 = b2 + kstep;
            if (last && has_next) S.a_ready(nxt);
            if constexpr (SP2) {
            PG8_LDB(B0, 0, 0); PG8_LDB(B1, 0, 1); PG8_SCHED; PG8_LDA(At, 0, 0); PG8_STAGE(PG8_SA(1, 1), a1 + hstepA, voffA);
            PG8_WAIT_V(8); PG8_WAIT_L(0); PG8_BAR; PG8_MMA(0, 0, At, B0); PG8_MMA(0, 1, At, B1); PG8_BAR; PG8_SCHED;
            PG8_LDA(At, 0, 1); PG8_STAGE(PG8_SB(0, 0), b2, voffB); PG8_STAGE(PG8_SB(0, 1), b2 + hstepB, voffB); PG8_STAGE(PG8_SA(0, 0), a2, voffA);
            PG8_WAIT_V(8); PG8_WAIT_L(0); PG8_BAR; PG8_MMA(1, 0, At, B0); PG8_MMA(1, 1, At, B1); PG8_BAR; PG8_SCHED;
            PG8_LDB(B0, 1, 0); PG8_LDB(B1, 1, 1); PG8_SCHED; PG8_LDA(At, 1, 0); PG8_STAGE(PG8_SA(0, 1), a2 + hstepA, voffA);
            PG8_WAIT_V(8); PG8_WAIT_L(0); PG8_BAR; PG8_MMA(0, 0, At, B0); PG8_MMA(0, 1, At, B1); PG8_BAR; PG8_SCHED;
            PG8_LDA(At, 1, 1); PG8_STAGE(PG8_SB(1, 0), b3, voffB); PG8_STAGE(PG8_SB(1, 1), b3 + hstepB, voffB); PG8_STAGE(PG8_SA(1, 0), a3, voffA);
            PG8_WAIT_V(8); PG8_WAIT_L(0); PG8_BAR; PG8_MMA(1, 0, At, B0); PG8_MMA(1, 1, At, B1); PG8_BAR; PG8_SCHED;
            } else {
            PG8_LDB(B0, 0, 0); PG8_SCHED; PG8_LDA(At, 0, 0); PG8_STAGE(PG8_SA(1, 1), a1 + hstepA, voffA);
            PG8_WAIT_L(8); PG8_BAR; PG8_WAIT_L(0); PG8_MMA(0, 0, At, B0); PG8_BAR; PG8_SCHED;
            PG8_LDB(B1, 0, 1); PG8_STAGE(PG8_SB(0, 0), b2, voffB);
            PG8_BAR; PG8_WAIT_L(0); PG8_MMA(0, 1, At, B1); PG8_BAR;
            PG8_LDA(At, 0, 1); PG8_STAGE(PG8_SA(0, 0), a2, voffA);
            PG8_BAR; PG8_WAIT_L(0); PG8_MMA(1, 0, At, B0); PG8_BAR; PG8_SCHED;
            PG8_STAGE(PG8_SB(0, 1), b2 + hstepB, voffB);
            PG8_WAIT_V(6); PG8_BAR; PG8_MMA(1, 1, At, B1); PG8_BAR;
            PG8_LDB(B0, 1, 0); PG8_SCHED; PG8_LDA(At, 1, 0); PG8_STAGE(PG8_SA(0, 1), a2 + hstepA, voffA);
            PG8_WAIT_L(8); PG8_BAR; PG8_WAIT_L(0); PG8_MMA(0, 0, At, B0); PG8_BAR; PG8_SCHED;
            PG8_LDB(B1, 1, 1); PG8_STAGE(PG8_SB(1, 0), b3, voffB);
            PG8_BAR; PG8_WAIT_L(0); PG8_MMA(0, 1, At, B1); PG8_BAR;
            PG8_LDA(At, 1, 1); PG8_STAGE(PG8_SA(1, 0), a3, voffA);
            PG8_BAR; PG8_WAIT_L(0); PG8_MMA(1, 0, At, B0); PG8_BAR; PG8_SCHED;
            PG8_STAGE(PG8_SB(1, 1), b3 + hstepB, voffB);
            PG8_WAIT_V(6); PG8_BAR; PG8_MMA(1, 1, At, B1); PG8_BAR;
            }
        }
        if constexpr (ALIGN_EPI) { if (wr == 0) PG8_BAR; }
        if constexpr (!Epi::AFTER_DRAIN) { E(acc, cur, wr, wc, fr, fq); S.done(cur); }
        if (!has_next) break;
#pragma unroll
        for (int a = 0; a < 2; ++a)
#pragma unroll
            for (int b = 0; b < 2; ++b)
#pragma unroll
                for (int m = 0; m < 4; ++m)
#pragma unroll
                    for (int n = 0; n < 2; ++n) acc[a][b][m][n] = (f32x4){0.f, 0.f, 0.f, 0.f};
        cur = nxt; cA = nA; cB = nB; ++ui;
        if constexpr (ALIGN_EPI) { if (wr == 1) PG8_BAR; }
    }
    PG8_WAIT_V(0);
    if constexpr (!ALIGN_EPI) { if (wr == 0) PG8_BAR; }
    PG8_BAR;
    if constexpr (Epi::AFTER_DRAIN) { E.fused(acc, cur, wr, wc, fr, fq, lds, wid, lane); S.done(cur); }
#undef PG8_SA
#undef PG8_SB
#undef PG8_STAGE
#undef PG8_LDA
#undef PG8_LDB
#undef PG8_MMA
#undef PG8_WAIT_V
#undef PG8_WAIT_L
#undef PG8_BAR
#undef PG8_SCHED
}}

namespace att {
#define ALAS __attribute__((address_space(3)))
using bf16 = unsigned short;
using bf16x8 = __attribute__((ext_vector_type(8))) short;
using s16x4 = __attribute__((ext_vector_type(4))) short;
using f32x16 = __attribute__((ext_vector_type(16))) float;
using f32x4 = __attribute__((ext_vector_type(4))) float;
using u32x4 = __attribute__((ext_vector_type(4))) unsigned;
typedef float f32x2_t __attribute__((ext_vector_type(2))); typedef __bf16 bf16x2_t __attribute__((ext_vector_type(2)));
#ifndef ATT_PREFETCH
#define ATT_PREFETCH 1
#endif
#ifndef ATT_EXIT_LOG2
#define ATT_EXIT_LOG2 -48.f
#endif
#ifndef ATT_EARLY_EXIT
#define ATT_EARLY_EXIT 1
#endif
constexpr int WLDS = 8192 + 4096 + 256 + 256;
__device__ __forceinline__ int crow(int r, int hi) { return (r & 3) + 8 * (r >> 2) + 4 * hi; }
__device__ __forceinline__ unsigned cvtpk_s(float lo, float hi) { f32x2_t v = {lo, hi}; bf16x2_t b = __builtin_convertvector(v, bf16x2_t); return __builtin_bit_cast(unsigned, b); }
__device__ __forceinline__ float bf2f(short s) { return __uint_as_float(((unsigned)(unsigned short)s) << 16); }
typedef short v4i16_t __attribute__((ext_vector_type(4)));
__device__ __forceinline__ s16x4 vtr(const ALAS unsigned char* p) { return __builtin_bit_cast(s16x4, __builtin_amdgcn_ds_read_tr16_b64_v4i16((ALAS v4i16_t*)p)); }
__device__ __forceinline__ void pv(f32x16* o, const ALAS unsigned char* vp, bf16x8 pa0, bf16x8 pa1, bf16x8 pa2, bf16x8 pa3) {
#pragma unroll
    for (int d0 = 0; d0 < 2; ++d0) { s16x4 lo[4], hi[4];
#pragma unroll
        for (int ks = 0; ks < 4; ++ks) { lo[ks] = vtr(vp + d0 * 4096 + ks * 1024); hi[ks] = vtr(vp + d0 * 4096 + ks * 1024 + 512); }
#define PK(k) (bf16x8){lo[k][0], lo[k][1], lo[k][2], lo[k][3], hi[k][0], hi[k][1], hi[k][2], hi[k][3]}
        o[d0] = __builtin_amdgcn_mfma_f32_32x32x16_bf16(pa0, PK(0), o[d0], 0, 0, 0);
        o[d0] = __builtin_amdgcn_mfma_f32_32x32x16_bf16(pa1, PK(1), o[d0], 0, 0, 0);
        o[d0] = __builtin_amdgcn_mfma_f32_32x32x16_bf16(pa2, PK(2), o[d0], 0, 0, 0);
        o[d0] = __builtin_amdgcn_mfma_f32_32x32x16_bf16(pa3, PK(3), o[d0], 0, 0, 0);
#undef PK
    }
}
__device__ __forceinline__ void wave_unit(const bf16* Qp, bf16* Op, const bf16* Kp, const bf16* Vp, const float* ckl, int qpos0, float kmaxn, ALAS unsigned char* wl, int lane) {
    const int r32 = lane & 31, hi = lane >> 5;
    ALAS unsigned char* vt = wl; ALAS bf16* stg = (ALAS bf16*)(wl + 8192); ALAS float* wsf = (ALAS float*)(wl + 8192 + 4096);
    const ALAS unsigned char* vp = vt + ((lane >> 4) & 1) * 32 + (lane & 3) * 8 + (4 * hi + ((lane & 15) >> 2)) * 64;
    bf16x8 qr[4];
#pragma unroll
    for (int d0 = 0; d0 < 4; ++d0) qr[d0] = *(const bf16x8*)(Qp + (size_t)r32 * 1024 + d0 * 16 + hi * 8);
    float qn2 = 0.f;
#pragma unroll
    for (int d0 = 0; d0 < 4; ++d0)
#pragma unroll
        for (int e = 0; e < 8; ++e) { const float v = bf2f(qr[d0][e]); qn2 += v * v; }
    qn2 += __shfl_xor(qn2, 32);
    const float qkb = __builtin_amdgcn_sqrtf(qn2) * kmaxn * 1.03f + 1.0f;
    const float cq = ckl[qpos0 + r32];
    float mref = 0.f, l = 0.f; f32x16 o[2]; o[0] = f32x16{}; o[1] = f32x16{};
    const int jd = (qpos0 + 31) >> 6;
    bf16x8 kf[8]; f32x4 bpre;
    ALAS float* bl = (ALAS float*)(wl + 8192 + 4096 + 256);
#define ATT_LOADK(JT) do { const bf16* kp_ = Kp + (size_t)(64 * (JT) + r32) * 1024 + hi * 8; \
        _Pragma("unroll") for (int d0 = 0; d0 < 4; ++d0) { kf[2 * d0] = *(const bf16x8*)(kp_ + d0 * 16); kf[2 * d0 + 1] = *(const bf16x8*)(kp_ + 32 * 1024 + d0 * 16); } \
        bpre = *(const f32x4*)(ckl + 64 * (JT) + 4 * (lane & 15)); } while (0)
#define ATT_LOADV(JT) do { _Pragma("unroll") for (int w = 0; w < 8; ++w) __builtin_amdgcn_global_load_lds((const unsigned*)(Vp + (size_t)(64 * (JT) + 16 * (w & 3) + (lane >> 2)) * 1024 + 32 * (w >> 2) + 8 * (lane & 3)), \
        (ALAS unsigned*)(vt + w * 1024), 16, 0, 0); } while (0)
    ATT_LOADK(jd); ATT_LOADV(jd);
    for (int j = jd; j >= 0; --j) {
        const int s0 = 64 * j;
        f32x16 p0, p1; const float base = cq - mref;
        if (lane < 16) *(ALAS f32x4*)(bl + 4 * lane) = bpre;
#pragma unroll
        for (int jj = 0; jj < 4; ++jj) { const f32x4 a = *(const ALAS f32x4*)(bl + 8 * jj + 4 * hi), b = *(const ALAS f32x4*)(bl + 32 + 8 * jj + 4 * hi);
#pragma unroll
            for (int e = 0; e < 4; ++e) { p0[4 * jj + e] = base - a[e]; p1[4 * jj + e] = base - b[e]; } }
#pragma unroll
        for (int d0 = 0; d0 < 4; ++d0) { p0 = __builtin_amdgcn_mfma_f32_32x32x16_bf16(kf[2 * d0], qr[d0], p0, 0, 0, 0); p1 = __builtin_amdgcn_mfma_f32_32x32x16_bf16(kf[2 * d0 + 1], qr[d0], p1, 0, 0, 0); }
        if (j > 0) ATT_LOADK(j - 1);
        if (j == jd) { const int qp = qpos0 + r32;
#pragma unroll
            for (int r = 0; r < 16; ++r) { const int kv = s0 + crow(r, hi); if (kv > qp) p0[r] = -INFINITY; if (kv + 32 > qp) p1[r] = -INFINITY; } }
        float rm;
        { float a = fmaxf(p0[0], p1[0]);
#pragma unroll
          for (int r = 1; r < 16; ++r) a = fmaxf(a, fmaxf(p0[r], p1[r]));
          rm = fmaxf(a, __shfl_xor(a, 32)); }
        if (j == jd) {
            mref = rm;
#pragma unroll
            for (int r = 0; r < 16; ++r) { p0[r] -= rm; p1[r] -= rm; }
        } else if (__any(rm > 0.f)) {
            const float dl = fmaxf(rm, 0.f); mref += dl;
#pragma unroll
            for (int r = 0; r < 16; ++r) { p0[r] -= dl; p1[r] -= dl; }
            const float f = __builtin_amdgcn_exp2f(-dl); l *= f; if (hi == 0) wsf[r32] = f;
            asm volatile("s_waitcnt lgkmcnt(0)" ::: "memory");
#pragma unroll
            for (int d_ = 0; d_ < 2; ++d_)
#pragma unroll
                for (int r = 0; r < 16; ++r) o[d_][r] *= wsf[crow(r, hi)];
        }
        float sacc = 0.f;
#pragma unroll
        for (int r = 0; r < 16; ++r) { p0[r] = __builtin_amdgcn_exp2f(p0[r]); p1[r] = __builtin_amdgcn_exp2f(p1[r]); sacc += p0[r] + p1[r]; }
        l += sacc;
        u32x4 pw0, pw1, pw2, pw3;
        pw0 = (u32x4){cvtpk_s(p0[0], p0[1]), cvtpk_s(p0[2], p0[3]), cvtpk_s(p0[4], p0[5]), cvtpk_s(p0[6], p0[7])};
        pw1 = (u32x4){cvtpk_s(p0[8], p0[9]), cvtpk_s(p0[10], p0[11]), cvtpk_s(p0[12], p0[13]), cvtpk_s(p0[14], p0[15])};
        pw2 = (u32x4){cvtpk_s(p1[0], p1[1]), cvtpk_s(p1[2], p1[3]), cvtpk_s(p1[4], p1[5]), cvtpk_s(p1[6], p1[7])};
        pw3 = (u32x4){cvtpk_s(p1[8], p1[9]), cvtpk_s(p1[10], p1[11]), cvtpk_s(p1[12], p1[13]), cvtpk_s(p1[14], p1[15])};
        if (j > 0) asm volatile("s_waitcnt vmcnt(9)" ::: "memory"); else asm volatile("s_waitcnt vmcnt(0)" ::: "memory");
        pv(o, vp, __builtin_bit_cast(bf16x8, pw0), __builtin_bit_cast(bf16x8, pw1), __builtin_bit_cast(bf16x8, pw2), __builtin_bit_cast(bf16x8, pw3));
        asm volatile("s_waitcnt lgkmcnt(0)" ::: "memory");
#if ATT_EARLY_EXIT
        if (j > 0) { const float cl = __uint_as_float(__builtin_amdgcn_readlane(__float_as_uint(bpre[3]), 15));
            const float ub = qkb + (cq - cl) - mref; if (!__any(ub > ATT_EXIT_LOG2)) break; }
#endif
        if (j > 0) ATT_LOADV(j - 1);
    }
    l += __shfl_xor(l, 32);
    if (hi == 0) wsf[32 + r32] = l;
    asm volatile("s_waitcnt lgkmcnt(0)" ::: "memory");
    float rli[16];
#pragma unroll
    for (int r = 0; r < 16; ++r) rli[r] = 1.0f / wsf[32 + crow(r, hi)];
#pragma unroll
    for (int r = 0; r < 16; ++r) { const int orow = crow(r, hi);
#pragma unroll
        for (int d0 = 0; d0 < 2; ++d0) { const unsigned w = cvtpk_s(o[d0][r] * rli[r], 0.f); stg[orow * 64 + d0 * 32 + r32] = (bf16)(w & 0xffffu); } }
    asm volatile("s_waitcnt lgkmcnt(0)" ::: "memory");
#pragma unroll
    for (int i = 0; i < 4; ++i) { const int row = i * 8 + (lane >> 3), ch = lane & 7; const u32x4 v = *(const ALAS u32x4*)(stg + row * 64 + ch * 8); *(u32x4*)(Op + (size_t)row * 1024 + ch * 8) = v; }
    asm volatile("s_waitcnt lgkmcnt(0)" ::: "memory");
}

constexpr int G_K = 0, G_V = 16384, G_PW = 32768, G_PWB = 4096 + 256 + 256, G_FLAG = G_PW + 8 * G_PWB, G_BYTES = G_FLAG + 64;
__device__ __forceinline__ void wg_unit(const bf16* Qb, bf16* Ob, const bf16* Kp, const bf16* Vp, const float* ckl, int qbase, int nact, float kmaxn, ALAS unsigned char* L, int wave, int lane) {
    const int r32 = lane & 31, hi = lane >> 5;
    ALAS unsigned char* pw = L + G_PW + wave * G_PWB;
    ALAS bf16* stg = (ALAS bf16*)pw; ALAS float* wsf = (ALAS float*)(pw + 4096); ALAS float* bl = (ALAS float*)(pw + 4096 + 256);
    ALAS unsigned* flags = (ALAS unsigned*)(L + G_FLAG);
    const bool active = wave < nact;
    const int qpos0 = qbase + 32 * wave, jd = (qpos0 + 31) >> 6, jmax = (qbase + 32 * nact - 1) >> 6;
    __syncthreads();
    if (threadIdx.x < 16) flags[threadIdx.x] = 0u;
    const ALAS unsigned char* vpo = L + G_V + ((lane >> 4) & 1) * 32 + (lane & 3) * 8 + (4 * hi + ((lane & 15) >> 2)) * 64;
#define WG_DMA(JT) do { const int sl_ = ((JT) & 1) * 8192; \
        __builtin_amdgcn_global_load_lds((const unsigned*)(Kp + (size_t)(64 * (JT) + lane) * 1024 + 8 * wave), (ALAS unsigned*)(L + G_K + sl_ + wave * 1024), 16, 0, 0); \
        __builtin_amdgcn_global_load_lds((const unsigned*)(Vp + (size_t)(64 * (JT) + 16 * (wave & 3) + (lane >> 2)) * 1024 + 32 * (wave >> 2) + 8 * (lane & 3)), (ALAS unsigned*)(L + G_V + sl_ + wave * 1024), 16, 0, 0); } while (0)
    WG_DMA(jmax);
    bf16x8 qr[4]; float qkb = 0.f, cq = 0.f;
    if (active) {
#pragma unroll
        for (int d0 = 0; d0 < 4; ++d0) qr[d0] = *(const bf16x8*)(Qb + (size_t)(32 * wave + r32) * 1024 + d0 * 16 + hi * 8);
        float qn2 = 0.f;
#pragma unroll
        for (int d0 = 0; d0 < 4; ++d0)
#pragma unroll
            for (int e = 0; e < 8; ++e) { const float v = bf2f(qr[d0][e]); qn2 += v * v; }
        qn2 += __shfl_xor(qn2, 32);
        qkb = __builtin_amdgcn_sqrtf(qn2) * kmaxn * 1.03f + 1.0f;
        cq = ckl[qpos0 + r32];
    } else {
#pragma unroll
        for (int d0 = 0; d0 < 4; ++d0) qr[d0] = bf16x8{};
    }
    float mref = 0.f, l = 0.f; f32x16 o[2]; o[0] = f32x16{}; o[1] = f32x16{};
    f32x4 bpre = *(const f32x4*)(ckl + 64 * jmax + 4 * (lane & 15));
    bool done = false;
    for (int j = jmax; j >= 0; --j) {
        asm volatile("s_waitcnt vmcnt(0)" ::: "memory");
        __syncthreads();
        { unsigned nd = 0;
#pragma unroll
          for (int w = 0; w < 8; ++w) nd += (w < nact) ? flags[((j + 1) & 1) * 8 + w] : 0u;
          if (nd >= (unsigned)nact) break; }
        if (j > 0) WG_DMA(j - 1);
        const f32x4 bcur = bpre;
        if (j > 0) bpre = *(const f32x4*)(ckl + 64 * (j - 1) + 4 * (lane & 15));
        if (active && !done && j <= jd) {
            const ALAS unsigned char* ks = L + G_K + (j & 1) * 8192 + hi * 1024 + r32 * 16;
            f32x16 p0, p1; const float base = cq - mref;
            if (lane < 16) *(ALAS f32x4*)(bl + 4 * lane) = bcur;
            { f32x4 qa[4], qb[4];
#pragma unroll
              for (int jj = 0; jj < 4; ++jj) { qa[jj] = base - *(const ALAS f32x4*)(bl + 8 * jj + 4 * hi); qb[jj] = base - *(const ALAS f32x4*)(bl + 32 + 8 * jj + 4 * hi); }
              p0 = (f32x16){qa[0][0], qa[0][1], qa[0][2], qa[0][3], qa[1][0], qa[1][1], qa[1][2], qa[1][3], qa[2][0], qa[2][1], qa[2][2], qa[2][3], qa[3][0], qa[3][1], qa[3][2], qa[3][3]};
              p1 = (f32x16){qb[0][0], qb[0][1], qb[0][2], qb[0][3], qb[1][0], qb[1][1], qb[1][2], qb[1][3], qb[2][0], qb[2][1], qb[2][2], qb[2][3], qb[3][0], qb[3][1], qb[3][2], qb[3][3]}; }
#pragma unroll
            for (int d0 = 0; d0 < 4; ++d0) { const bf16x8 k0 = *(const ALAS bf16x8*)(ks + d0 * 2048), k1 = *(const ALAS bf16x8*)(ks + d0 * 2048 + 512);
                p0 = __builtin_amdgcn_mfma_f32_32x32x16_bf16(k0, qr[d0], p0, 0, 0, 0); p1 = __builtin_amdgcn_mfma_f32_32x32x16_bf16(k1, qr[d0], p1, 0, 0, 0); }
            if (j == jd) { const int qp = qpos0 + r32, s0 = 64 * j;
#pragma unroll
                for (int r = 0; r < 16; ++r) { const int kv = s0 + crow(r, hi); if (kv > qp) p0[r] = -INFINITY; if (kv + 32 > qp) p1[r] = -INFINITY; } }
            float rm;
            { float a = fmaxf(p0[0], p1[0]);
#pragma unroll
              for (int r = 1; r < 16; ++r) a = fmaxf(a, fmaxf(p0[r], p1[r]));
              rm = fmaxf(a, __shfl_xor(a, 32)); }
            if (j == jd) {
                mref = rm;
#pragma unroll
                for (int r = 0; r < 16; ++r) { p0[r] -= rm; p1[r] -= rm; }
            } else if (__any(rm > 0.f)) {
                const float dl = fmaxf(rm, 0.f); mref += dl;
#pragma unroll
                for (int r = 0; r < 16; ++r) { p0[r] -= dl; p1[r] -= dl; }
                const float f = __builtin_amdgcn_exp2f(-dl); l *= f; if (hi == 0) wsf[r32] = f;
                asm volatile("s_waitcnt lgkmcnt(0)" ::: "memory");
#pragma unroll
                for (int d_ = 0; d_ < 2; ++d_)
#pragma unroll
                    for (int r = 0; r < 16; ++r) o[d_][r] *= wsf[crow(r, hi)];
            }
#pragma unroll
            for (int r = 0; r < 16; ++r) { p0[r] = __builtin_amdgcn_exp2f(p0[r]); p1[r] = __builtin_amdgcn_exp2f(p1[r]); }
            { const f32x16 ps = p0 + p1;
              const f32x4 s4 = ((f32x4){ps[0], ps[1], ps[2], ps[3]} + (f32x4){ps[4], ps[5], ps[6], ps[7]}) + ((f32x4){ps[8], ps[9], ps[10], ps[11]} + (f32x4){ps[12], ps[13], ps[14], ps[15]});
              l += (s4[0] + s4[1]) + (s4[2] + s4[3]); }
            u32x4 pw0, pw1, pw2, pw3;
            pw0 = (u32x4){cvtpk_s(p0[0], p0[1]), cvtpk_s(p0[2], p0[3]), cvtpk_s(p0[4], p0[5]), cvtpk_s(p0[6], p0[7])};
            pw1 = (u32x4){cvtpk_s(p0[8], p0[9]), cvtpk_s(p0[10], p0[11]), cvtpk_s(p0[12], p0[13]), cvtpk_s(p0[14], p0[15])};
            pw2 = (u32x4){cvtpk_s(p1[0], p1[1]), cvtpk_s(p1[2], p1[3]), cvtpk_s(p1[4], p1[5]), cvtpk_s(p1[6], p1[7])};
            pw3 = (u32x4){cvtpk_s(p1[8], p1[9]), cvtpk_s(p1[10], p1[11]), cvtpk_s(p1[12], p1[13]), cvtpk_s(p1[14], p1[15])};
            pv(o, vpo + (j & 1) * 8192, __builtin_bit_cast(bf16x8, pw0), __builtin_bit_cast(bf16x8, pw1), __builtin_bit_cast(bf16x8, pw2), __builtin_bit_cast(bf16x8, pw3));
            if (j == 0) done = true;
            else { const float cl = __uint_as_float(__builtin_amdgcn_readlane(__float_as_uint(bpre[3]), 15));
                const float ub = qkb + (cq - cl) - mref; if (!__any(ub > ATT_EXIT_LOG2)) done = true; }
        }
        if (lane == 0) flags[(j & 1) * 8 + wave] = done ? 1u : 0u;
        asm volatile("s_waitcnt lgkmcnt(0)" ::: "memory");
    }
    if (active) {
        l += __shfl_xor(l, 32);
        if (hi == 0) wsf[32 + r32] = l;
        asm volatile("s_waitcnt lgkmcnt(0)" ::: "memory");
        float rli[16];
#pragma unroll
        for (int r = 0; r < 16; ++r) rli[r] = 1.0f / wsf[32 + crow(r, hi)];
#pragma unroll
        for (int r = 0; r < 16; ++r) { const int orow = crow(r, hi);
#pragma unroll
            for (int d0 = 0; d0 < 2; ++d0) { const unsigned w = cvtpk_s(o[d0][r] * rli[r], 0.f); stg[orow * 64 + d0 * 32 + r32] = (bf16)(w & 0xffffu); } }
        asm volatile("s_waitcnt lgkmcnt(0)" ::: "memory");
        bf16* Op = Ob + (size_t)(32 * wave) * 1024;
#pragma unroll
        for (int i = 0; i < 4; ++i) { const int row = i * 8 + (lane >> 3), ch = lane & 7; const u32x4 v = *(const ALAS u32x4*)(stg + row * 64 + ch * 8); *(u32x4*)(Op + (size_t)row * 1024 + ch * 8) = v; }
        asm volatile("s_waitcnt lgkmcnt(0)" ::: "memory");
    }
#undef WG_DMA
}
#undef ATT_LOADK
#undef ATT_LOADV
}

constexpr int NWAVES = 8;
constexpr int DM = 1024, FF = 2816, NH = 16;
constexpr int MP = 16384, MS = 512, M = MP + MS;
constexpr int TP = 8192, TS = 64, PAST = 2048, TKS = PAST + TS;
constexpr float C2 = 0.125f * 1.4426950408889634f;
constexpr float LOG2E = 1.4426950408889634f;
#ifndef MK_N_LAUNCHES
#define MK_N_LAUNCHES 1
#endif
constexpr int NPHASE = 15;
#ifndef PROBE_P0_REPS
#define PROBE_P0_REPS 1
#endif
#ifndef PROBE_P3_REPS
#define PROBE_P3_REPS 1
#endif
#ifndef PROBE_P1_REPS
#define PROBE_P1_REPS 1
#endif
#ifndef PROBE_P2_REPS
#define PROBE_P2_REPS 1
#endif
#ifndef PROBE_P9_REPS
#define PROBE_P9_REPS 1
#endif
#ifndef PROBE_P7_REPS
#define PROBE_P7_REPS 1
#endif
#ifndef USE_XCD_BAR
#define USE_XCD_BAR 1
#endif
#ifndef RUNTIME_DELAY
#define RUNTIME_DELAY 0
#endif
#ifndef RUNTIME_USE_CG
#define RUNTIME_USE_CG 0
#endif
#ifndef PROBE_ATT_REPS
#define PROBE_ATT_REPS 1
#endif
constexpr size_t OFF_Y = 0, OFF_POOLP = 17301504, OFF_POOLS = 17332224, OFF_LFP = 51009536, OFF_LFS = 52320256, OUT_TOTAL = 52328448;
constexpr size_t MiB = 1u << 20;
constexpr size_t WS_BAR = 65536, WS_CNT = 131072;
constexpr size_t WS_KMX = 0, WS_SS = 1 * MiB, WS_CKLP = 3 * MiB, WS_CKLS = 4 * MiB, WS_WFG = 6 * MiB, WS_WPOOL = 7 * MiB;
constexpr size_t WS_WKVIN = 8 * MiB  , WS_WIN00 = 23 * MiB, WS_WIN01 = 34 * MiB, WS_WIN11 = 45 * MiB, WS_WOUT = 56 * MiB  ;
constexpr size_t WOUT_BYTES = (size_t)DM * FF * 2;
constexpr size_t WS_WQ = 78 * MiB, WS_WO = 80 * MiB, WS_XB = 82 * MiB, WS_ACT = 115 * MiB, WS_QO = WS_ACT, WS_DP = WS_ACT + 33 * MiB;
constexpr size_t WS_KB = 206 * MiB, WS_VB = 238 * MiB, WS_KS = 270 * MiB, WS_VS = 303 * MiB, WS_END = 336 * MiB;
static_assert(WS_WOUT + 4 * WOUT_BYTES <= WS_WQ && WS_XB + (size_t)M * DM * 2 <= WS_ACT && WS_ACT + (size_t)M * FF * 2 <= WS_KB && WS_DP + (size_t)M * DM * 2 <= WS_KB, "ws map");
static_assert(WS_KS + (size_t)8 * TKS * DM * 2 <= WS_VS && WS_VS + (size_t)8 * TKS * DM * 2 <= WS_END && WS_CKLS + (size_t)8 * 16 * TKS * 4 <= WS_WFG, "ws map 2");
constexpr int RING_BYTES = 131072, LDS_BYTES = 147456;

#define LAS __attribute__((address_space(3)))
typedef unsigned short bf16;
typedef unsigned v4u __attribute__((ext_vector_type(4)));
typedef unsigned v2u __attribute__((ext_vector_type(2)));
typedef float f32x4 __attribute__((ext_vector_type(4)));
typedef float f32x2 __attribute__((ext_vector_type(2)));
typedef short bf16x8 __attribute__((ext_vector_type(8)));
#define LDS_WAIT() asm volatile("s_waitcnt lgkmcnt(0)" ::: "memory")
__device__ __forceinline__ unsigned pk2(float lo, float hi) { return pg8::cvt_pk_bf16(lo, hi); }
__device__ __forceinline__ float wave_sum(float v) {
#pragma unroll
    for (int o = 1; o < 64; o <<= 1) v += __shfl_xor(v, o);
    return v;
}
__device__ __forceinline__ void tr_item(const float* W, int K, int N, bf16* WT, int k0, int n0, int drow0, const float* gain, int lane) {
    const int kg = lane >> 3, nl = lane & 7;
    const float* src = W + (size_t)(k0 + 8 * kg) * N + n0 + 4 * nl;
    f32x4 v[8];
#pragma unroll
    for (int i = 0; i < 8; ++i) v[i] = __builtin_nontemporal_load((const f32x4*)(src + (size_t)i * N));
    if (gain) { const f32x4 g0 = *(const f32x4*)(gain + k0 + 8 * kg), g1 = *(const f32x4*)(gain + k0 + 8 * kg + 4);
#pragma unroll
        for (int i = 0; i < 4; ++i) { v[i] = v[i] * g0[i]; v[4 + i] = v[4 + i] * g1[i]; } }
#pragma unroll
    for (int e = 0; e < 4; ++e) { v4u o; o.x = pk2(v[0][e], v[1][e]); o.y = pk2(v[2][e], v[3][e]); o.z = pk2(v[4][e], v[5][e]); o.w = pk2(v[6][e], v[7][e]);
        *(v4u*)(WT + (size_t)(drow0 + 4 * nl + e) * K + k0 + 8 * kg) = o; }
}
template <int W> __device__ __forceinline__ void pool_emit(const f32x4 (&u)[31], int posbase, int t0, bf16* dst  ) {
#pragma unroll
    for (int i = 0; i < 16; ++i) {
        f32x4 s = {0.f, 0.f, 0.f, 0.f};
#pragma unroll
        for (int j = W - 1; j >= 0; --j) s += u[15 + i - j];
        const int pos = posbase + t0 + i; const float cnt = (float)(pos + 1 < W ? pos + 1 : W);
        const f32x4 d = s / cnt - u[15 + i];
        v2u w; w.x = pk2(d[0], d[1]); w.y = pk2(d[2], d[3]);
        *(v2u*)(dst + (size_t)i * 256) = w;
    }
}

#define XB_TMO      128
#define XB_XCNT(j)  (256  + 64 * (j))
#define XB_XSUB(j)  (1280 + 64 * (j))
#define XB_XGEN(j)  (2304 + 64 * (j))
#define XB_TOP      3328
#define XB_TOPGEN   3392
#define XCD_BAR_WORDS 3456
#define XB_SPIN_CAP (1u << 18)

__device__ __forceinline__ unsigned xb_ld(unsigned* p)              { return __hip_atomic_load(p, __ATOMIC_RELAXED, __HIP_MEMORY_SCOPE_AGENT); }
__device__ __forceinline__ unsigned xb_add(unsigned* p, unsigned v) { return __hip_atomic_fetch_add(p, v, __ATOMIC_RELAXED, __HIP_MEMORY_SCOPE_AGENT); }
__device__ __forceinline__ unsigned xb_xcc_id() { return (unsigned)__builtin_amdgcn_s_getreg((3 << 11) | 20) & 0xFu; }
#define XB_SPIN(cond, bar) do { unsigned _sp = 0; while (cond) { __builtin_amdgcn_s_sleep(1); \
    if ((++_sp & 255u) == 0u) { if (xb_ld(&(bar)[XB_TMO])) break; if (_sp > XB_SPIN_CAP) { atomicAdd(&(bar)[XB_TMO], 1u); break; } } } } while (0)

struct XcdBarrier {
    unsigned* bar; unsigned x;
    volatile LAS unsigned* st;
};

__device__ __forceinline__ XcdBarrier xcd_barrier_post(unsigned* bar, volatile LAS unsigned* st) {
    XcdBarrier b; b.bar = bar; b.x = xb_xcc_id(); b.st = st;
    if (threadIdx.x == 0) (void)xb_add(&bar[XB_XCNT(b.x)], 1u);
    return b;
}
__device__ __forceinline__ void xcd_barrier_complete(unsigned* bar, unsigned x, unsigned& nloc, unsigned& nx) {
    const unsigned G = gridDim.x * gridDim.y * gridDim.z;
    unsigned sum, cnt, mine, sp = 0u;
    for (;;) {
        sum = 0u; cnt = 0u; mine = 0u;
#pragma unroll
        for (unsigned j = 0; j < 16; ++j) { const unsigned c = xb_ld(&bar[XB_XCNT(j)]); sum += c; cnt += (c > 0u) ? 1u : 0u; mine = (j == x) ? c : mine; }
        if (sum == G) break;
        __builtin_amdgcn_s_sleep(1);
        if ((++sp & 255u) == 0u) { if (xb_ld(&bar[XB_TMO])) break; if (sp > XB_SPIN_CAP) { atomicAdd(&bar[XB_TMO], 1u); break; } }
    }
    nloc = mine > 0u ? mine : 1u; nx = cnt > 0u ? cnt : 1u;
}

__device__ __forceinline__ void xcd_barrier(const XcdBarrier& b) {
    asm volatile("s_waitcnt vmcnt(0)" ::: "memory");
    __syncthreads();
    if (threadIdx.x == 0) {
        unsigned* bar = b.bar;
        __builtin_amdgcn_s_waitcnt(0);
        unsigned nloc = b.st[0], nx = b.st[1];
        if (nloc == 0u) { xcd_barrier_complete(bar, b.x, nloc, nx); b.st[0] = nloc; b.st[1] = nx; }
        const unsigned old = xb_add(&bar[XB_XSUB(b.x)], 1u);
        const unsigned gen = old / nloc;
        if (old + 1u == (gen + 1u) * nloc) {
            __builtin_amdgcn_fence(__ATOMIC_RELEASE, "agent");
            asm volatile("s_waitcnt vmcnt(0)" ::: "memory");
            const unsigned og = xb_add(&bar[XB_TOP], 1u);
            const unsigned tg = og / nx;
            if (og + 1u == (tg + 1u) * nx) xb_add(&bar[XB_TOPGEN], 1u);
            else XB_SPIN(xb_ld(&bar[XB_TOPGEN]) == tg, bar);
            __builtin_amdgcn_fence(__ATOMIC_ACQUIRE, "agent");
            xb_add(&bar[XB_XGEN(b.x)], 1u);
            asm volatile("s_waitcnt vmcnt(0)" ::: "memory");
        } else {
            XB_SPIN(xb_ld(&bar[XB_XGEN(b.x)]) == gen, bar);
            __builtin_amdgcn_fence(__ATOMIC_ACQUIRE, "agent");
            asm volatile("s_waitcnt vmcnt(0)" ::: "memory");
        }
    }
    __syncthreads();
}
#define GB_SUB(g) (64 * (g))
#define GB_GEN(g) (512 + 64 * (g))
#define GB_TOP 1024
#define GB_TOPGEN 1088
__device__ __forceinline__ void grp_barrier(unsigned* gb, int delay) {
    asm volatile("s_waitcnt vmcnt(0)" ::: "memory");
    __syncthreads();
    if (threadIdx.x == 0) {
        __builtin_amdgcn_fence(__ATOMIC_RELEASE, "agent");
        asm volatile("s_waitcnt vmcnt(0)" ::: "memory");
        for (int d_ = 0; d_ < delay; ++d_) __builtin_amdgcn_s_sleep(16);
        const unsigned g = blockIdx.x & 7u, nloc = gridDim.x >> 3;
        const unsigned old = xb_add(&gb[GB_SUB(g)], 1u), gen = old / nloc;
        if (old + 1u == (gen + 1u) * nloc) {
            const unsigned og = xb_add(&gb[GB_TOP], 1u), tg = og >> 3;
            if (og + 1u == (tg + 1u) * 8u) xb_add(&gb[GB_TOPGEN], 1u);
            else { unsigned sp = 0; while (xb_ld(&gb[GB_TOPGEN]) == tg) { __builtin_amdgcn_s_sleep(1); if (++sp > (1u << 24)) break; } }
            xb_add(&gb[GB_GEN(g)], 1u);
        } else { unsigned sp = 0; while (xb_ld(&gb[GB_GEN(g)]) == gen) { __builtin_amdgcn_s_sleep(1); if (++sp > (1u << 24)) break; } }
        __builtin_amdgcn_fence(__ATOMIC_ACQUIRE, "agent");
        asm volatile("s_waitcnt vmcnt(0)" ::: "memory");
    }
    __syncthreads();
}
struct Args { const float* in[20]; float* out; unsigned char* ws; int ph_lo, ph_hi, use_cg, pad; };

__global__ void __launch_bounds__(NWAVES * 64, 2) mega_fwd(Args args) {
    extern __shared__ __attribute__((aligned(16))) unsigned char lds_raw[];
    cg::grid_group grid = cg::this_grid();
    LAS unsigned char* lds = (LAS unsigned char*)lds_raw;
    const int tid = threadIdx.x, lane = tid & 63, wave = __builtin_amdgcn_readfirstlane(tid >> 6);
    const int G = gridDim.x, bx = blockIdx.x;
    const int gw = bx * NWAVES + wave, NGW = G * NWAVES;
    unsigned char* ws = args.ws; float* dout = args.out;
    const float* x_prompt = args.in[0]; const float* x_sample = args.in[1]; const float* cache_pool = args.in[2];
    const float* cache_k = args.in[3]; const float* cache_v = args.in[4]; const float* cache_logf = args.in[5];
    const float* ln_ffn1 = args.in[6]; const float* ln_mix = args.in[7]; const float* ln_ffn2 = args.in[8];
    const float* w_ffn_in = args.in[9]; const float* w_ffn_out = args.in[10]; const float* w_pool = args.in[11]; const float* pool_scale = args.in[12];
    const float* ln_kv = args.in[13]; const float* w_kv = args.in[14]; const float* w_fgate = args.in[15]; const float* b_fgate = args.in[16];
    const float* w_q = args.in[17]; const float* w_o = args.in[18]; const float* ln_final = args.in[19];
    unsigned* KMX = (unsigned*)(ws + WS_KMX); float* SS = (float*)(ws + WS_SS); float* CKLP = (float*)(ws + WS_CKLP); float* CKLS = (float*)(ws + WS_CKLS);
    bf16* WFG = (bf16*)(ws + WS_WFG); bf16* WPOOL = (bf16*)(ws + WS_WPOOL); bf16* WKVIN = (bf16*)(ws + WS_WKVIN);
    bf16* WIN00 = (bf16*)(ws + WS_WIN00); bf16* WIN01 = (bf16*)(ws + WS_WIN01); bf16* WIN11 = (bf16*)(ws + WS_WIN11);
    bf16* WQ = (bf16*)(ws + WS_WQ); bf16* WO = (bf16*)(ws + WS_WO); bf16* XB = (bf16*)(ws + WS_XB); bf16* ACT = (bf16*)(ws + WS_ACT); bf16* QO = (bf16*)(ws + WS_QO); bf16* DP = (bf16*)(ws + WS_DP); bf16* OB = DP;
    bf16* KB = (bf16*)(ws + WS_KB); bf16* VB = (bf16*)(ws + WS_VB); bf16* KS = (bf16*)(ws + WS_KS); bf16* VS = (bf16*)(ws + WS_VS);
    float* X32 = dout + OFF_Y;
    const int lo = args.ph_lo, hi = args.ph_hi;
#define IN(k) (lo <= (k) && (k) < hi)
    volatile LAS unsigned* MISC = (volatile LAS unsigned*)(lds + LDS_BYTES - 256);
    LAS unsigned* LCNT = (LAS unsigned*)(lds + LDS_BYTES - 1024);
    if (tid < 32) MISC[tid] = 0u;
    if (tid == 32) *LCNT = 0u;
    __syncthreads();
    unsigned* barw = (unsigned*)(ws + WS_BAR); unsigned* CNT = (unsigned*)(ws + WS_CNT);
    XcdBarrier bar; bar.bar = barw; bar.x = 0; bar.st = nullptr;
#define SEAM(k) do { if (IN(k) && IN((k) + 1)) { if ((k) == lo) { grid.sync(); bar = xcd_barrier_post(barw, MISC + 8); } else xcd_barrier(bar); } } while (0)
#define GEMM_PHASE(EPI, E, Aptr, Bptr, Kdim, LDA, PNSTEP, NCOLS) do { pg8::Gemm g_{(const pg8::bf16_t*)(Aptr), (const pg8::bf16_t*)(Bptr), (Kdim), (LDA), (size_t)(PNSTEP)}; \
        pg8::StaticOrder S_; S_.init(M, (NCOLS), G, bx); pg8::gemm_phase<EPI, pg8::StaticOrder, true, true>(lds, g_, S_, E); } while (0)

#define RIDE_PHASE(EPI, E, Bptr, NTILES, SLOT, WOUTP, BASE_LO, BASE_HI, OUT32) do {   \
        { pg8::Gemm g_{(const pg8::bf16_t*)XB, (const pg8::bf16_t*)(Bptr), DM, DM, (size_t)0}; pg8::RideOrder S_; S_.init((NTILES), bx); pg8::gemm_phase<EPI, pg8::RideOrder, true, true>(lds, g_, S_, E); } \
        if (bx >= 248) { const int s_ = bx - 248, pan_ = s_ >> 2; unsigned* cw_ = CNT + 128 * (SLOT) + 64 * pan_; \
            if (tid == 0) { unsigned sp_ = 0; while (__hip_atomic_load(cw_, __ATOMIC_RELAXED, __HIP_MEMORY_SCOPE_AGENT) < (unsigned)(NTILES) * 8u) { __builtin_amdgcn_s_sleep(2); if (++sp_ > (1u << 22)) break; } } \
            __syncthreads(); __builtin_amdgcn_fence(__ATOMIC_ACQUIRE, "agent"); asm volatile("s_waitcnt vmcnt(0)" ::: "memory"); \
            pg8::Gemm g2_{(const pg8::bf16_t*)ACT, (const pg8::bf16_t*)(WOUTP), FF, FF, (size_t)0}; pg8::OneUnit S2_{64 + pan_, s_ & 3}; \
            pg8::EpiRes E2_{(BASE_LO), (BASE_HI), (OUT32), XB, SS, nullptr, 0.5f}; pg8::gemm_phase<pg8::EpiRes, pg8::OneUnit, true, true>(lds, g2_, S2_, E2_); } } while (0)
#define GEMM_PROMPT(EPI, E, Aptr, Bptr, Kdim, LDA, NCOLS) do { pg8::Gemm g_{(const pg8::bf16_t*)(Aptr), (const pg8::bf16_t*)(Bptr), (Kdim), (LDA), (size_t)0}; \
        pg8::StaticOrder S_; S_.init(MP, (NCOLS), G, bx); pg8::gemm_phase<EPI, pg8::StaticOrder, true, true>(lds, g_, S_, E); } while (0)

#define FGATE_ROWS(IT0, IT1, W0, NW) do { \
        const int fr = lane & 15, fq = lane >> 4; \
        for (int it = (IT0) + (W0); it < (IT1); it += (NW)) { \
            const int row = it * 16 + fr; f32x4 acc = {0.f, 0.f, 0.f, 0.f}; \
            const bf16* ap = XB + (size_t)row * DM + 8 * fq; const bf16* bp = WFG + (size_t)fr * DM + 8 * fq; \
_Pragma("unroll 16") \
            for (int ks = 0; ks < 32; ++ks) { const bf16x8 av = *(const bf16x8*)(ap + 32 * ks), bv = *(const bf16x8*)(bp + 32 * ks); acc = __builtin_amdgcn_mfma_f32_16x16x32_bf16(bv, av, acc, 0, 0, 0); } \
            const float rs = pg8::row_rstd(SS, row); const f32x4 bb = *(const f32x4*)(b_fgate + 4 * fq); f32x4 lf; \
_Pragma("unroll") \
            for (int e = 0; e < 4; ++e) { const float z = acc[e] * rs + bb[e]; lf[e] = fminf(z, 0.f) - 0.6931471805599453f * __builtin_amdgcn_logf(1.0f + __builtin_amdgcn_exp2f(-1.4426950408889634f * fabsf(z))); }   \
            float* dp = (row < MP) ? dout + OFF_LFP + (size_t)row * 16 : dout + OFF_LFS + (size_t)(row - MP) * 16; \
            *(f32x4*)(dp + 4 * fq) = lf; \
        } \
    } while (0)

    if (IN(0)) for (int rep0 = 0; rep0 < PROBE_P0_REPS; ++rep0) {
        constexpr int I_IN = 16 * 176, I_OUT = 44 * 32, I_KV = 16 * 64, I_Q = 16 * 32, I_P = 4 * 8;
        constexpr int NITEMS = 4 * I_IN + 4 * I_OUT + I_KV + 2 * I_Q + 4 * I_P;
        for (int it = gw; it < NITEMS; it += NGW) {
            int r = it;
            if (r < 4 * I_IN) { const int f = r / I_IN; r -= f * I_IN; const int kb = r / 176, nb = r % 176, n0 = 32 * nb;
                const int drow = (n0 < FF) ? (n0 >> 7) * 256 + (n0 & 127) : ((n0 - FF) >> 7) * 256 + 128 + ((n0 - FF) & 127);
                bf16* dst = (f == 0) ? WIN00 : (f == 1) ? WIN01 : (f == 2) ? WKVIN + (size_t)2048 * DM : WIN11;
                const float* gain = ((f & 1) ? ln_ffn2 : ln_ffn1) + (f >> 1) * DM;
                tr_item(w_ffn_in + (size_t)f * DM * 2 * FF, DM, 2 * FF, dst, 64 * kb, n0, drow, gain, lane); continue; }
            r -= 4 * I_IN;
            if (r < 4 * I_OUT) { const int f = r / I_OUT; r -= f * I_OUT; const int kb = r / 32, nb = r % 32;
                tr_item(w_ffn_out + (size_t)f * FF * DM, FF, DM, (bf16*)(ws + WS_WOUT + f * WOUT_BYTES), 64 * kb, 32 * nb, 32 * nb, nullptr, lane); continue; }
            r -= 4 * I_OUT;
            if (r < I_KV) { const int kb = r / 64, nb = r % 64; tr_item(w_kv, DM, 2048, WKVIN, 64 * kb, 32 * nb, 32 * nb, ln_kv, lane); continue; }
            r -= I_KV;
            if (r < I_Q) { const int kb = r / 32, nb = r % 32; tr_item(w_q, DM, DM, WQ, 64 * kb, 32 * nb, 32 * nb, ln_mix + DM, lane); continue; }
            r -= I_Q;
            if (r < I_Q) { const int kb = r / 32, nb = r % 32; tr_item(w_o, DM, DM, WO, 64 * kb, 32 * nb, 32 * nb, nullptr, lane); continue; }
            r -= I_Q;
            { const int gq = r / I_P; r -= gq * I_P; const int kb = r / 8, nb = r % 8; tr_item(w_pool + (size_t)gq * 65536, 256, 256, WPOOL, 64 * kb, 32 * nb, gq * 256 + 32 * nb, nullptr, lane); }
        }
        for (int i = bx * 512 + tid; i < 16 * DM; i += G * 512) { const int n = i >> 10, k = i & 1023; WFG[i] = (bf16)(pk2(w_fgate[k * 16 + n] * ln_kv[k], 0.f) & 0xffffu); }
        if (bx == 0) { if (tid < 320) KMX[tid] = 0u; for (int i = tid; i < XCD_BAR_WORDS; i += 512) barw[i] = 0u; CNT[tid] = 0u; }
        for (int m0 = gw; m0 < M; m0 += 2 * NGW) {
            const int m1 = (m0 + NGW < M) ? m0 + NGW : m0;
            const float* xr0 = (m0 < MP) ? x_prompt + (size_t)m0 * DM : x_sample + (size_t)(m0 - MP) * DM;
            const float* xr1 = (m1 < MP) ? x_prompt + (size_t)m1 * DM : x_sample + (size_t)(m1 - MP) * DM;
            const f32x4* xv0 = (const f32x4*)xr0 + lane; const f32x4* xv1 = (const f32x4*)xr1 + lane; f32x4 v0[4], v1[4]; float s0 = 0.f, s1 = 0.f;
#pragma unroll
            for (int j = 0; j < 4; ++j) { v0[j] = __builtin_nontemporal_load(xv0 + 64 * j); v1[j] = __builtin_nontemporal_load(xv1 + 64 * j); }
#pragma unroll
            for (int j = 0; j < 4; ++j) { s0 += (v0[j].x * v0[j].x + v0[j].y * v0[j].y) + (v0[j].z * v0[j].z + v0[j].w * v0[j].w); s1 += (v1[j].x * v1[j].x + v1[j].y * v1[j].y) + (v1[j].z * v1[j].z + v1[j].w * v1[j].w); }
            s0 = wave_sum(s0); s1 = wave_sum(s1);
            v2u* o0 = (v2u*)(XB + (size_t)m0 * DM) + lane; v2u* o1 = (v2u*)(XB + (size_t)m1 * DM) + lane;
#pragma unroll
            for (int j = 0; j < 4; ++j) { v2u w; w.x = pk2(v0[j].x, v0[j].y); w.y = pk2(v0[j].z, v0[j].w); o0[64 * j] = w; w.x = pk2(v1[j].x, v1[j].y); w.y = pk2(v1[j].z, v1[j].w); o1[64 * j] = w; }
            if (lane < 16) { SS[(size_t)m0 * 16 + lane] = (lane == 0) ? s0 : 0.f; SS[(size_t)m1 * 16 + lane] = (lane == 0) ? s1 : 0.f; }
        }
    }
    SEAM(0);
    if (IN(1) && PROBE_P1_REPS > 1) { pg8::EpiSwiglu E{ACT, SS, 0, nullptr, LCNT}; GEMM_PROMPT(pg8::EpiSwiglu, E, XB, WIN00, DM, DM, 2 * FF); }
    if (IN(1)) { pg8::EpiSwiglu E{ACT, SS, 0, CNT + 128 * 0, LCNT}; RIDE_PHASE(pg8::EpiSwiglu, E, WIN00, 22, 0, ws + WS_WOUT, x_prompt, x_sample, (float*)nullptr); }
    SEAM(1);
    if (IN(2) && PROBE_P2_REPS > 1) { pg8::EpiRes E{x_prompt, x_sample, nullptr, XB, SS, nullptr, 0.5f}; GEMM_PROMPT(pg8::EpiRes, E, ACT, ws + WS_WOUT, FF, FF, DM); }
    if (IN(2)) { pg8::EpiRes E{x_prompt, x_sample, nullptr, XB, SS, nullptr, 0.5f}; GEMM_PROMPT(pg8::EpiRes, E, ACT, ws + WS_WOUT, FF, FF, DM); }
    SEAM(2);
    if (IN(3)) for (int rep3 = 0; rep3 < PROBE_P3_REPS; ++rep3) {
        LAS float* rsl = (LAS float*)lds;
        const int hb = tid >> 8, t2 = tid & 255;
        for (int it3 = 0; it3 < 3; ++it3) {
            const int item = 2 * bx + hb + 512 * it3; const bool valid = item < 1024 + 32;
            int sb = 0, ch = 0; if (item < 1024) { sb = item >> 9; ch = item & 511; } else if (valid) { const int r = item - 1024; sb = 2 + (r >> 2); ch = r & 3; }
            const bool prompt = sb < 2; const int T = prompt ? TP : TS, t0 = ch * 16, grow0 = prompt ? sb * TP : MP + (sb - 2) * TS;
            if (valid && t2 < 31) { const int t = t0 - 15 + t2; rsl[hb * 32 + t2] = (t >= 0) ? pg8::row_rstd(SS, grow0 + t) : 0.f; }
            __syncthreads();
            if (valid) {
                const int c = 4 * t2; const f32x4 g4 = *(const f32x4*)(ln_mix + c);
                f32x4 u[31];
#pragma unroll
                for (int i = 0; i < 31; ++i) { const int t = t0 - 15 + i;
                    if (t >= 0) { const v2u xw = *(const v2u*)(XB + (size_t)(grow0 + t) * DM + c); const float rs = rsl[hb * 32 + i];
                        u[i] = (f32x4){__uint_as_float(xw.x << 16), __uint_as_float(xw.x & 0xffff0000u), __uint_as_float(xw.y << 16), __uint_as_float(xw.y & 0xffff0000u)} * rs * g4; }
                    else if (!prompt) u[i] = *(const f32x4*)(cache_pool + (size_t)((sb - 2) * 15 + 15 + t) * DM + c);
                    else u[i] = (f32x4){0.f, 0.f, 0.f, 0.f}; }
                const int gq = c >> 8, posbase = prompt ? 0 : PAST;
                bf16* dst = DP + (size_t)gq * M * 256 + (size_t)(grow0 + t0) * 256 + (c & 255);
                if (gq == 0) pool_emit<2>(u, posbase, t0, dst); else if (gq == 1) pool_emit<4>(u, posbase, t0, dst); else if (gq == 2) pool_emit<8>(u, posbase, t0, dst); else pool_emit<16>(u, posbase, t0, dst);
                float* pout = dout + (prompt ? OFF_POOLP + (size_t)sb * 15 * DM : OFF_POOLS + (size_t)(sb - 2) * 15 * DM);
#pragma unroll
                for (int i = 0; i < 16; ++i) { const int t = t0 + i; if (t >= T - 15) *(f32x4*)(pout + (size_t)(t - (T - 15)) * DM + c) = u[15 + i]; }
            }
            __syncthreads();
        }
    }
    SEAM(3);
    if (IN(4)) { pg8::EpiRes E{nullptr, nullptr, nullptr, XB, SS, pool_scale, 1.0f}; GEMM_PHASE(pg8::EpiRes, E, DP, WPOOL, 256, 256, (size_t)M * 256 * 2, DM); }
    SEAM(4);
    if (IN(5)) { pg8::EpiSwiglu E{ACT, SS, 0, CNT + 128 * 1, LCNT}; RIDE_PHASE(pg8::EpiSwiglu, E, WIN01, 22, 1, ws + WS_WOUT + WOUT_BYTES, (const float*)nullptr, (const float*)nullptr, (float*)nullptr); }
    SEAM(5);
    if (IN(6)) { pg8::EpiRes E{nullptr, nullptr, nullptr, XB, SS, nullptr, 0.5f}; GEMM_PROMPT(pg8::EpiRes, E, ACT, ws + WS_WOUT + WOUT_BYTES, FF, FF, DM);
        FGATE_ROWS(MP / 16, M / 16, gw, NGW); }
    SEAM(6);
    if (IN(7) && PROBE_P7_REPS > 1) { pg8::EpiKVSwiglu E{pg8::EpiKV{dout, KB, VB, KS, VS, SS, KMX, nullptr}, pg8::EpiSwiglu{ACT, SS, 8, nullptr, LCNT}}; GEMM_PROMPT(pg8::EpiKVSwiglu, E, XB, WKVIN, DM, DM, 2048 + 2 * FF); }
    if (IN(7)) {
        pg8::EpiKVSwiglu E{pg8::EpiKV{dout, KB, VB, KS, VS, SS, KMX, CNT + 128 * 2}, pg8::EpiSwiglu{ACT, SS, 8, CNT + 128 * 2, LCNT}};
        RIDE_PHASE(pg8::EpiKVSwiglu, E, WKVIN, 30, 2, ws + WS_WOUT + 2 * WOUT_BYTES, (const float*)nullptr, (const float*)nullptr, (float*)nullptr);
        FGATE_ROWS(0, MP / 16, gw, NGW);
    }
    SEAM(7);
    if (IN(8)) {
        pg8::EpiRes E{nullptr, nullptr, nullptr, XB, SS, nullptr, 0.5f}; GEMM_PROMPT(pg8::EpiRes, E, ACT, ws + WS_WOUT + 2 * WOUT_BYTES, FF, FF, DM);
    }
    SEAM(8);
    if (IN(9)) for (int rep9 = 0; rep9 < PROBE_P9_REPS; ++rep9) { { pg8::EpiQ E{QO, SS, C2}; GEMM_PHASE(pg8::EpiQ, E, XB, WQ, DM, DM, 0, DM); }
        if (bx >= 8 && bx < 246) {
            LAS float* red = (LAS float*)lds;
            for (int ch = bx - 8; ch < 512; ch += 238) {
                const int b = ch >> 6; float mx[4] = {0.f, 0.f, 0.f, 0.f};
                for (int i = 0; i < 4; ++i) {
                    const int r = ch * 32 + wave * 4 + i, s = r & 2047;
                    const f32x4* kx = (const f32x4*)(cache_k + (size_t)r * DM) + lane; const f32x4* vx = (const f32x4*)(cache_v + (size_t)r * DM) + lane;
                    f32x4 kv[4], vv[4];
#pragma unroll
                    for (int j = 0; j < 4; ++j) { kv[j] = __builtin_nontemporal_load(kx + 64 * j); vv[j] = __builtin_nontemporal_load(vx + 64 * j); }
                    v2u* ko = (v2u*)(KS + (size_t)(b * TKS + s) * DM) + lane; v2u* vo = (v2u*)(VS + (size_t)(b * TKS + s) * DM) + lane;
#pragma unroll
                    for (int j = 0; j < 4; ++j) { v2u w; w.x = pk2(kv[j].x, kv[j].y); w.y = pk2(kv[j].z, kv[j].w); ko[64 * j] = w; w.x = pk2(vv[j].x, vv[j].y); w.y = pk2(vv[j].z, vv[j].w); vo[64 * j] = w;
                        float n2 = (kv[j].x * kv[j].x + kv[j].y * kv[j].y) + (kv[j].z * kv[j].z + kv[j].w * kv[j].w); n2 += __shfl_xor(n2, 1); n2 += __shfl_xor(n2, 2); n2 += __shfl_xor(n2, 4);
                        mx[j] = fmaxf(mx[j], n2); }
                }
                if ((lane & 7) == 0) {
#pragma unroll
                    for (int j = 0; j < 4; ++j) red[(wave * 4 + j) * 8 + (lane >> 3)] = mx[j]; }
                __syncthreads();
                if (tid < 32) { float v = red[tid];
#pragma unroll
                    for (int w = 1; w < 8; ++w) v = fmaxf(v, red[w * 32 + tid]);
                    atomicMax(KMX + ((2 + b) * 16 + 4 * (tid >> 3) + ((tid & 7) >> 1)) * 2 + (tid & 1), __float_as_uint(v)); }
                __syncthreads();
            }
        }
        LAS f32x4* part4 = (LAS f32x4*)lds;
        for (int sb = G - 1 - bx; sb < 10; sb += G) {
            const bool prompt = sb < 2; const int b = prompt ? 0 : sb - 2, T = prompt ? TP : TKS, NCH = prompt ? 128 : 66, CH = prompt ? 64 : 32, c = tid >> 2, hq = tid & 3;
            const float* srcA = prompt ? dout + OFF_LFP + (size_t)sb * TP * 16 : cache_logf + (size_t)b * PAST * 16;
            const float* srcB = dout + OFF_LFS + (size_t)b * TS * 16 - (size_t)PAST * 16;
#define LF4_AT(t) (*(const f32x4*)((((prompt) || (t) < PAST) ? srcA : srcB) + (size_t)(t) * 16 + 4 * hq))
            f32x4 s = {0.f, 0.f, 0.f, 0.f};
            if (c < NCH) for (int t0 = c * CH; t0 < (c + 1) * CH; t0 += 16) { f32x4 v[16];
#pragma unroll
                for (int i = 0; i < 16; ++i) v[i] = LF4_AT(t0 + i);
#pragma unroll
                for (int i = 0; i < 16; ++i) s += v[i]; }
            part4[c * 4 + hq] = s; __syncthreads();
            if (c < NCH) {
                f32x4 run = {0.f, 0.f, 0.f, 0.f}; for (int cc = 0; cc < c; ++cc) run += part4[cc * 4 + hq];
                float* dst = (prompt ? CKLP + (size_t)(sb * 16 + 4 * hq) * TP : CKLS + (size_t)(b * 16 + 4 * hq) * TKS);
                for (int t0 = c * CH; t0 < (c + 1) * CH; t0 += 16) { f32x4 v[16];
#pragma unroll
                    for (int i = 0; i < 16; ++i) v[i] = LF4_AT(t0 + i);
#pragma unroll
                    for (int i = 0; i < 16; ++i) { run += v[i]; v[i] = run * LOG2E; }
#pragma unroll
                    for (int e = 0; e < 4; ++e)
#pragma unroll
                        for (int i = 0; i < 4; ++i) *(f32x4*)(dst + (size_t)e * T + t0 + 4 * i) = (f32x4){v[4 * i][e], v[4 * i + 1][e], v[4 * i + 2][e], v[4 * i + 3][e]}; }
            }
#undef LF4_AT
            __syncthreads();
        }
    }
    SEAM(9);
    if (IN(10)) {
        for (int rep = 0; rep < PROBE_ATT_REPS; ++rep)
        for (int gi = bx; gi < 1024 + 128; gi += G) {
            int qrow0, qbase, sb, h, nact; const bf16 *Kp, *Vp; const float* ckl;
            if (gi < 1024) { const int bh = gi >> 5, qb = gi & 31, b = bh >> 4; h = bh & 15; sb = b; qrow0 = b * TP + 256 * qb; qbase = 256 * qb; nact = 8;
                Kp = KB + (size_t)b * TP * DM + h * 64; Vp = VB + (size_t)b * TP * DM + h * 64; ckl = CKLP + (size_t)bh * TP; }
            else { const int bh = gi - 1024, b = bh >> 4; h = bh & 15; sb = 2 + b; qrow0 = MP + b * TS; qbase = PAST; nact = 2;
                Kp = KS + (size_t)b * TKS * DM + h * 64; Vp = VS + (size_t)b * TKS * DM + h * 64; ckl = CKLS + (size_t)bh * TKS; }
            const float kmaxn = __builtin_amdgcn_sqrtf(__uint_as_float(KMX[(sb * 16 + h) * 2]) + __uint_as_float(KMX[(sb * 16 + h) * 2 + 1]));
            att::wg_unit(QO + (size_t)qrow0 * DM + h * 64, OB + (size_t)qrow0 * DM + h * 64, Kp, Vp, ckl, qbase, nact, kmaxn, lds, wave, lane);
        }
        __syncthreads();
    }
    SEAM(10);
    if (IN(11)) { pg8::EpiRes E{nullptr, nullptr, nullptr, XB, SS, nullptr, 1.0f}; GEMM_PHASE(pg8::EpiRes, E, OB, WO, DM, DM, 0, DM); }
    SEAM(11);
    if (IN(12)) { pg8::EpiSwiglu E{ACT, SS, 0, CNT + 128 * 3, LCNT}; RIDE_PHASE(pg8::EpiSwiglu, E, WIN11, 22, 3, ws + WS_WOUT + 3 * WOUT_BYTES, (const float*)nullptr, (const float*)nullptr, (float*)nullptr); }
    SEAM(12);
    if (IN(13)) { pg8::EpiRes E{nullptr, nullptr, nullptr, XB, SS, nullptr, 0.5f}; GEMM_PROMPT(pg8::EpiRes, E, ACT, ws + WS_WOUT + 3 * WOUT_BYTES, FF, FF, DM); }
    SEAM(13);
    if (IN(14)) {
        for (int m0 = gw; m0 < M; m0 += 2 * NGW) {
            const int m1 = (m0 + NGW < M) ? m0 + NGW : m0;
            const v2u* xa = (const v2u*)(XB + (size_t)m0 * DM) + lane; const v2u* xb = (const v2u*)(XB + (size_t)m1 * DM) + lane; const f32x4* gv = (const f32x4*)ln_final + lane;
            v2u wa[4], wb[4];
#pragma unroll
            for (int j = 0; j < 4; ++j) { wa[j] = xa[64 * j]; wb[j] = xb[64 * j]; }
            const float ra = pg8::row_rstd(SS, m0), rb = pg8::row_rstd(SS, m1);
            f32x4* ya = (f32x4*)(X32 + (size_t)m0 * DM) + lane; f32x4* yb = (f32x4*)(X32 + (size_t)m1 * DM) + lane;
#pragma unroll
            for (int j = 0; j < 4; ++j) { const f32x4 g = gv[64 * j];
                __builtin_nontemporal_store((f32x4){__uint_as_float(wa[j].x << 16) * ra * g.x, __uint_as_float(wa[j].x & 0xffff0000u) * ra * g.y, __uint_as_float(wa[j].y << 16) * ra * g.z, __uint_as_float(wa[j].y & 0xffff0000u) * ra * g.w}, ya + 64 * j);
                __builtin_nontemporal_store((f32x4){__uint_as_float(wb[j].x << 16) * rb * g.x, __uint_as_float(wb[j].x & 0xffff0000u) * rb * g.y, __uint_as_float(wb[j].y << 16) * rb * g.z, __uint_as_float(wb[j].y & 0xffff0000u) * rb * g.w}, yb + 64 * j); }
        }
    }
#undef IN
#undef SEAM
#undef GEMM_PHASE
#undef GEMM_PROMPT
#undef RIDE_PHASE
#undef FGATE_ROWS
}

extern "C" void kernel_launch(void* const* d_in, const int* in_sizes, int n_in, void* d_out, int out_size, void* d_ws, size_t ws_size, hipStream_t stream) {
    static int grid = 0;
    if (grid == 0) {
        if (n_in != 20 || (size_t)out_size != OUT_TOTAL || ws_size < WS_END) { fprintf(stderr, "kernel_launch: unexpected shapes (n_in %d out %d ws %zu)\n", n_in, out_size, ws_size); grid = -1; return; }
        int dev = 0, cus = 0, per_cu = 0;
        if (hipGetDevice(&dev) != hipSuccess || hipDeviceGetAttribute(&cus, hipDeviceAttributeMultiprocessorCount, dev) != hipSuccess) { grid = -1; return; }
        if (hipFuncSetAttribute((const void*)mega_fwd, hipFuncAttributeMaxDynamicSharedMemorySize, LDS_BYTES) != hipSuccess) { fprintf(stderr, "kernel_launch: hipFuncSetAttribute failed\n"); grid = -1; return; }
        if (hipOccupancyMaxActiveBlocksPerMultiprocessor(&per_cu, (const void*)mega_fwd, NWAVES * 64, LDS_BYTES) != hipSuccess || per_cu < 1) { fprintf(stderr, "kernel_launch: occupancy query says %d\n", per_cu); (void)hipGetLastError(); grid = -1; return; }
        if (cus != 256) { fprintf(stderr, "kernel_launch: built for a 256-CU device (got %d)\n", cus); grid = -1; return; }
        grid = cus * 1;
    }
    if (grid < 0) return;
    Args a{};
    for (int i = 0; i < 20; ++i) a.in[i] = (const float*)d_in[i];
    a.out = (float*)d_out; a.ws = (unsigned char*)d_ws; a.use_cg = RUNTIME_USE_CG; a.pad = RUNTIME_DELAY;
#if MK_N_LAUNCHES == 1
    a.ph_lo = 0; a.ph_hi = NPHASE;
    void* kargs[] = {&a};
    hipError_t e = hipLaunchCooperativeKernel((const void*)mega_fwd, dim3(grid), dim3(NWAVES * 64), kargs, LDS_BYTES, stream);
    if (e != hipSuccess) fprintf(stderr, "cooperative launch failed: %s (grid %d)\n", hipGetErrorString(e), grid);
#else
    for (int p = 0; p < NPHASE; ++p) { a.ph_lo = p; a.ph_hi = p + 1; hipLaunchKernelGGL(mega_fwd, dim3(grid), dim3(NWAVES * 64), LDS_BYTES, stream, a); }
#endif
}
```

```cpp
#include <hip/hip_runtime.h>
#include <hip/hip_cooperative_groups.h>
#include <cstdio>
#include <cstdint>
#include <cmath>
namespace cg = cooperative_groups;
namespace pg8 {
#define PG8_LAS __attribute__((address_space(3)))
typedef unsigned short bf16_t;
typedef short bf16x8 __attribute__((ext_vector_type(8)));
typedef float f32x4 __attribute__((ext_vector_type(4)));
typedef unsigned u32x4 __attribute__((ext_vector_type(4)));
constexpr int BM = 256, BK = 64, HALF = 128, HTB = HALF * BK * 2  , STAGE_BYTES = 8 * HTB, NXCD = 8, WGM = 8;

__host__ __device__ __forceinline__ int lds_byte(int r, int c) { const int st = (r >> 4) * 2 + (c >> 5), rr = r & 15, cc = c & 31, ob = rr * 64 + cc * 2; return st * 1024 + (ob ^ (((ob >> 9) & 1) << 5)); }
__host__ __device__ __forceinline__ void stage_rc(int b, int& R, int& C) { const int st = b / 1024, sb = b % 1024, swz = sb ^ (((sb >> 9) & 1) << 5); R = (st >> 1) * 16 + swz / 64; C = (st & 1) * 32 + (swz % 64) / 2; }
__host__ __device__ __forceinline__ int perm32(int rho) { const int n = rho >> 4, i = rho & 15; return 8 * (i >> 2) + 4 * n + (i & 3); }

struct Unit { int pm, pn; };
struct Gemm { const bf16_t* A; const bf16_t* Bt; int K; int lda; size_t a_pn_step; };

struct StaticOrder {
    int nM, nN, nwg, G, c;
    __host__ __device__ void init(int M, int N, int G_, int c_) { nM = M / BM; nN = N / BM; nwg = nM * nN; G = G_; c = c_; }
    __host__ __device__ bool next(int i, Unit& u) const {
        const long L = (long)i * G + c; if (L >= nwg) return false;
        int wgid = (int)L; { const int q = nwg / NXCD, r = nwg % NXCD, xcd = wgid % NXCD, off = wgid / NXCD; wgid = (xcd < r ? xcd * (q + 1) : r * (q + 1) + (xcd - r) * q) + off; }
        const int nig = WGM * nN, gid = wgid / nig, fm = gid * WGM, gsz = (nM - fm) < WGM ? (nM - fm) : WGM;
        u.pm = fm + ((wgid % nig) % gsz); u.pn = (wgid % nig) / gsz; return true;
    }
    __device__ __forceinline__ void a_ready(const Unit&) const {}
    __device__ __forceinline__ void done(const Unit&) const {}
};

__device__ __forceinline__ void map_tile(long L, int nM, int nN, Unit& u) {
    const int nwg = nM * nN; int wgid = (int)L; { const int q = nwg / NXCD, r = nwg % NXCD, xcd = wgid % NXCD, off = wgid / NXCD; wgid = (xcd < r ? xcd * (q + 1) : r * (q + 1) + (xcd - r) * q) + off; }
    const int nig = WGM * nN, gid = wgid / nig, fm = gid * WGM, gsz = (nM - fm) < WGM ? (nM - fm) : WGM;
    u.pm = fm + ((wgid % nig) % gsz); u.pn = ((wgid % nig) / gsz + 4 * gid) % nN;
}
struct RideOrder {
    static constexpr int GIVE = 3;
    int nN, c, nP, sample_e, orphanL;
    __device__ __forceinline__ void init(int nN_, int c_) {
        nN = nN_; c = c_; const int nwgP = 64 * nN, nS = 2 * nN;
        nP = (nwgP - c + 255) / 256; sample_e = (c >= 128 && c < 128 + nS) ? c - 128 : -1; orphanL = -1;
        if (c >= 248) nP -= GIVE;
        else if (c >= 128 + nS && c < 128 + nS + 8 * GIVE) { const int o = c - 128 - nS, sc = 248 + o / GIVE; orphanL = ((nwgP - sc + 255) / 256 - 1 - o % GIVE) * 256 + sc; }
    }
    __device__ __forceinline__ bool next(int i, Unit& u) const {
        if (sample_e >= 0) { if (i == 0) { u.pm = 64 + (sample_e & 1); u.pn = sample_e >> 1; return true; } --i; }
        long L; if (i < nP) L = (long)i * 256 + c; else if (i == nP && orphanL >= 0) L = orphanL; else return false;
        map_tile(L, 64, nN, u); return true;
    }
    __device__ __forceinline__ void a_ready(const Unit&) const {}
    __device__ __forceinline__ void done(const Unit&) const {}
};
struct OneUnit {
    int pm, pn;
    __device__ __forceinline__ bool next(int i, Unit& u) const { if (i != 0 || pm < 0) return false; u.pm = pm; u.pn = pn; return true; }
    __device__ __forceinline__ void a_ready(const Unit&) const {}
    __device__ __forceinline__ void done(const Unit&) const {}
};

constexpr int ROWS_P = 16384;
constexpr int DM_ = 1024, FF_ = 2816;
constexpr size_t OFF_KP = 17455104, OFF_VP = 34232320, OFF_KS = 51271680, OFF_VS = 51795968;
__device__ __forceinline__ unsigned cvt_pk_bf16(float lo, float hi) { unsigned r; asm volatile("v_cvt_pk_bf16_f32 %0, %1, %2" : "=v"(r) : "v"(lo), "v"(hi)); return r; }
__device__ __forceinline__ u32x4 pack8(const f32x4 a, const f32x4 b) { u32x4 w; w.x = cvt_pk_bf16(a[0], a[1]); w.y = cvt_pk_bf16(a[2], a[3]); w.z = cvt_pk_bf16(b[0], b[1]); w.w = cvt_pk_bf16(b[2], b[3]); return w; }
__device__ __forceinline__ float row_rstd(const float* SS, int row) {
    const f32x4* p = (const f32x4*)(SS + (size_t)row * 16);
    const f32x4 a = p[0], b = p[1], c = p[2], d = p[3];
    const float s = (((a[0] + a[1]) + (a[2] + a[3])) + ((b[0] + b[1]) + (b[2] + b[3]))) + (((c[0] + c[1]) + (c[2] + c[3])) + ((d[0] + d[1]) + (d[2] + d[3])));
    return rsqrtf(s * (1.0f / 1024.0f) + 1e-6f);
}
__device__ __forceinline__ void rows_rstd(const float* SS, int row0, int fq, float (&rs)[2][4]) {
    f32x4 t[2][4];
#pragma unroll
    for (int ai = 0; ai < 2; ++ai)
#pragma unroll
        for (int m = 0; m < 4; ++m) t[ai][m] = *(const f32x4*)(SS + (size_t)(row0 + ai * HALF + m * 16) * 16 + 4 * fq);
#pragma unroll
    for (int ai = 0; ai < 2; ++ai)
#pragma unroll
        for (int m = 0; m < 4; ++m) { float s = (t[ai][m][0] + t[ai][m][1]) + (t[ai][m][2] + t[ai][m][3]); s += __shfl_xor(s, 16); s += __shfl_xor(s, 32); rs[ai][m] = rsqrtf(s * (1.0f / 1024.0f) + 1e-6f); }
}
__device__ __forceinline__ float silu_mul(float g, float u) { return g * __builtin_amdgcn_rcpf(1.0f + __builtin_amdgcn_exp2f(-1.4426950408889634f * g)) * u; }

struct EpiSwiglu {
    static constexpr bool PERM = true, AFTER_DRAIN = false;
    bf16_t* ACT; const float* SS; int pn0; unsigned* cnt; PG8_LAS unsigned* lcnt;
    __device__ __forceinline__ void operator()(const f32x4 (&acc)[2][2][4][2], const Unit& u, int wr, int wc, int fr, int fq) const {
        const int row0 = u.pm * BM + wr * 64 + fr, col0 = (u.pn - pn0) * 128 + wc * 32 + 8 * fq;
        float rsv[2][4]; rows_rstd(SS, row0, fq, rsv);
#pragma unroll
        for (int ai = 0; ai < 2; ++ai)
#pragma unroll
            for (int m = 0; m < 4; ++m) {
                const int row = row0 + ai * HALF + m * 16; const float rs = rsv[ai][m];
                const float k1 = -1.4426950408889634f * rs, k2 = rs * rs;
                f32x4 h[2];
#pragma unroll
                for (int n = 0; n < 2; ++n) { const f32x4 g = acc[ai][0][m][n], uu = acc[ai][1][m][n]; const f32x4 t = g * k1; f32x4 ex;
#pragma unroll
                    for (int e = 0; e < 4; ++e) ex[e] = __builtin_amdgcn_exp2f(t[e]);
                    const f32x4 d = ex + 1.0f; f32x4 r;
#pragma unroll
                    for (int e = 0; e < 4; ++e) r[e] = __builtin_amdgcn_rcpf(d[e]);
                    h[n] = ((g * uu) * k2) * r; }
                *(u32x4*)(ACT + (size_t)row * FF_ + col0) = pack8(h[0], h[1]);
            }
        if (cnt && u.pm >= 64) {
            asm volatile("s_waitcnt vmcnt(0)" ::: "memory");
            unsigned old = 0u;
            if ((fr | fq) == 0) old = __hip_atomic_fetch_add(lcnt, 1u, __ATOMIC_RELAXED, __HIP_MEMORY_SCOPE_WORKGROUP);
            old = (unsigned)__builtin_amdgcn_readfirstlane((int)old);
            if (old == 7u) {
                if ((fr | fq) == 0) __hip_atomic_store(lcnt, 0u, __ATOMIC_RELAXED, __HIP_MEMORY_SCOPE_WORKGROUP);
                __builtin_amdgcn_fence(__ATOMIC_RELEASE, "agent");
                if ((fr | fq) == 0) __hip_atomic_fetch_add(cnt + 64 * (u.pm - 64), 8u, __ATOMIC_RELAXED, __HIP_MEMORY_SCOPE_AGENT);
            }
        }
    }
};
struct EpiRes {
    static constexpr bool PERM = true, AFTER_DRAIN = false;
    const float* in_lo; const float* in_hi;
    float* out32; bf16_t* XB; float* SS; const float* colscale; float alpha;
    __device__ __forceinline__ void operator()(const f32x4 (&acc)[2][2][4][2], const Unit& u, int wr, int wc, int fr, int fq) const {
        const int row0 = u.pm * BM + wr * 64 + fr, colw = u.pn * BM + wc * 32 + 8 * fq;
        f32x4 sc[2][2];
#pragma unroll
        for (int bj = 0; bj < 2; ++bj)
#pragma unroll
            for (int n = 0; n < 2; ++n) sc[bj][n] = colscale ? *(const f32x4*)(colscale + colw + bj * HALF + 4 * n) : (f32x4){alpha, alpha, alpha, alpha};
#define EPIRES_ROW(B0, B1, M_, BJ_) do { const int row = row0 + ai * HALF + (M_) * 16, col = colw + (BJ_) * HALF; \
            const f32x4 o0 = (B0) + sc[BJ_][0] * acc[ai][BJ_][M_][0], o1 = (B1) + sc[BJ_][1] * acc[ai][BJ_][M_][1]; \
            if (out32) { float* op = out32 + (size_t)row * DM_ + col; *(f32x4*)op = o0; *(f32x4*)(op + 4) = o1; } \
            *(u32x4*)(XB + (size_t)row * DM_ + col) = pack8(o0, o1); \
            ssq[M_] += ((o0[0] * o0[0] + o0[1] * o0[1]) + (o0[2] * o0[2] + o0[3] * o0[3])) + ((o1[0] * o1[0] + o1[1] * o1[1]) + (o1[2] * o1[2] + o1[3] * o1[3])); } while (0)
#pragma unroll
        for (int ai = 0; ai < 2; ++ai) {
            float ssq[4] = {0.f, 0.f, 0.f, 0.f};
            if (in_lo) {
#pragma unroll
                for (int mh = 0; mh < 2; ++mh) { f32x4 bq[2][2][2];
#pragma unroll
                    for (int mm = 0; mm < 2; ++mm) { const int row = row0 + ai * HALF + (2 * mh + mm) * 16; const float* bp = (row < ROWS_P) ? in_lo + (size_t)row * DM_ : in_hi + (size_t)(row - ROWS_P) * DM_;
#pragma unroll
                        for (int bj = 0; bj < 2; ++bj) { bq[mm][bj][0] = *(const f32x4*)(bp + colw + bj * HALF); bq[mm][bj][1] = *(const f32x4*)(bp + colw + bj * HALF + 4); } }
#pragma unroll
                    for (int mm = 0; mm < 2; ++mm)
#pragma unroll
                        for (int bj = 0; bj < 2; ++bj) EPIRES_ROW(bq[mm][bj][0], bq[mm][bj][1], 2 * mh + mm, bj); }
            } else {
                u32x4 bw[4][2];
#pragma unroll
                for (int m = 0; m < 4; ++m)
#pragma unroll
                    for (int bj = 0; bj < 2; ++bj) bw[m][bj] = *(const u32x4*)(XB + (size_t)(row0 + ai * HALF + m * 16) * DM_ + colw + bj * HALF);
#pragma unroll
                for (int m = 0; m < 4; ++m)
#pragma unroll
                    for (int bj = 0; bj < 2; ++bj) { const u32x4 w = bw[m][bj];
                        const f32x4 b0 = (f32x4){__uint_as_float(w.x << 16), __uint_as_float(w.x & 0xffff0000u), __uint_as_float(w.y << 16), __uint_as_float(w.y & 0xffff0000u)};
                        const f32x4 b1 = (f32x4){__uint_as_float(w.z << 16), __uint_as_float(w.z & 0xffff0000u), __uint_as_float(w.w << 16), __uint_as_float(w.w & 0xffff0000u)};
                        EPIRES_ROW(b0, b1, m, bj); }
            }
#pragma unroll
            for (int m = 0; m < 4; ++m) { float s = ssq[m]; s += __shfl_xor(s, 16); s += __shfl_xor(s, 32);
                if (fq == 0) SS[(size_t)(row0 + ai * HALF + m * 16) * 16 + u.pn * 4 + wc] = s; }
        }
#undef EPIRES_ROW
    }
};
struct EpiKV {
    static constexpr bool PERM = true, AFTER_DRAIN = false;
    float* dout; bf16_t* KBp; bf16_t* VBp; bf16_t* KSp; bf16_t* VSp; const float* SS; unsigned* KMX; unsigned* cnt;
    __device__ __forceinline__ void operator()(const f32x4 (&acc)[2][2][4][2], const Unit& u, int wr, int wc, int fr, int fq) const {
        const bool isV = u.pn >= 4, samp = u.pm >= 64; const int ct = (u.pn & 3) * BM;
        const int row0 = u.pm * BM + wr * 64 + fr, colw = ct + wc * 32 + 8 * fq;
        float rsv[2][4]; rows_rstd(SS, row0, fq, rsv);
#pragma unroll
        for (int ai = 0; ai < 2; ++ai) {
            float mx[2] = {0.f, 0.f};
#pragma unroll
            for (int m = 0; m < 4; ++m) {
                const int row = row0 + ai * HALF + m * 16; const float rs = rsv[ai][m];
                float* fp; bf16_t* bp;
                if (!samp) { fp = dout + (isV ? OFF_VP : OFF_KP) + (size_t)row * DM_; bp = (isV ? VBp : KBp) + (size_t)row * DM_; }
                else { const int r2 = row - ROWS_P, b = r2 >> 6, t = r2 & 63; fp = dout + (isV ? OFF_VS : OFF_KS) + (size_t)r2 * DM_; bp = (isV ? VSp : KSp) + (size_t)(b * 2112 + 2048 + t) * DM_; }
#pragma unroll
                for (int bj = 0; bj < 2; ++bj) {
                    const int col = colw + bj * HALF;
                    const f32x4 v0 = acc[ai][bj][m][0] * rs, v1 = acc[ai][bj][m][1] * rs;
                    __builtin_nontemporal_store(v0, (f32x4*)(fp + col)); __builtin_nontemporal_store(v1, (f32x4*)(fp + col + 4));
                    *(u32x4*)(bp + col) = pack8(v0, v1);
                    if (!isV) {
                        float n2 = ((v0[0] * v0[0] + v0[1] * v0[1]) + (v0[2] * v0[2] + v0[3] * v0[3])) + ((v1[0] * v1[0] + v1[1] * v1[1]) + (v1[2] * v1[2] + v1[3] * v1[3]));
                        n2 += __shfl_xor(n2, 16); n2 += __shfl_xor(n2, 32);
                        mx[bj] = fmaxf(mx[bj], n2);
                    }
                }
            }
            if (!isV) {
#pragma unroll
                for (int bj = 0; bj < 2; ++bj) {
                    float v = mx[bj];
                    v = fmaxf(v, __shfl_xor(v, 1)); v = fmaxf(v, __shfl_xor(v, 2)); v = fmaxf(v, __shfl_xor(v, 4)); v = fmaxf(v, __shfl_xor(v, 8));
                    const int sb = samp ? 2 + (u.pm - 64) * 4 + 2 * ai + wr : (u.pm >> 5);
                    const int head = (ct + bj * HALF + wc * 32) >> 6, half = wc & 1;
                    if (fr == 0 && fq == 0) atomicMax(KMX + (sb * 16 + head) * 2 + half, __float_as_uint(v));
                }
            }
        }
        if (cnt && samp) {
            if ((fr | fq) == 0) __hip_atomic_fetch_add(cnt + 64 * (u.pm - 64), 1u, __ATOMIC_RELAXED, __HIP_MEMORY_SCOPE_AGENT);
        }
    }
};
struct EpiQ {
    static constexpr bool PERM = true, AFTER_DRAIN = false;
    bf16_t* Q; const float* SS; float c2;
    __device__ __forceinline__ void operator()(const f32x4 (&acc)[2][2][4][2], const Unit& u, int wr, int wc, int fr, int fq) const {
        const int row0 = u.pm * BM + wr * 64 + fr, colw = u.pn * BM + wc * 32 + 8 * fq;
        float rsv[2][4]; rows_rstd(SS, row0, fq, rsv);
#pragma unroll
        for (int ai = 0; ai < 2; ++ai)
#pragma unroll
            for (int m = 0; m < 4; ++m) {
                const int row = row0 + ai * HALF + m * 16; const float rs = rsv[ai][m] * c2;
#pragma unroll
                for (int bj = 0; bj < 2; ++bj) *(u32x4*)(Q + (size_t)row * DM_ + colw + bj * HALF) = pack8(acc[ai][bj][m][0] * rs, acc[ai][bj][m][1] * rs);
            }
    }
};
struct EpiKVSwiglu {
    static constexpr bool PERM = true, AFTER_DRAIN = false;
    EpiKV kv; EpiSwiglu sw;
    __device__ __forceinline__ void operator()(const f32x4 (&acc)[2][2][4][2], const Unit& u, int wr, int wc, int fr, int fq) const {
        if (u.pn < 8) kv(acc, u, wr, wc, fr, fq); else sw(acc, u, wr, wc, fr, fq);
    }
};
template <class Epi, class Sched, bool ALIGN_EPI = false, bool SP2 = false>
__device__ __forceinline__ void gemm_phase(PG8_LAS unsigned char* lds, const Gemm g, const Sched& S, const Epi& E) {
    const int tid = threadIdx.x, wid = __builtin_amdgcn_readfirstlane(tid >> 6), lane = tid & 63, wr = wid >> 2, wc = wid & 3, fr = lane & 15, fq = lane >> 4;
    const int K = g.K, nt = K / BK;
    unsigned voffA[2], voffB[2];
#pragma unroll
    for (int i = 0; i < 2; ++i) { int R, C; stage_rc(tid * 16 + i * 8192, R, C); const int Rb = Epi::PERM ? ((R & ~31) + perm32(R & 31)) : R;
        voffA[i] = (unsigned)(R * g.lda + C) * 2u; voffB[i] = (unsigned)(Rb * K + C) * 2u; }
    const size_t kstep = (size_t)(BK * 2);
    const size_t hstepA = (size_t)HALF * g.lda * 2, hstepB = (size_t)HALF * K * 2;
    const size_t tstepA = 2 * hstepA, tstepB = 2 * hstepB;
    const unsigned ldsw = (unsigned)wid * 1024u;
    const int aoff = lds_byte(wr * 64 + fr, fq * 8), boff = lds_byte(wc * 32 + fr, fq * 8);
#define PG8_SA(b, h) (((b) * 2 + (h)) * HTB)
#define PG8_SB(b, h) ((4 + (b) * 2 + (h)) * HTB)
#define PG8_STAGE(bufoff, gbase, voff) do { _Pragma("unroll") for (int _i = 0; _i < 2; ++_i) \
        __builtin_amdgcn_global_load_lds((const unsigned*)((const char*)(gbase) + (voff)[_i]), (PG8_LAS unsigned*)(lds + (bufoff) + ldsw + _i * 8192), 16, 0, 0); } while (0)
#define PG8_LDA(dst, b, h) do { _Pragma("unroll") for (int m = 0; m < 4; ++m) _Pragma("unroll") for (int k = 0; k < 2; ++k) dst[m][k] = *(const PG8_LAS bf16x8*)(lds + PG8_SA(b, h) + aoff + m * 2048 + k * 1024); } while (0)
#define PG8_LDB(dst, b, h) do { _Pragma("unroll") for (int n = 0; n < 2; ++n) _Pragma("unroll") for (int k = 0; k < 2; ++k) dst[n][k] = *(const PG8_LAS bf16x8*)(lds + PG8_SB(b, h) + boff + n * 2048 + k * 1024); } while (0)
#define PG8_MMA(ai, bj, At, Bt) do { __builtin_amdgcn_s_setprio(1); _Pragma("unroll") for (int m = 0; m < 4; ++m) _Pragma("unroll") for (int n = 0; n < 2; ++n) _Pragma("unroll") for (int k = 0; k < 2; ++k) \
        acc[ai][bj][m][n] = __builtin_amdgcn_mfma_f32_16x16x32_bf16(Bt[n][k], At[m][k], acc[ai][bj][m][n], 0, 0, 0); __builtin_amdgcn_s_setprio(0); } while (0)
#define PG8_WAIT_V(n) asm volatile("s_waitcnt vmcnt(" #n ")" ::: "memory")
#define PG8_WAIT_L(n) asm volatile("s_waitcnt lgkmcnt(" #n ")" ::: "memory")
#define PG8_BAR __builtin_amdgcn_s_barrier()
#define PG8_SCHED __builtin_amdgcn_sched_barrier(0)
    Unit cur, nxt; int ui = 0;
    if (!S.next(0, cur)) return;
    f32x4 acc[2][2][4][2];
#pragma unroll
    for (int a = 0; a < 2; ++a)
#pragma unroll
        for (int b = 0; b < 2; ++b)
#pragma unroll
            for (int m = 0; m < 4; ++m)
#pragma unroll
                for (int n = 0; n < 2; ++n) acc[a][b][m][n] = (f32x4){0.f, 0.f, 0.f, 0.f};
    bf16x8 At[4][2], B0[2][2], B1[2][2];
    const char* cA = (const char*)g.A + (size_t)cur.pm * tstepA + (size_t)cur.pn * g.a_pn_step; const char* cB = (const char*)g.Bt + (size_t)cur.pn * tstepB;
    S.a_ready(cur);
    if constexpr (SP2) {
        PG8_STAGE(PG8_SB(0, 0), cB, voffB); PG8_STAGE(PG8_SB(0, 1), cB + hstepB, voffB); PG8_STAGE(PG8_SA(0, 0), cA, voffA); PG8_STAGE(PG8_SA(0, 1), cA + hstepA, voffA);
        if (wr == 1) PG8_BAR;
        PG8_WAIT_V(2); PG8_BAR;
        PG8_STAGE(PG8_SB(1, 0), cB + kstep, voffB); PG8_STAGE(PG8_SA(1, 0), cA + kstep, voffA); PG8_STAGE(PG8_SB(1, 1), cB + hstepB + kstep, voffB);
        PG8_WAIT_V(6); PG8_BAR;
    } else {
        PG8_STAGE(PG8_SB(0, 0), cB, voffB); PG8_STAGE(PG8_SA(0, 0), cA, voffA); PG8_STAGE(PG8_SB(0, 1), cB + hstepB, voffB); PG8_STAGE(PG8_SA(0, 1), cA + hstepA, voffA);
        if (wr == 1) PG8_BAR;
        PG8_WAIT_V(4); PG8_BAR;
        PG8_STAGE(PG8_SB(1, 0), cB + kstep, voffB); PG8_STAGE(PG8_SA(1, 0), cA + kstep, voffA); PG8_STAGE(PG8_SB(1, 1), cB + hstepB + kstep, voffB);
        PG8_WAIT_V(6); PG8_BAR;
    }
    for (;;) {
        const bool has_next = S.next(ui + 1, nxt);
        const char* nA = has_next ? (const char*)g.A + (size_t)nxt.pm * tstepA + (size_t)nxt.pn * g.a_pn_step : cA; const char* nB = has_next ? (const char*)g.Bt + (size_t)nxt.pn * tstepB : cB;
        for (int t = 0; t < nt; t += 2) {
            const bool last = (t == nt - 2);
            const char* a1 = cA + (size_t)(t + 1) * kstep;
            const char* a2 = last ? nA : cA + (size_t)(t + 2) * kstep; const char* b2 = last ? nB : cB + (size_t)(t + 2) * kstep;
            const char* a3 = a2 + kstep; const char* b3 = b2 + kstep;
            if (last && has_next) S.a_ready(nxt);
            if constexpr (SP2) {
            PG8_LDB(B0, 0, 0); PG8_LDB(B1, 0, 1); PG8_SCHED; PG8_LDA(At, 0, 0); PG8_STAGE(PG8_SA(1, 1), a1 + hstepA, voffA);
            PG8_WAIT_V(8); PG8_WAIT_L(0); PG8_BAR; PG8_MMA(0, 0, At, B0); PG8_MMA(0, 1, At, B1); PG8_BAR; PG8_SCHED;
            PG8_LDA(At, 0, 1); PG8_STAGE(PG8_SB(0, 0), b2, voffB); PG8_STAGE(PG8_SB(0, 1), b2 + hstepB, voffB); PG8_STAGE(PG8_SA(0, 0), a2, voffA);
            PG8_WAIT_V(8); PG8_WAIT_L(0); PG8_BAR; PG8_MMA(1, 0, At, B0); PG8_MMA(1, 1, At, B1); PG8_BAR; PG8_SCHED;
            PG8_LDB(B0, 1, 0); PG8_LDB(B1, 1, 1); PG8_SCHED; PG8_LDA(At, 1, 0); PG8_STAGE(PG8_SA(0, 1), a2 + hstepA, voffA);
            PG8_WAIT_V(8); PG8_WAIT_L(0); PG8_BAR; PG8_MMA(0, 0, At, B0); PG8_MMA(0, 1, At, B1); PG8_BAR; PG8_SCHED;
            PG8_LDA(At, 1, 1); PG8_STAGE(PG8_SB(1, 0), b3, voffB); PG8_STAGE(PG8_SB(1, 1), b3 + hstepB, voffB); PG8_STAGE(PG8_SA(1, 0), a3, voffA);
            PG8_WAIT_V(8); PG8_WAIT_L(0); PG8_BAR; PG8_MMA(1, 0, At, B0); PG8_MMA(1, 1, At, B1); PG8_BAR; PG8_SCHED;
            } else {
            PG8_LDB(B0, 0, 0); PG8_SCHED; PG8_LDA(At, 0, 0); PG8_STAGE(PG8_SA(1, 1), a1 + hstepA, voffA);
            PG8_WAIT_L(8); PG8_BAR; PG8_WAIT_L(0); PG8_MMA(0, 0, At, B0); PG8_BAR; PG8_SCHED;
            PG8_LDB(B1, 0, 1); PG8_STAGE(PG8_SB(0, 0), b2, voffB);
            PG8_BAR; PG8_WAIT_L(0); PG8_MMA(0, 1, At, B1); PG8_BAR;
            PG8_LDA(At, 0, 1); PG8_STAGE(PG8_SA(0, 0), a2, voffA);
            PG8_BAR; PG8_WAIT_L(0); PG8_MMA(1, 0, At, B0); PG8_BAR; PG8_SCHED;
            PG8_STAGE(PG8_SB(0, 1), b2 + hstepB, voffB);
            PG8_WAIT_V(6); PG8_BAR; PG8_MMA(1, 1, At, B1); PG8_BAR;
            PG8_LDB(B0, 1, 0); PG8_SCHED; PG8_LDA(At, 1, 0); PG8_STAGE(PG8_SA(0, 1), a2 + hstepA, voffA);
            PG8_WAIT_L(8); PG8_BAR; PG8_WAIT_L(0); PG8_MMA(0, 0, At, B0); PG8_BAR; PG8_SCHED;
            PG8_LDB(B1, 1, 1); PG8_STAGE(PG8_SB(1, 0), b3, voffB);
            PG8_BAR; PG8_WAIT_L(0); PG8_MMA(0, 1, At, B1); PG8_BAR;
            PG8_LDA(At, 1, 1); PG8_STAGE(PG8_SA(1, 0), a3, voffA);
            PG8_BAR; PG8_WAIT_L(0); PG8_MMA(1, 0, At, B0); PG8_BAR; PG8_SCHED;
            PG8_STAGE(PG8_SB(1, 1), b3 + hstepB, voffB);
            PG8_WAIT_V(6); PG8_BAR; PG8_MMA(1, 1, At, B1); PG8_BAR;
            }
        }
        if constexpr (ALIGN_EPI) { if (wr == 0) PG8_BAR; }
        if constexpr (!Epi::AFTER_DRAIN) { E(acc, cur, wr, wc, fr, fq); S.done(cur); }
        if (!has_next) break;
#pragma unroll
        for (int a = 0; a < 2; ++a)
#pragma unroll
            for (int b = 0; b < 2; ++b)
#pragma unroll
                for (int m = 0; m < 4; ++m)
#pragma unroll
                    for (int n = 0; n < 2; ++n) acc[a][b][m][n] = (f32x4){0.f, 0.f, 0.f, 0.f};
        cur = nxt; cA = nA; cB = nB; ++ui;
        if constexpr (ALIGN_EPI) { if (wr == 1) PG8_BAR; }
    }
    PG8_WAIT_V(0);
    if constexpr (!ALIGN_EPI) { if (wr == 0) PG8_BAR; }
    PG8_BAR;
    if constexpr (Epi::AFTER_DRAIN) { E.fused(acc, cur, wr, wc, fr, fq, lds, wid, lane); S.done(cur); }
#undef PG8_SA
#undef PG8_SB
#undef PG8_STAGE
#undef PG8_LDA
#undef PG8_LDB
#undef PG8_MMA
#undef PG8_WAIT_V
#undef PG8_WAIT_L
#undef PG8_BAR
#undef PG8_SCHED
}}

namespace att {
#define ALAS __attribute__((address_space(3)))
using bf16 = unsigned short;
using bf16x8 = __attribute__((ext_vector_type(8))) short;
using s16x4 = __attribute__((ext_vector_type(4))) short;
using f32x16 = __attribute__((ext_vector_type(16))) float;
using f32x4 = __attribute__((ext_vector_type(4))) float;
using u32x4 = __attribute__((ext_vector_type(4))) unsigned;
typedef float f32x2_t __attribute__((ext_vector_type(2))); typedef __bf16 bf16x2_t __attribute__((ext_vector_type(2)));
#ifndef ATT_PREFETCH
#define ATT_PREFETCH 1
#endif
#ifndef ATT_EXIT_LOG2
#define ATT_EXIT_LOG2 -48.f
#endif
#ifndef ATT_EARLY_EXIT
#define ATT_EARLY_EXIT 1
#endif
constexpr int WLDS = 8192 + 4096 + 256 + 256;
__device__ __forceinline__ int crow(int r, int hi) { return (r & 3) + 8 * (r >> 2) + 4 * hi; }
__device__ __forceinline__ unsigned cvtpk_s(float lo, float hi) { f32x2_t v = {lo, hi}; bf16x2_t b = __builtin_convertvector(v, bf16x2_t); return __builtin_bit_cast(unsigned, b); }
__device__ __forceinline__ float bf2f(short s) { return __uint_as_float(((unsigned)(unsigned short)s) << 16); }
typedef short v4i16_t __attribute__((ext_vector_type(4)));
__device__ __forceinline__ s16x4 vtr(const ALAS unsigned char* p) { return __builtin_bit_cast(s16x4, __builtin_amdgcn_ds_read_tr16_b64_v4i16((ALAS v4i16_t*)p)); }
__device__ __forceinline__ void pv(f32x16* o, const ALAS unsigned char* vp, bf16x8 pa0, bf16x8 pa1, bf16x8 pa2, bf16x8 pa3) {
#pragma unroll
    for (int d0 = 0; d0 < 2; ++d0) { s16x4 lo[4], hi[4];
#pragma unroll
        for (int ks = 0; ks < 4; ++ks) { lo[ks] = vtr(vp + d0 * 4096 + ks * 1024); hi[ks] = vtr(vp + d0 * 4096 + ks * 1024 + 512); }
#define PK(k) (bf16x8){lo[k][0], lo[k][1], lo[k][2], lo[k][3], hi[k][0], hi[k][1], hi[k][2], hi[k][3]}
        o[d0] = __builtin_amdgcn_mfma_f32_32x32x16_bf16(pa0, PK(0), o[d0], 0, 0, 0);
        o[d0] = __builtin_amdgcn_mfma_f32_32x32x16_bf16(pa1, PK(1), o[d0], 0, 0, 0);
        o[d0] = __builtin_amdgcn_mfma_f32_32x32x16_bf16(pa2, PK(2), o[d0], 0, 0, 0);
        o[d0] = __builtin_amdgcn_mfma_f32_32x32x16_bf16(pa3, PK(3), o[d0], 0, 0, 0);
#undef PK
    }
}
__device__ __forceinline__ void wave_unit(const bf16* Qp, bf16* Op, const bf16* Kp, const bf16* Vp, const float* ckl, int qpos0, float kmaxn, ALAS unsigned char* wl, int lane) {
    const int r32 = lane & 31, hi = lane >> 5;
    ALAS unsigned char* vt = wl; ALAS bf16* stg = (ALAS bf16*)(wl + 8192); ALAS float* wsf = (ALAS float*)(wl + 8192 + 4096);
    const ALAS unsigned char* vp = vt + ((lane >> 4) & 1) * 32 + (lane & 3) * 8 + (4 * hi + ((lane & 15) >> 2)) * 64;
    bf16x8 qr[4];
#pragma unroll
    for (int d0 = 0; d0 < 4; ++d0) qr[d0] = *(const bf16x8*)(Qp + (size_t)r32 * 1024 + d0 * 16 + hi * 8);
    float qn2 = 0.f;
#pragma unroll
    for (int d0 = 0; d0 < 4; ++d0)
#pragma unroll
        for (int e = 0; e < 8; ++e) { const float v = bf2f(qr[d0][e]); qn2 += v * v; }
    qn2 += __shfl_xor(qn2, 32);
    const float qkb = __builtin_amdgcn_sqrtf(qn2) * kmaxn * 1.03f + 1.0f;
    const float cq = ckl[qpos0 + r32];
    float mref = 0.f, l = 0.f; f32x16 o[2]; o[0] = f32x16{}; o[1] = f32x16{};
    const int jd = (qpos0 + 31) >> 6;
    bf16x8 kf[8]; f32x4 bpre;
    ALAS float* bl = (ALAS float*)(wl + 8192 + 4096 + 256);
#define ATT_LOADK(JT) do { const bf16* kp_ = Kp + (size_t)(64 * (JT) + r32) * 1024 + hi * 8; \
        _Pragma("unroll") for (int d0 = 0; d0 < 4; ++d0) { kf[2 * d0] = *(const bf16x8*)(kp_ + d0 * 16); kf[2 * d0 + 1] = *(const bf16x8*)(kp_ + 32 * 1024 + d0 * 16); } \
        bpre = *(const f32x4*)(ckl + 64 * (JT) + 4 * (lane & 15)); } while (0)
#define ATT_LOADV(JT) do { _Pragma("unroll") for (int w = 0; w < 8; ++w) __builtin_amdgcn_global_load_lds((const unsigned*)(Vp + (size_t)(64 * (JT) + 16 * (w & 3) + (lane >> 2)) * 1024 + 32 * (w >> 2) + 8 * (lane & 3)), \
        (ALAS unsigned*)(vt + w * 1024), 16, 0, 0); } while (0)
    ATT_LOADK(jd); ATT_LOADV(jd);
    for (int j = jd; j >= 0; --j) {
        const int s0 = 64 * j;
        f32x16 p0, p1; const float base = cq - mref;
        if (lane < 16) *(ALAS f32x4*)(bl + 4 * lane) = bpre;
#pragma unroll
        for (int jj = 0; jj < 4; ++jj) { const f32x4 a = *(const ALAS f32x4*)(bl + 8 * jj + 4 * hi), b = *(const ALAS f32x4*)(bl + 32 + 8 * jj + 4 * hi);
#pragma unroll
            for (int e = 0; e < 4; ++e) { p0[4 * jj + e] = base - a[e]; p1[4 * jj + e] = base - b[e]; } }
#pragma unroll
        for (int d0 = 0; d0 < 4; ++d0) { p0 = __builtin_amdgcn_mfma_f32_32x32x16_bf16(kf[2 * d0], qr[d0], p0, 0, 0, 0); p1 = __builtin_amdgcn_mfma_f32_32x32x16_bf16(kf[2 * d0 + 1], qr[d0], p1, 0, 0, 0); }
        if (j > 0) ATT_LOADK(j - 1);
        if (j == jd) { const int qp = qpos0 + r32;
#pragma unroll
            for (int r = 0; r < 16; ++r) { const int kv = s0 + crow(r, hi); if (kv > qp) p0[r] = -INFINITY; if (kv + 32 > qp) p1[r] = -INFINITY; } }
        float rm;
        { float a = fmaxf(p0[0], p1[0]);
#pragma unroll
          for (int r = 1; r < 16; ++r) a = fmaxf(a, fmaxf(p0[r], p1[r]));
          rm = fmaxf(a, __shfl_xor(a, 32)); }
        if (j == jd) {
            mref = rm;
#pragma unroll
            for (int r = 0; r < 16; ++r) { p0[r] -= rm; p1[r] -= rm; }
        } else if (__any(rm > 0.f)) {
            const float dl = fmaxf(rm, 0.f); mref += dl;
#pragma unroll
            for (int r = 0; r < 16; ++r) { p0[r] -= dl; p1[r] -= dl; }
            const float f = __builtin_amdgcn_exp2f(-dl); l *= f; if (hi == 0) wsf[r32] = f;
            asm volatile("s_waitcnt lgkmcnt(0)" ::: "memory");
#pragma unroll
            for (int d_ = 0; d_ < 2; ++d_)
#pragma unroll
                for (int r = 0; r < 16; ++r) o[d_][r] *= wsf[crow(r, hi)];
        }
        float sacc = 0.f;
#pragma unroll
        for (int r = 0; r < 16; ++r) { p0[r] = __builtin_amdgcn_exp2f(p0[r]); p1[r] = __builtin_amdgcn_exp2f(p1[r]); sacc += p0[r] + p1[r]; }
        l += sacc;
        u32x4 pw0, pw1, pw2, pw3;
        pw0 = (u32x4){cvtpk_s(p0[0], p0[1]), cvtpk_s(p0[2], p0[3]), cvtpk_s(p0[4], p0[5]), cvtpk_s(p0[6], p0[7])};
        pw1 = (u32x4){cvtpk_s(p0[8], p0[9]), cvtpk_s(p0[10], p0[11]), cvtpk_s(p0[12], p0[13]), cvtpk_s(p0[14], p0[15])};
        pw2 = (u32x4){cvtpk_s(p1[0], p1[1]), cvtpk_s(p1[2], p1[3]), cvtpk_s(p1[4], p1[5]), cvtpk_s(p1[6], p1[7])};
        pw3 = (u32x4){cvtpk_s(p1[8], p1[9]), cvtpk_s(p1[10], p1[11]), cvtpk_s(p1[12], p1[13]), cvtpk_s(p1[14], p1[15])};
        if (j > 0) asm volatile("s_waitcnt vmcnt(9)" ::: "memory"); else asm volatile("s_waitcnt vmcnt(0)" ::: "memory");
        pv(o, vp, __builtin_bit_cast(bf16x8, pw0), __builtin_bit_cast(bf16x8, pw1), __builtin_bit_cast(bf16x8, pw2), __builtin_bit_cast(bf16x8, pw3));
        asm volatile("s_waitcnt lgkmcnt(0)" ::: "memory");
#if ATT_EARLY_EXIT
        if (j > 0) { const float cl = __uint_as_float(__builtin_amdgcn_readlane(__float_as_uint(bpre[3]), 15));
            const float ub = qkb + (cq - cl) - mref; if (!__any(ub > ATT_EXIT_LOG2)) break; }
#endif
        if (j > 0) ATT_LOADV(j - 1);
    }
    l += __shfl_xor(l, 32);
    if (hi == 0) wsf[32 + r32] = l;
    asm volatile("s_waitcnt lgkmcnt(0)" ::: "memory");
    float rli[16];
#pragma unroll
    for (int r = 0; r < 16; ++r) rli[r] = 1.0f / wsf[32 + crow(r, hi)];
#pragma unroll
    for (int r = 0; r < 16; ++r) { const int orow = crow(r, hi);
#pragma unroll
        for (int d0 = 0; d0 < 2; ++d0) { const unsigned w = cvtpk_s(o[d0][r] * rli[r], 0.f); stg[orow * 64 + d0 * 32 + r32] = (bf16)(w & 0xffffu); } }
    asm volatile("s_waitcnt lgkmcnt(0)" ::: "memory");
#pragma unroll
    for (int i = 0; i < 4; ++i) { const int row = i * 8 + (lane >> 3), ch = lane & 7; const u32x4 v = *(const ALAS u32x4*)(stg + row * 64 + ch * 8); *(u32x4*)(Op + (size_t)row * 1024 + ch * 8) = v; }
    asm volatile("s_waitcnt lgkmcnt(0)" ::: "memory");
}

constexpr int G_K = 0, G_V = 16384, G_PW = 32768, G_PWB = 4096 + 256 + 256, G_FLAG = G_PW + 8 * G_PWB, G_BYTES = G_FLAG + 64;
__device__ __forceinline__ void wg_unit(const bf16* Qb, bf16* Ob, const bf16* Kp, const bf16* Vp, const float* ckl, int qbase, int nact, float kmaxn, ALAS unsigned char* L, int wave, int lane) {
    const int r32 = lane & 31, hi = lane >> 5;
    ALAS unsigned char* pw = L + G_PW + wave * G_PWB;
    ALAS bf16* stg = (ALAS bf16*)pw; ALAS float* wsf = (ALAS float*)(pw + 4096); ALAS float* bl = (ALAS float*)(pw + 4096 + 256);
    ALAS unsigned* flags = (ALAS unsigned*)(L + G_FLAG);
    const bool active = wave < nact;
    const int qpos0 = qbase + 32 * wave, jd = (qpos0 + 31) >> 6, jmax = (qbase + 32 * nact - 1) >> 6;
    __syncthreads();
    if (threadIdx.x < 16) flags[threadIdx.x] = 0u;
    const ALAS unsigned char* vpo = L + G_V + ((lane >> 4) & 1) * 32 + (lane & 3) * 8 + (4 * hi + ((lane & 15) >> 2)) * 64;
#define WG_DMA(JT) do { const int sl_ = ((JT) & 1) * 8192; \
        __builtin_amdgcn_global_load_lds((const unsigned*)(Kp + (size_t)(64 * (JT) + lane) * 1024 + 8 * wave), (ALAS unsigned*)(L + G_K + sl_ + wave * 1024), 16, 0, 0); \
        __builtin_amdgcn_global_load_lds((const unsigned*)(Vp + (size_t)(64 * (JT) + 16 * (wave & 3) + (lane >> 2)) * 1024 + 32 * (wave >> 2) + 8 * (lane & 3)), (ALAS unsigned*)(L + G_V + sl_ + wave * 1024), 16, 0, 0); } while (0)
    WG_DMA(jmax);
    bf16x8 qr[4]; float qkb = 0.f, cq = 0.f;
    if (active) {
#pragma unroll
        for (int d0 = 0; d0 < 4; ++d0) qr[d0] = *(const bf16x8*)(Qb + (size_t)(32 * wave + r32) * 1024 + d0 * 16 + hi * 8);
        float qn2 = 0.f;
#pragma unroll
        for (int d0 = 0; d0 < 4; ++d0)
#pragma unroll
            for (int e = 0; e < 8; ++e) { const float v = bf2f(qr[d0][e]); qn2 += v * v; }
        qn2 += __shfl_xor(qn2, 32);
        qkb = __builtin_amdgcn_sqrtf(qn2) * kmaxn * 1.03f + 1.0f;
        cq = ckl[qpos0 + r32];
    } else {
#pragma unroll
        for (int d0 = 0; d0 < 4; ++d0) qr[d0] = bf16x8{};
    }
    float mref = 0.f, l = 0.f; f32x16 o[2]; o[0] = f32x16{}; o[1] = f32x16{};
    f32x4 bpre = *(const f32x4*)(ckl + 64 * jmax + 4 * (lane & 15));
    bool done = false;
    for (int j = jmax; j >= 0; --j) {
        asm volatile("s_waitcnt vmcnt(0)" ::: "memory");
        __syncthreads();
        { unsigned nd = 0;
#pragma unroll
          for (int w = 0; w < 8; ++w) nd += (w < nact) ? flags[((j + 1) & 1) * 8 + w] : 0u;
          if (nd >= (unsigned)nact) break; }
        if (j > 0) WG_DMA(j - 1);
        const f32x4 bcur = bpre;
        if (j > 0) bpre = *(const f32x4*)(ckl + 64 * (j - 1) + 4 * (lane & 15));
        if (active && !done && j <= jd) {
            const ALAS unsigned char* ks = L + G_K + (j & 1) * 8192 + hi * 1024 + r32 * 16;
            f32x16 p0, p1; const float base = cq - mref;
            if (lane < 16) *(ALAS f32x4*)(bl + 4 * lane) = bcur;
            { f32x4 qa[4], qb[4];
#pragma unroll
              for (int jj = 0; jj < 4; ++jj) { qa[jj] = base - *(const ALAS f32x4*)(bl + 8 * jj + 4 * hi); qb[jj] = base - *(const ALAS f32x4*)(bl + 32 + 8 * jj + 4 * hi); }
              p0 = (f32x16){qa[0][0], qa[0][1], qa[0][2], qa[0][3], qa[1][0], qa[1][1], qa[1][2], qa[1][3], qa[2][0], qa[2][1], qa[2][2], qa[2][3], qa[3][0], qa[3][1], qa[3][2], qa[3][3]};
              p1 = (f32x16){qb[0][0], qb[0][1], qb[0][2], qb[0][3], qb[1][0], qb[1][1], qb[1][2], qb[1][3], qb[2][0], qb[2][1], qb[2][2], qb[2][3], qb[3][0], qb[3][1], qb[3][2], qb[3][3]}; }
#pragma unroll
            for (int d0 = 0; d0 < 4; ++d0) { const bf16x8 k0 = *(const ALAS bf16x8*)(ks + d0 * 2048), k1 = *(const ALAS bf16x8*)(ks + d0 * 2048 + 512);
                p0 = __builtin_amdgcn_mfma_f32_32x32x16_bf16(k0, qr[d0], p0, 0, 0, 0); p1 = __builtin_amdgcn_mfma_f32_32x32x16_bf16(k1, qr[d0], p1, 0, 0, 0); }
            if (j == jd) { const int qp = qpos0 + r32, s0 = 64 * j;
#pragma unroll
                for (int r = 0; r < 16; ++r) { const int kv = s0 + crow(r, hi); if (kv > qp) p0[r] = -INFINITY; if (kv + 32 > qp) p1[r] = -INFINITY; } }
            float rm;
            { float a = fmaxf(p0[0], p1[0]);
#pragma unroll
              for (int r = 1; r < 16; ++r) a = fmaxf(a, fmaxf(p0[r], p1[r]));
              rm = fmaxf(a, __shfl_xor(a, 32)); }
            if (j == jd) {
                mref = rm;
#pragma unroll
                for (int r = 0; r < 16; ++r) { p0[r] -= rm; p1[r] -= rm; }
            } else if (__any(rm > 0.f)) {
                const float dl = fmaxf(rm, 0.f); mref += dl;
#pragma unroll
                for (int r = 0; r < 16; ++r) { p0[r] -= dl; p1[r] -= dl; }
                const float f = __builtin_amdgcn_exp2f(-dl); l *= f; if (hi == 0) wsf[r32] = f;
                asm volatile("s_waitcnt lgkmcnt(0)" ::: "memory");
#pragma unroll
                for (int d_ = 0; d_ < 2; ++d_)
#pragma unroll
                    for (int r = 0; r < 16; ++r) o[d_][r] *= wsf[crow(r, hi)];
            }
#pragma unroll
            for (int r = 0; r < 16; ++r) { p0[r] = __builtin_amdgcn_exp2f(p0[r]); p1[r] = __builtin_amdgcn_exp2f(p1[r]); }
            { const f32x16 ps = p0 + p1;
              const f32x4 s4 = ((f32x4){ps[0], ps[1], ps[2], ps[3]} + (f32x4){ps[4], ps[5], ps[6], ps[7]}) + ((f32x4){ps[8], ps[9], ps[10], ps[11]} + (f32x4){ps[12], ps[13], ps[14], ps[15]});
              l += (s4[0] + s4[1]) + (s4[2] + s4[3]); }
            u32x4 pw0, pw1, pw2, pw3;
            pw0 = (u32x4){cvtpk_s(p0[0], p0[1]), cvtpk_s(p0[2], p0[3]), cvtpk_s(p0[4], p0[5]), cvtpk_s(p0[6], p0[7])};
            pw1 = (u32x4){cvtpk_s(p0[8], p0[9]), cvtpk_s(p0[10], p0[11]), cvtpk_s(p0[12], p0[13]), cvtpk_s(p0[14], p0[15])};
            pw2 = (u32x4){cvtpk_s(p1[0], p1[1]), cvtpk_s(p1[2], p1[3]), cvtpk_s(p1[4], p1[5]), cvtpk_s(p1[6], p1[7])};
            pw3 = (u32x4){cvtpk_s(p1[8], p1[9]), cvtpk_s(p1[10], p1[11]), cvtpk_s(p1[12], p1[13]), cvtpk_s(p1[14], p1[15])};
            pv(o, vpo + (j & 1) * 8192, __builtin_bit_cast(bf16x8, pw0), __builtin_bit_cast(bf16x8, pw1), __builtin_bit_cast(bf16x8, pw2), __builtin_bit_cast(bf16x8, pw3));
            if (j == 0) done = true;
            else { const float cl = __uint_as_float(__builtin_amdgcn_readlane(__float_as_uint(bpre[3]), 15));
                const float ub = qkb + (cq - cl) - mref; if (!__any(ub > ATT_EXIT_LOG2)) done = true; }
        }
        if (lane == 0) flags[(j & 1) * 8 + wave] = done ? 1u : 0u;
        asm volatile("s_waitcnt lgkmcnt(0)" ::: "memory");
    }
    if (active) {
        l += __shfl_xor(l, 32);
        if (hi == 0) wsf[32 + r32] = l;
        asm volatile("s_waitcnt lgkmcnt(0)" ::: "memory");
        float rli[16];
#pragma unroll
        for (int r = 0; r < 16; ++r) rli[r] = 1.0f / wsf[32 + crow(r, hi)];
#pragma unroll
        for (int r = 0; r < 16; ++r) { const int orow = crow(r, hi);
#pragma unroll
            for (int d0 = 0; d0 < 2; ++d0) { const unsigned w = cvtpk_s(o[d0][r] * rli[r], 0.f); stg[orow * 64 + d0 * 32 + r32] = (bf16)(w & 0xffffu); } }
        asm volatile("s_waitcnt lgkmcnt(0)" ::: "memory");
        bf16* Op = Ob + (size_t)(32 * wave) * 1024;
#pragma unroll
        for (int i = 0; i < 4; ++i) { const int row = i * 8 + (lane >> 3), ch = lane & 7; const u32x4 v = *(const ALAS u32x4*)(stg + row * 64 + ch * 8); *(u32x4*)(Op + (size_t)row * 1024 + ch * 8) = v; }
        asm volatile("s_waitcnt lgkmcnt(0)" ::: "memory");
    }
#undef WG_DMA
}
#undef ATT_LOADK
#undef ATT_LOADV
}

constexpr int NWAVES = 8;
constexpr int DM = 1024, FF = 2816, NH = 16;
constexpr int MP = 16384, MS = 512, M = MP + MS;
constexpr int TP = 8192, TS = 64, PAST = 2048, TKS = PAST + TS;
constexpr float C2 = 0.125f * 1.4426950408889634f;
constexpr float LOG2E = 1.4426950408889634f;
#ifndef MK_N_LAUNCHES
#define MK_N_LAUNCHES 1
#endif
constexpr int NPHASE = 15;
#ifndef PROBE_P0_REPS
#define PROBE_P0_REPS 1
#endif
#ifndef PROBE_P3_REPS
#define PROBE_P3_REPS 1
#endif
#ifndef PROBE_P1_REPS
#define PROBE_P1_REPS 1
#endif
#ifndef PROBE_P2_REPS
#define PROBE_P2_REPS 1
#endif
#ifndef PROBE_P9_REPS
#define PROBE_P9_REPS 1
#endif
#ifndef PROBE_P7_REPS
#define PROBE_P7_REPS 1
#endif
#ifndef USE_XCD_BAR
#define USE_XCD_BAR 1
#endif
#ifndef RUNTIME_DELAY
#define RUNTIME_DELAY 0
#endif
#ifndef RUNTIME_USE_CG
#define RUNTIME_USE_CG 0
#endif
#ifndef PROBE_ATT_REPS
#define PROBE_ATT_REPS 1
#endif
constexpr size_t OFF_Y = 0, OFF_POOLP = 17301504, OFF_POOLS = 17332224, OFF_LFP = 51009536, OFF_LFS = 52320256, OUT_TOTAL = 52328448;
constexpr size_t MiB = 1u << 20;
constexpr size_t WS_BAR = 65536, WS_CNT = 131072;
constexpr size_t WS_KMX = 0, WS_SS = 1 * MiB, WS_CKLP = 3 * MiB, WS_CKLS = 4 * MiB, WS_WFG = 6 * MiB, WS_WPOOL = 7 * MiB;
constexpr size_t WS_WKVIN = 8 * MiB  , WS_WIN00 = 23 * MiB, WS_WIN01 = 34 * MiB, WS_WIN11 = 45 * MiB, WS_WOUT = 56 * MiB  ;
constexpr size_t WOUT_BYTES = (size_t)DM * FF * 2;
constexpr size_t WS_WQ = 78 * MiB, WS_WO = 80 * MiB, WS_XB = 82 * MiB, WS_ACT = 115 * MiB, WS_QO = WS_ACT, WS_DP = WS_ACT + 33 * MiB;
constexpr size_t WS_KB = 206 * MiB, WS_VB = 238 * MiB, WS_KS = 270 * MiB, WS_VS = 303 * MiB, WS_END = 336 * MiB;
static_assert(WS_WOUT + 4 * WOUT_BYTES <= WS_WQ && WS_XB + (size_t)M * DM * 2 <= WS_ACT && WS_ACT + (size_t)M * FF * 2 <= WS_KB && WS_DP + (size_t)M * DM * 2 <= WS_KB, "ws map");
static_assert(WS_KS + (size_t)8 * TKS * DM * 2 <= WS_VS && WS_VS + (size_t)8 * TKS * DM * 2 <= WS_END && WS_CKLS + (size_t)8 * 16 * TKS * 4 <= WS_WFG, "ws map 2");
constexpr int RING_BYTES = 131072, LDS_BYTES = 147456;

#define LAS __attribute__((address_space(3)))
typedef unsigned short bf16;
typedef unsigned v4u __attribute__((ext_vector_type(4)));
typedef unsigned v2u __attribute__((ext_vector_type(2)));
typedef float f32x4 __attribute__((ext_vector_type(4)));
typedef float f32x2 __attribute__((ext_vector_type(2)));
typedef short bf16x8 __attribute__((ext_vector_type(8)));
#define LDS_WAIT() asm volatile("s_waitcnt lgkmcnt(0)" ::: "memory")
__device__ __forceinline__ unsigned pk2(float lo, float hi) { return pg8::cvt_pk_bf16(lo, hi); }
__device__ __forceinline__ float wave_sum(float v) {
#pragma unroll
    for (int o = 1; o < 64; o <<= 1) v += __shfl_xor(v, o);
    return v;
}
__device__ __forceinline__ void tr_item(const float* W, int K, int N, bf16* WT, int k0, int n0, int drow0, const float* gain, int lane) {
    const int kg = lane >> 3, nl = lane & 7;
    const float* src = W + (size_t)(k0 + 8 * kg) * N + n0 + 4 * nl;
    f32x4 v[8];
#pragma unroll
    for (int i = 0; i < 8; ++i) v[i] = __builtin_nontemporal_load((const f32x4*)(src + (size_t)i * N));
    if (gain) { const f32x4 g0 = *(const f32x4*)(gain + k0 + 8 * kg), g1 = *(const f32x4*)(gain + k0 + 8 * kg + 4);
#pragma unroll
        for (int i = 0; i < 4; ++i) { v[i] = v[i] * g0[i]; v[4 + i] = v[4 + i] * g1[i]; } }
#pragma unroll
    for (int e = 0; e < 4; ++e) { v4u o; o.x = pk2(v[0][e], v[1][e]); o.y = pk2(v[2][e], v[3][e]); o.z = pk2(v[4][e], v[5][e]); o.w = pk2(v[6][e], v[7][e]);
        *(v4u*)(WT + (size_t)(drow0 + 4 * nl + e) * K + k0 + 8 * kg) = o; }
}
template <int W> __device__ __forceinline__ void pool_emit(const f32x4 (&u)[31], int posbase, int t0, bf16* dst  ) {
#pragma unroll
    for (int i = 0; i < 16; ++i) {
        f32x4 s = {0.f, 0.f, 0.f, 0.f};
#pragma unroll
        for (int j = W - 1; j >= 0; --j) s += u[15 + i - j];
        const int pos = posbase + t0 + i; const float cnt = (float)(pos + 1 < W ? pos + 1 : W);
        const f32x4 d = s / cnt - u[15 + i];
        v2u w; w.x = pk2(d[0], d[1]); w.y = pk2(d[2], d[3]);
        *(v2u*)(dst + (size_t)i * 256) = w;
    }
}

#define XB_TMO      128
#define XB_XCNT(j)  (256  + 64 * (j))
#define XB_XSUB(j)  (1280 + 64 * (j))
#define XB_XGEN(j)  (2304 + 64 * (j))
#define XB_TOP      3328
#define XB_TOPGEN   3392
#define XCD_BAR_WORDS 3456
#define XB_SPIN_CAP (1u << 18)

__device__ __forceinline__ unsigned xb_ld(unsigned* p)              { return __hip_atomic_load(p, __ATOMIC_RELAXED, __HIP_MEMORY_SCOPE_AGENT); }
__device__ __forceinline__ unsigned xb_add(unsigned* p, unsigned v) { return __hip_atomic_fetch_add(p, v, __ATOMIC_RELAXED, __HIP_MEMORY_SCOPE_AGENT); }
__device__ __forceinline__ unsigned xb_xcc_id() { return (unsigned)__builtin_amdgcn_s_getreg((3 << 11) | 20) & 0xFu; }
#define XB_SPIN(cond, bar) do { unsigned _sp = 0; while (cond) { __builtin_amdgcn_s_sleep(1); \
    if ((++_sp & 255u) == 0u) { if (xb_ld(&(bar)[XB_TMO])) break; if (_sp > XB_SPIN_CAP) { atomicAdd(&(bar)[XB_TMO], 1u); break; } } } } while (0)

struct XcdBarrier {
    unsigned* bar; unsigned x;
    volatile LAS unsigned* st;
};

__device__ __forceinline__ XcdBarrier xcd_barrier_post(unsigned* bar, volatile LAS unsigned* st) {
    XcdBarrier b; b.bar = bar; b.x = xb_xcc_id(); b.st = st;
    if (threadIdx.x == 0) (void)xb_add(&bar[XB_XCNT(b.x)], 1u);
    return b;
}
__device__ __forceinline__ void xcd_barrier_complete(unsigned* bar, unsigned x, unsigned& nloc, unsigned& nx) {
    const unsigned G = gridDim.x * gridDim.y * gridDim.z;
    unsigned sum, cnt, mine, sp = 0u;
    for (;;) {
        sum = 0u; cnt = 0u; mine = 0u;
#pragma unroll
        for (unsigned j = 0; j < 16; ++j) { const unsigned c = xb_ld(&bar[XB_XCNT(j)]); sum += c; cnt += (c > 0u) ? 1u : 0u; mine = (j == x) ? c : mine; }
        if (sum == G) break;
        __builtin_amdgcn_s_sleep(1);
        if ((++sp & 255u) == 0u) { if (xb_ld(&bar[XB_TMO])) break; if (sp > XB_SPIN_CAP) { atomicAdd(&bar[XB_TMO], 1u); break; } }
    }
    nloc = mine > 0u ? mine : 1u; nx = cnt > 0u ? cnt : 1u;
}

__device__ __forceinline__ void xcd_barrier(const XcdBarrier& b) {
    asm volatile("s_waitcnt vmcnt(0)" ::: "memory");
    __syncthreads();
    if (threadIdx.x == 0) {
        unsigned* bar = b.bar;
        __builtin_amdgcn_s_waitcnt(0);
        unsigned nloc = b.st[0], nx = b.st[1];
        if (nloc == 0u) { xcd_barrier_complete(bar, b.x, nloc, nx); b.st[0] = nloc; b.st[1] = nx; }
        const unsigned old = xb_add(&bar[XB_XSUB(b.x)], 1u);
        const unsigned gen = old / nloc;
        if (old + 1u == (gen + 1u) * nloc) {
            __builtin_amdgcn_fence(__ATOMIC_RELEASE, "agent");
            asm volatile("s_waitcnt vmcnt(0)" ::: "memory");
            const unsigned og = xb_add(&bar[XB_TOP], 1u);
            const unsigned tg = og / nx;
            if (og + 1u == (tg + 1u) * nx) xb_add(&bar[XB_TOPGEN], 1u);
            else XB_SPIN(xb_ld(&bar[XB_TOPGEN]) == tg, bar);
            __builtin_amdgcn_fence(__ATOMIC_ACQUIRE, "agent");
            xb_add(&bar[XB_XGEN(b.x)], 1u);
            asm volatile("s_waitcnt vmcnt(0)" ::: "memory");
        } else {
            XB_SPIN(xb_ld(&bar[XB_XGEN(b.x)]) == gen, bar);
            __builtin_amdgcn_fence(__ATOMIC_ACQUIRE, "agent");
            asm volatile("s_waitcnt vmcnt(0)" ::: "memory");
        }
    }
    __syncthreads();
}
#define GB_SUB(g) (64 * (g))
#define GB_GEN(g) (512 + 64 * (g))
#define GB_TOP 1024
#define GB_TOPGEN 1088
__device__ __forceinline__ void grp_barrier(unsigned* gb, int delay) {
    asm volatile("s_waitcnt vmcnt(0)" ::: "memory");
    __syncthreads();
    if (threadIdx.x == 0) {
        __builtin_amdgcn_fence(__ATOMIC_RELEASE, "agent");
        asm volatile("s_waitcnt vmcnt(0)" ::: "memory");
        for (int d_ = 0; d_ < delay; ++d_) __builtin_amdgcn_s_sleep(16);
        const unsigned g = blockIdx.x & 7u, nloc = gridDim.x >> 3;
        const unsigned old = xb_add(&gb[GB_SUB(g)], 1u), gen = old / nloc;
        if (old + 1u == (gen + 1u) * nloc) {
            const unsigned og = xb_add(&gb[GB_TOP], 1u), tg = og >> 3;
            if (og + 1u == (tg + 1u) * 8u) xb_add(&gb[GB_TOPGEN], 1u);
            else { unsigned sp = 0; while (xb_ld(&gb[GB_TOPGEN]) == tg) { __builtin_amdgcn_s_sleep(1); if (++sp > (1u << 24)) break; } }
            xb_add(&gb[GB_GEN(g)], 1u);
        } else { unsigned sp = 0; while (xb_ld(&gb[GB_GEN(g)]) == gen) { __builtin_amdgcn_s_sleep(1); if (++sp > (1u << 24)) break; } }
        __builtin_amdgcn_fence(__ATOMIC_ACQUIRE, "agent");
        asm volatile("s_waitcnt vmcnt(0)" ::: "memory");
    }
    __syncthreads();
}
struct Args { const float* in[20]; float* out; unsigned char* ws; int ph_lo, ph_hi, use_cg, pad; };

__global__ void __launch_bounds__(NWAVES * 64, 2) mega_fwd(Args args) {
    extern __shared__ __attribute__((aligned(16))) unsigned char lds_raw[];
    cg::grid_group grid = cg::this_grid();
    LAS unsigned char* lds = (LAS unsigned char*)lds_raw;
    const int tid = threadIdx.x, lane = tid & 63, wave = __builtin_amdgcn_readfirstlane(tid >> 6);
    const int G = gridDim.x, bx = blockIdx.x;
    const int gw = bx * NWAVES + wave, NGW = G * NWAVES;
    unsigned char* ws = args.ws; float* dout = args.out;
    const float* x_prompt = args.in[0]; const float* x_sample = args.in[1]; const float* cache_pool = args.in[2];
    const float* cache_k = args.in[3]; const float* cache_v = args.in[4]; const float* cache_logf = args.in[5];
    const float* ln_ffn1 = args.in[6]; const float* ln_mix = args.in[7]; const float* ln_ffn2 = args.in[8];
    const float* w_ffn_in = args.in[9]; const float* w_ffn_out = args.in[10]; const float* w_pool = args.in[11]; const float* pool_scale = args.in[12];
    const float* ln_kv = args.in[13]; const float* w_kv = args.in[14]; const float* w_fgate = args.in[15]; const float* b_fgate = args.in[16];
    const float* w_q = args.in[17]; const float* w_o = args.in[18]; const float* ln_final = args.in[19];
    unsigned* KMX = (unsigned*)(ws + WS_KMX); float* SS = (float*)(ws + WS_SS); float* CKLP = (float*)(ws + WS_CKLP); float* CKLS = (float*)(ws + WS_CKLS);
    bf16* WFG = (bf16*)(ws + WS_WFG); bf16* WPOOL = (bf16*)(ws + WS_WPOOL); bf16* WKVIN = (bf16*)(ws + WS_WKVIN);
    bf16* WIN00 = (bf16*)(ws + WS_WIN00); bf16* WIN01 = (bf16*)(ws + WS_WIN01); bf16* WIN11 = (bf16*)(ws + WS_WIN11);
    bf16* WQ = (bf16*)(ws + WS_WQ); bf16* WO = (bf16*)(ws + WS_WO); bf16* XB = (bf16*)(ws + WS_XB); bf16* ACT = (bf16*)(ws + WS_ACT); bf16* QO = (bf16*)(ws + WS_QO); bf16* DP = (bf16*)(ws + WS_DP); bf16* OB = DP;
    bf16* KB = (bf16*)(ws + WS_KB); bf16* VB = (bf16*)(ws + WS_VB); bf16* KS = (bf16*)(ws + WS_KS); bf16* VS = (bf16*)(ws + WS_VS);
    float* X32 = dout + OFF_Y;
    const int lo = args.ph_lo, hi = args.ph_hi;
#define IN(k) (lo <= (k) && (k) < hi)
    volatile LAS unsigned* MISC = (volatile LAS unsigned*)(lds + LDS_BYTES - 256);
    LAS unsigned* LCNT = (LAS unsigned*)(lds + LDS_BYTES - 1024);
    if (tid < 32) MISC[tid] = 0u;
    if (tid == 32) *LCNT = 0u;
    __syncthreads();
    unsigned* barw = (unsigned*)(ws + WS_BAR); unsigned* CNT = (unsigned*)(ws + WS_CNT);
    XcdBarrier bar; bar.bar = barw; bar.x = 0; bar.st = nullptr;
#define SEAM(k) do { if (IN(k) && IN((k) + 1)) { if ((k) == lo) { grid.sync(); bar = xcd_barrier_post(barw, MISC + 8); } else xcd_barrier(bar); } } while (0)
#define GEMM_PHASE(EPI, E, Aptr, Bptr, Kdim, LDA, PNSTEP, NCOLS) do { pg8::Gemm g_{(const pg8::bf16_t*)(Aptr), (const pg8::bf16_t*)(Bptr), (Kdim), (LDA), (size_t)(PNSTEP)}; \
        pg8::StaticOrder S_; S_.init(M, (NCOLS), G, bx); pg8::gemm_phase<EPI, pg8::StaticOrder, true, true>(lds, g_, S_, E); } while (0)

#define RIDE_PHASE(EPI, E, Bptr, NTILES, SLOT, WOUTP, BASE_LO, BASE_HI, OUT32) do {   \
        { pg8::Gemm g_{(const pg8::bf16_t*)XB, (const pg8::bf16_t*)(Bptr), DM, DM, (size_t)0}; pg8::RideOrder S_; S_.init((NTILES), bx); pg8::gemm_phase<EPI, pg8::RideOrder, true, true>(lds, g_, S_, E); } \
        if (bx >= 248) { const int s_ = bx - 248, pan_ = s_ >> 2; unsigned* cw_ = CNT + 128 * (SLOT) + 64 * pan_; \
            if (tid == 0) { unsigned sp_ = 0; while (__hip_atomic_load(cw_, __ATOMIC_RELAXED, __HIP_MEMORY_SCOPE_AGENT) < (unsigned)(NTILES) * 8u) { __builtin_amdgcn_s_sleep(2); if (++sp_ > (1u << 22)) break; } } \
            __syncthreads(); __builtin_amdgcn_fence(__ATOMIC_ACQUIRE, "agent"); asm volatile("s_waitcnt vmcnt(0)" ::: "memory"); \
            pg8::Gemm g2_{(const pg8::bf16_t*)ACT, (const pg8::bf16_t*)(WOUTP), FF, FF, (size_t)0}; pg8::OneUnit S2_{64 + pan_, s_ & 3}; \
            pg8::EpiRes E2_{(BASE_LO), (BASE_HI), (OUT32), XB, SS, nullptr, 0.5f}; pg8::gemm_phase<pg8::EpiRes, pg8::OneUnit, true, true>(lds, g2_, S2_, E2_); } } while (0)
#define GEMM_PROMPT(EPI, E, Aptr, Bptr, Kdim, LDA, NCOLS) do { pg8::Gemm g_{(const pg8::bf16_t*)(Aptr), (const pg8::bf16_t*)(Bptr), (Kdim), (LDA), (size_t)0}; \
        pg8::StaticOrder S_; S_.init(MP, (NCOLS), G, bx); pg8::gemm_phase<EPI, pg8::StaticOrder, true, true>(lds, g_, S_, E); } while (0)

#define FGATE_ROWS(IT0, IT1, W0, NW) do { \
        const int fr = lane & 15, fq = lane >> 4; \
        for (int it = (IT0) + (W0); it < (IT1); it += (NW)) { \
            const int row = it * 16 + fr; f32x4 acc = {0.f, 0.f, 0.f, 0.f}; \
            const bf16* ap = XB + (size_t)row * DM + 8 * fq; const bf16* bp = WFG + (size_t)fr * DM + 8 * fq; \
_Pragma("unroll 16") \
            for (int ks = 0; ks < 32; ++ks) { const bf16x8 av = *(const bf16x8*)(ap + 32 * ks), bv = *(const bf16x8*)(bp + 32 * ks); acc = __builtin_amdgcn_mfma_f32_16x16x32_bf16(bv, av, acc, 0, 0, 0); } \
            const float rs = pg8::row_rstd(SS, row); const f32x4 bb = *(const f32x4*)(b_fgate + 4 * fq); f32x4 lf; \
_Pragma("unroll") \
            for (int e = 0; e < 4; ++e) { const float z = acc[e] * rs + bb[e]; lf[e] = fminf(z, 0.f) - 0.6931471805599453f * __builtin_amdgcn_logf(1.0f + __builtin_amdgcn_exp2f(-1.4426950408889634f * fabsf(z))); }   \
            float* dp = (row < MP) ? dout + OFF_LFP + (size_t)row * 16 : dout + OFF_LFS + (size_t)(row - MP) * 16; \
            *(f32x4*)(dp + 4 * fq) = lf; \
        } \
    } while (0)

    if (IN(0)) for (int rep0 = 0; rep0 < PROBE_P0_REPS; ++rep0) {
        constexpr int I_IN = 16 * 176, I_OUT = 44 * 32, I_KV = 16 * 64, I_Q = 16 * 32, I_P = 4 * 8;
        constexpr int NITEMS = 4 * I_IN + 4 * I_OUT + I_KV + 2 * I_Q + 4 * I_P;
        for (int it = gw; it < NITEMS; it += NGW) {
            int r = it;
            if (r < 4 * I_IN) { const int f = r / I_IN; r -= f * I_IN; const int kb = r / 176, nb = r % 176, n0 = 32 * nb;
                const int drow = (n0 < FF) ? (n0 >> 7) * 256 + (n0 & 127) : ((n0 - FF) >> 7) * 256 + 128 + ((n0 - FF) & 127);
                bf16* dst = (f == 0) ? WIN00 : (f == 1) ? WIN01 : (f == 2) ? WKVIN + (size_t)2048 * DM : WIN11;
                const float* gain = ((f & 1) ? ln_ffn2 : ln_ffn1) + (f >> 1) * DM;
                tr_item(w_ffn_in + (size_t)f * DM * 2 * FF, DM, 2 * FF, dst, 64 * kb, n0, drow, gain, lane); continue; }
            r -= 4 * I_IN;
            if (r < 4 * I_OUT) { const int f = r / I_OUT; r -= f * I_OUT; const int kb = r / 32, nb = r % 32;
                tr_item(w_ffn_out + (size_t)f * FF * DM, FF, DM, (bf16*)(ws + WS_WOUT + f * WOUT_BYTES), 64 * kb, 32 * nb, 32 * nb, nullptr, lane); continue; }
            r -= 4 * I_OUT;
            if (r < I_KV) { const int kb = r / 64, nb = r % 64; tr_item(w_kv, DM, 2048, WKVIN, 64 * kb, 32 * nb, 32 * nb, ln_kv, lane); continue; }
            r -= I_KV;
            if (r < I_Q) { const int kb = r / 32, nb = r % 32; tr_item(w_q, DM, DM, WQ, 64 * kb, 32 * nb, 32 * nb, ln_mix + DM, lane); continue; }
            r -= I_Q;
            if (r < I_Q) { const int kb = r / 32, nb = r % 32; tr_item(w_o, DM, DM, WO, 64 * kb, 32 * nb, 32 * nb, nullptr, lane); continue; }
            r -= I_Q;
            { const int gq = r / I_P; r -= gq * I_P; const int kb = r / 8, nb = r % 8; tr_item(w_pool + (size_t)gq * 65536, 256, 256, WPOOL, 64 * kb, 32 * nb, gq * 256 + 32 * nb, nullptr, lane); }
        }
        for (int i = bx * 512 + tid; i < 16 * DM; i += G * 512) { const int n = i >> 10, k = i & 1023; WFG[i] = (bf16)(pk2(w_fgate[k * 16 + n] * ln_kv[k], 0.f) & 0xffffu); }
        if (bx == 0) { if (tid < 320) KMX[tid] = 0u; for (int i = tid; i < XCD_BAR_WORDS; i += 512) barw[i] = 0u; CNT[tid] = 0u; }
        for (int m0 = gw; m0 < M; m0 += 2 * NGW) {
            const int m1 = (m0 + NGW < M) ? m0 + NGW : m0;
            const float* xr0 = (m0 < MP) ? x_prompt + (size_t)m0 * DM : x_sample + (size_t)(m0 - MP) * DM;
            const float* xr1 = (m1 < MP) ? x_prompt + (size_t)m1 * DM : x_sample + (size_t)(m1 - MP) * DM;
            const f32x4* xv0 = (const f32x4*)xr0 + lane; const f32x4* xv1 = (const f32x4*)xr1 + lane; f32x4 v0[4], v1[4]; float s0 = 0.f, s1 = 0.f;
#pragma unroll
            for (int j = 0; j < 4; ++j) { v0[j] = __builtin_nontemporal_load(xv0 + 64 * j); v1[j] = __builtin_nontemporal_load(xv1 + 64 * j); }
#pragma unroll
            for (int j = 0; j < 4; ++j) { s0 += (v0[j].x * v0[j].x + v0[j].y * v0[j].y) + (v0[j].z * v0[j].z + v0[j].w * v0[j].w); s1 += (v1[j].x * v1[j].x + v1[j].y * v1[j].y) + (v1[j].z * v1[j].z + v1[j].w * v1[j].w); }
            s0 = wave_sum(s0); s1 = wave_sum(s1);
            v2u* o0 = (v2u*)(XB + (size_t)m0 * DM) + lane; v2u* o1 = (v2u*)(XB + (size_t)m1 * DM) + lane;
#pragma unroll
            for (int j = 0; j < 4; ++j) { v2u w; w.x = pk2(v0[j].x, v0[j].y); w.y = pk2(v0[j].z, v0[j].w); o0[64 * j] = w; w.x = pk2(v1[j].x, v1[j].y); w.y = pk2(v1[j].z, v1[j].w); o1[64 * j] = w; }
            if (lane < 16) { SS[(size_t)m0 * 16 + lane] = (lane == 0) ? s0 : 0.f; SS[(size_t)m1 * 16 + lane] = (lane == 0) ? s1 : 0.f; }
        }
    }
    SEAM(0);
    if (IN(1) && PROBE_P1_REPS > 1) { pg8::EpiSwiglu E{ACT, SS, 0, nullptr, LCNT}; GEMM_PROMPT(pg8::EpiSwiglu, E, XB, WIN00, DM, DM, 2 * FF); }
    if (IN(1)) { pg8::EpiSwiglu E{ACT, SS, 0, CNT + 128 * 0, LCNT}; RIDE_PHASE(pg8::EpiSwiglu, E, WIN00, 22, 0, ws + WS_WOUT, x_prompt, x_sample, (float*)nullptr); }
    SEAM(1);
    if (IN(2) && PROBE_P2_REPS > 1) { pg8::EpiRes E{x_prompt, x_sample, nullptr, XB, SS, nullptr, 0.5f}; GEMM_PROMPT(pg8::EpiRes, E, ACT, ws + WS_WOUT, FF, FF, DM); }
    if (IN(2)) { pg8::EpiRes E{x_prompt, x_sample, nullptr, XB, SS, nullptr, 0.5f}; GEMM_PROMPT(pg8::EpiRes, E, ACT, ws + WS_WOUT, FF, FF, DM); }
    SEAM(2);
    if (IN(3)) for (int rep3 = 0; rep3 < PROBE_P3_REPS; ++rep3) {
        LAS float* rsl = (LAS float*)lds;
        const int hb = tid >> 8, t2 = tid & 255;
        for (int it3 = 0; it3 < 3; ++it3) {
            const int item = 2 * bx + hb + 512 * it3; const bool valid = item < 1024 + 32;
            int sb = 0, ch = 0; if (item < 1024) { sb = item >> 9; ch = item & 511; } else if (valid) { const int r = item - 1024; sb = 2 + (r >> 2); ch = r & 3; }
            const bool prompt = sb < 2; const int T = prompt ? TP : TS, t0 = ch * 16, grow0 = prompt ? sb * TP : MP + (sb - 2) * TS;
            if (valid && t2 < 31) { const int t = t0 - 15 + t2; rsl[hb * 32 + t2] = (t >= 0) ? pg8::row_rstd(SS, grow0 + t) : 0.f; }
            __syncthreads();
            if (valid) {
                const int c = 4 * t2; const f32x4 g4 = *(const f32x4*)(ln_mix + c);
                f32x4 u[31];
#pragma unroll
                for (int i = 0; i < 31; ++i) { const int t = t0 - 15 + i;
                    if (t >= 0) { const v2u xw = *(const v2u*)(XB + (size_t)(grow0 + t) * DM + c); const float rs = rsl[hb * 32 + i];
                        u[i] = (f32x4){__uint_as_float(xw.x << 16), __uint_as_float(xw.x & 0xffff0000u), __uint_as_float(xw.y << 16), __uint_as_float(xw.y & 0xffff0000u)} * rs * g4; }
                    else if (!prompt) u[i] = *(const f32x4*)(cache_pool + (size_t)((sb - 2) * 15 + 15 + t) * DM + c);
                    else u[i] = (f32x4){0.f, 0.f, 0.f, 0.f}; }
                const int gq = c >> 8, posbase = prompt ? 0 : PAST;
                bf16* dst = DP + (size_t)gq * M * 256 + (size_t)(grow0 + t0) * 256 + (c & 255);
                if (gq == 0) pool_emit<2>(u, posbase, t0, dst); else if (gq == 1) pool_emit<4>(u, posbase, t0, dst); else if (gq == 2) pool_emit<8>(u, posbase, t0, dst); else pool_emit<16>(u, posbase, t0, dst);
                float* pout = dout + (prompt ? OFF_POOLP + (size_t)sb * 15 * DM : OFF_POOLS + (size_t)(sb - 2) * 15 * DM);
#pragma unroll
                for (int i = 0; i < 16; ++i) { const int t = t0 + i; if (t >= T - 15) *(f32x4*)(pout + (size_t)(t - (T - 15)) * DM + c) = u[15 + i]; }
            }
            __syncthreads();
        }
    }
    SEAM(3);
    if (IN(4)) { pg8::EpiRes E{nullptr, nullptr, nullptr, XB, SS, pool_scale, 1.0f}; GEMM_PHASE(pg8::EpiRes, E, DP, WPOOL, 256, 256, (size_t)M * 256 * 2, DM); }
    SEAM(4);
    if (IN(5)) { pg8::EpiSwiglu E{ACT, SS, 0, CNT + 128 * 1, LCNT}; RIDE_PHASE(pg8::EpiSwiglu, E, WIN01, 22, 1, ws + WS_WOUT + WOUT_BYTES, (const float*)nullptr, (const float*)nullptr, (float*)nullptr); }
    SEAM(5);
    if (IN(6)) { pg8::EpiRes E{nullptr, nullptr, nullptr, XB, SS, nullptr, 0.5f}; GEMM_PROMPT(pg8::EpiRes, E, ACT, ws + WS_WOUT + WOUT_BYTES, FF, FF, DM);
        FGATE_ROWS(MP / 16, M / 16, gw, NGW); }
    SEAM(6);
    if (IN(7) && PROBE_P7_REPS > 1) { pg8::EpiKVSwiglu E{pg8::EpiKV{dout, KB, VB, KS, VS, SS, KMX, nullptr}, pg8::EpiSwiglu{ACT, SS, 8, nullptr, LCNT}}; GEMM_PROMPT(pg8::EpiKVSwiglu, E, XB, WKVIN, DM, DM, 2048 + 2 * FF); }
    if (IN(7)) {
        pg8::EpiKVSwiglu E{pg8::EpiKV{dout, KB, VB, KS, VS, SS, KMX, CNT + 128 * 2}, pg8::EpiSwiglu{ACT, SS, 8, CNT + 128 * 2, LCNT}};
        RIDE_PHASE(pg8::EpiKVSwiglu, E, WKVIN, 30, 2, ws + WS_WOUT + 2 * WOUT_BYTES, (const float*)nullptr, (const float*)nullptr, (float*)nullptr);
        FGATE_ROWS(0, MP / 16, gw, NGW);
    }
    SEAM(7);
    if (IN(8)) {
        pg8::EpiRes E{nullptr, nullptr, nullptr, XB, SS, nullptr, 0.5f}; GEMM_PROMPT(pg8::EpiRes, E, ACT, ws + WS_WOUT + 2 * WOUT_BYTES, FF, FF, DM);
    }
    SEAM(8);
    if (IN(9)) for (int rep9 = 0; rep9 < PROBE_P9_REPS; ++rep9) { { pg8::EpiQ E{QO, SS, C2}; GEMM_PHASE(pg8::EpiQ, E, XB, WQ, DM, DM, 0, DM); }
        if (bx >= 8 && bx < 246) {
            LAS float* red = (LAS float*)lds;
            for (int ch = bx - 8; ch < 1024; ch += 238) {
                const int b = ch >> 7; float mx[4] = {0.f, 0.f, 0.f, 0.f};
                for (int i = 0; i < 2; ++i) {
                    const int r = ch * 16 + wave * 2 + i, s = r & 2047;
                    const f32x4* kx = (const f32x4*)(cache_k + (size_t)r * DM) + lane; const f32x4* vx = (const f32x4*)(cache_v + (size_t)r * DM) + lane;
                    f32x4 kv[4], vv[4];
#pragma unroll
                    for (int j = 0; j < 4; ++j) { kv[j] = __builtin_nontemporal_load(kx + 64 * j); vv[j] = __builtin_nontemporal_load(vx + 64 * j); }
                    v2u* ko = (v2u*)(KS + (size_t)(b * TKS + s) * DM) + lane; v2u* vo = (v2u*)(VS + (size_t)(b * TKS + s) * DM) + lane;
#pragma unroll
                    for (int j = 0; j < 4; ++j) { v2u w; w.x = pk2(kv[j].x, kv[j].y); w.y = pk2(kv[j].z, kv[j].w); ko[64 * j] = w; w.x = pk2(vv[j].x, vv[j].y); w.y = pk2(vv[j].z, vv[j].w); vo[64 * j] = w;
                        float n2 = (kv[j].x * kv[j].x + kv[j].y * kv[j].y) + (kv[j].z * kv[j].z + kv[j].w * kv[j].w); n2 += __shfl_xor(n2, 1); n2 += __shfl_xor(n2, 2); n2 += __shfl_xor(n2, 4);
                        mx[j] = fmaxf(mx[j], n2); }
                }
                if ((lane & 7) == 0) {
#pragma unroll
                    for (int j = 0; j < 4; ++j) red[(wave * 4 + j) * 8 + (lane >> 3)] = mx[j]; }
                __syncthreads();
                if (tid < 32) { float v = red[tid];
#pragma unroll
                    for (int w = 1; w < 8; ++w) v = fmaxf(v, red[w * 32 + tid]);
                    atomicMax(KMX + ((2 + b) * 16 + 4 * (tid >> 3) + ((tid & 7) >> 1)) * 2 + (tid & 1), __float_as_uint(v)); }
                __syncthreads();
            }
        }
        LAS f32x4* part4 = (LAS f32x4*)lds;
        for (int sb = G - 1 - bx; sb < 10; sb += G) {
            const bool prompt = sb < 2; const int b = prompt ? 0 : sb - 2, T = prompt ? TP : TKS, NCH = prompt ? 128 : 66, CH = prompt ? 64 : 32, c = tid >> 2, hq = tid & 3;
            const float* srcA = prompt ? dout + OFF_LFP + (size_t)sb * TP * 16 : cache_logf + (size_t)b * PAST * 16;
            const float* srcB = dout + OFF_LFS + (size_t)b * TS * 16 - (size_t)PAST * 16;
#define LF4_AT(t) (*(const f32x4*)((((prompt) || (t) < PAST) ? srcA : srcB) + (size_t)(t) * 16 + 4 * hq))
            f32x4 s = {0.f, 0.f, 0.f, 0.f};
            if (c < NCH) for (int t0 = c * CH; t0 < (c + 1) * CH; t0 += 16) { f32x4 v[16];
#pragma unroll
                for (int i = 0; i < 16; ++i) v[i] = LF4_AT(t0 + i);
#pragma unroll
                for (int i = 0; i < 16; ++i) s += v[i]; }
            part4[c * 4 + hq] = s; __syncthreads();
            if (c < NCH) {
                f32x4 run = {0.f, 0.f, 0.f, 0.f}; for (int cc = 0; cc < c; ++cc) run += part4[cc * 4 + hq];
                float* dst = (prompt ? CKLP + (size_t)(sb * 16 + 4 * hq) * TP : CKLS + (size_t)(b * 16 + 4 * hq) * TKS);
                for (int t0 = c * CH; t0 < (c + 1) * CH; t0 += 16) { f32x4 v[16];
#pragma unroll
                    for (int i = 0; i < 16; ++i) v[i] = LF4_AT(t0 + i);
#pragma unroll
                    for (int i = 0; i < 16; ++i) { run += v[i]; v[i] = run * LOG2E; }
#pragma unroll
                    for (int e = 0; e < 4; ++e)
#pragma unroll
                        for (int i = 0; i < 4; ++i) *(f32x4*)(dst + (size_t)e * T + t0 + 4 * i) = (f32x4){v[4 * i][e], v[4 * i + 1][e], v[4 * i + 2][e], v[4 * i + 3][e]}; }
            }
#undef LF4_AT
            __syncthreads();
        }
    }
    SEAM(9);
    if (IN(10)) {
        for (int rep = 0; rep < PROBE_ATT_REPS; ++rep)
        for (int gi = bx; gi < 1024 + 128; gi += G) {
            int qrow0, qbase, sb, h, nact; const bf16 *Kp, *Vp; const float* ckl;
            if (gi < 1024) { const int bh = gi >> 5, qb = gi & 31, b = bh >> 4; h = bh & 15; sb = b; qrow0 = b * TP + 256 * qb; qbase = 256 * qb; nact = 8;
                Kp = KB + (size_t)b * TP * DM + h * 64; Vp = VB + (size_t)b * TP * DM + h * 64; ckl = CKLP + (size_t)bh * TP; }
            else { const int bh = gi - 1024, b = bh >> 4; h = bh & 15; sb = 2 + b; qrow0 = MP + b * TS; qbase = PAST; nact = 2;
                Kp = KS + (size_t)b * TKS * DM + h * 64; Vp = VS + (size_t)b * TKS * DM + h * 64; ckl = CKLS + (size_t)bh * TKS; }
            const float kmaxn = __builtin_amdgcn_sqrtf(__uint_as_float(KMX[(sb * 16 + h) * 2]) + __uint_as_float(KMX[(sb * 16 + h) * 2 + 1]));
            att::wg_unit(QO + (size_t)qrow0 * DM + h * 64, OB + (size_t)qrow0 * DM + h * 64, Kp, Vp, ckl, qbase, nact, kmaxn, lds, wave, lane);
        }
        __syncthreads();
    }
    SEAM(10);
    if (IN(11)) { pg8::EpiRes E{nullptr, nullptr, nullptr, XB, SS, nullptr, 1.0f}; GEMM_PHASE(pg8::EpiRes, E, OB, WO, DM, DM, 0, DM); }
    SEAM(11);
    if (IN(12)) { pg8::EpiSwiglu E{ACT, SS, 0, CNT + 128 * 3, LCNT}; RIDE_PHASE(pg8::EpiSwiglu, E, WIN11, 22, 3, ws + WS_WOUT + 3 * WOUT_BYTES, (const float*)nullptr, (const float*)nullptr, (float*)nullptr); }
    SEAM(12);
    if (IN(13)) { pg8::EpiRes E{nullptr, nullptr, nullptr, XB, SS, nullptr, 0.5f}; GEMM_PROMPT(pg8::EpiRes, E, ACT, ws + WS_WOUT + 3 * WOUT_BYTES, FF, FF, DM); }
    SEAM(13);
    if (IN(14)) {
        for (int m0 = gw; m0 < M; m0 += 2 * NGW) {
            const int m1 = (m0 + NGW < M) ? m0 + NGW : m0;
            const v2u* xa = (const v2u*)(XB + (size_t)m0 * DM) + lane; const v2u* xb = (const v2u*)(XB + (size_t)m1 * DM) + lane; const f32x4* gv = (const f32x4*)ln_final + lane;
            v2u wa[4], wb[4];
#pragma unroll
            for (int j = 0; j < 4; ++j) { wa[j] = xa[64 * j]; wb[j] = xb[64 * j]; }
            const float ra = pg8::row_rstd(SS, m0), rb = pg8::row_rstd(SS, m1);
            f32x4* ya = (f32x4*)(X32 + (size_t)m0 * DM) + lane; f32x4* yb = (f32x4*)(X32 + (size_t)m1 * DM) + lane;
#pragma unroll
            for (int j = 0; j < 4; ++j) { const f32x4 g = gv[64 * j];
                __builtin_nontemporal_store((f32x4){__uint_as_float(wa[j].x << 16) * ra * g.x, __uint_as_float(wa[j].x & 0xffff0000u) * ra * g.y, __uint_as_float(wa[j].y << 16) * ra * g.z, __uint_as_float(wa[j].y & 0xffff0000u) * ra * g.w}, ya + 64 * j);
                __builtin_nontemporal_store((f32x4){__uint_as_float(wb[j].x << 16) * rb * g.x, __uint_as_float(wb[j].x & 0xffff0000u) * rb * g.y, __uint_as_float(wb[j].y << 16) * rb * g.z, __uint_as_float(wb[j].y & 0xffff0000u) * rb * g.w}, yb + 64 * j); }
        }
    }
#undef IN
#undef SEAM
#undef GEMM_PHASE
#undef GEMM_PROMPT
#undef RIDE_PHASE
#undef FGATE_ROWS
}

extern "C" void kernel_launch(void* const* d_in, const int* in_sizes, int n_in, void* d_out, int out_size, void* d_ws, size_t ws_size, hipStream_t stream) {
    static int grid = 0;
    if (grid == 0) {
        if (n_in != 20 || (size_t)out_size != OUT_TOTAL || ws_size < WS_END) { fprintf(stderr, "kernel_launch: unexpected shapes (n_in %d out %d ws %zu)\n", n_in, out_size, ws_size); grid = -1; return; }
        int dev = 0, cus = 0, per_cu = 0;
        if (hipGetDevice(&dev) != hipSuccess || hipDeviceGetAttribute(&cus, hipDeviceAttributeMultiprocessorCount, dev) != hipSuccess) { grid = -1; return; }
        if (hipFuncSetAttribute((const void*)mega_fwd, hipFuncAttributeMaxDynamicSharedMemorySize, LDS_BYTES) != hipSuccess) { fprintf(stderr, "kernel_launch: hipFuncSetAttribute failed\n"); grid = -1; return; }
        if (hipOccupancyMaxActiveBlocksPerMultiprocessor(&per_cu, (const void*)mega_fwd, NWAVES * 64, LDS_BYTES) != hipSuccess || per_cu < 1) { fprintf(stderr, "kernel_launch: occupancy query says %d\n", per_cu); (void)hipGetLastError(); grid = -1; return; }
        if (cus != 256) { fprintf(stderr, "kernel_launch: built for a 256-CU device (got %d)\n", cus); grid = -1; return; }
        grid = cus * 1;
    }
    if (grid < 0) return;
    Args a{};
    for (int i = 0; i < 20; ++i) a.in[i] = (const float*)d_in[i];
    a.out = (float*)d_out; a.ws = (unsigned char*)d_ws; a.use_cg = RUNTIME_USE_CG; a.pad = RUNTIME_DELAY;
#if MK_N_LAUNCHES == 1
    a.ph_lo = 0; a.ph_hi = NPHASE;
    void* kargs[] = {&a};
    hipError_t e = hipLaunchCooperativeKernel((const void*)mega_fwd, dim3(grid), dim3(NWAVES * 64), kargs, LDS_BYTES, stream);
    if (e != hipSuccess) fprintf(stderr, "cooperative launch failed: %s (grid %d)\n", hipGetErrorString(e), grid);
#else
    for (int p = 0; p < NPHASE; ++p) { a.ph_lo = p; a.ph_hi = p + 1; hipLaunchKernelGGL(mega_fwd, dim3(grid), dim3(NWAVES * 64), LDS_BYTES, stream, a); }
#endif
}
```

```cpp
#include <hip/hip_runtime.h>
#include <hip/hip_cooperative_groups.h>
#include <cstdio>
#include <cstdint>
#include <cmath>
namespace cg = cooperative_groups;
namespace pg8 {
#define PG8_LAS __attribute__((address_space(3)))
typedef unsigned short bf16_t;
typedef short bf16x8 __attribute__((ext_vector_type(8)));
typedef float f32x4 __attribute__((ext_vector_type(4)));
typedef unsigned u32x4 __attribute__((ext_vector_type(4)));
constexpr int BM = 256, BK = 64, HALF = 128, HTB = HALF * BK * 2  , STAGE_BYTES = 8 * HTB, NXCD = 8, WGM = 8;

__host__ __device__ __forceinline__ int lds_byte(int r, int c) { const int st = (r >> 4) * 2 + (c >> 5), rr = r & 15, cc = c & 31, ob = rr * 64 + cc * 2; return st * 1024 + (ob ^ (((ob >> 9) & 1) << 5)); }
__host__ __device__ __forceinline__ void stage_rc(int b, int& R, int& C) { const int st = b / 1024, sb = b % 1024, swz = sb ^ (((sb >> 9) & 1) << 5); R = (st >> 1) * 16 + swz / 64; C = (st & 1) * 32 + (swz % 64) / 2; }
__host__ __device__ __forceinline__ int perm32(int rho) { const int n = rho >> 4, i = rho & 15; return 8 * (i >> 2) + 4 * n + (i & 3); }

struct Unit { int pm, pn; };
struct Gemm { const bf16_t* A; const bf16_t* Bt; int K; int lda; size_t a_pn_step; };

struct StaticOrder {
    int nM, nN, nwg, G, c;
    __host__ __device__ void init(int M, int N, int G_, int c_) { nM = M / BM; nN = N / BM; nwg = nM * nN; G = G_; c = c_; }
    __host__ __device__ bool next(int i, Unit& u) const {
        const long L = (long)i * G + c; if (L >= nwg) return false;
        int wgid = (int)L; { const int q = nwg / NXCD, r = nwg % NXCD, xcd = wgid % NXCD, off = wgid / NXCD; wgid = (xcd < r ? xcd * (q + 1) : r * (q + 1) + (xcd - r) * q) + off; }
        const int nig = WGM * nN, gid = wgid / nig, fm = gid * WGM, gsz = (nM - fm) < WGM ? (nM - fm) : WGM;
        u.pm = fm + ((wgid % nig) % gsz); u.pn = (wgid % nig) / gsz; return true;
    }
    __device__ __forceinline__ void a_ready(const Unit&) const {}
    __device__ __forceinline__ void done(const Unit&) const {}
};

__device__ __forceinline__ void map_tile(long L, int nM, int nN, Unit& u) {
    const int nwg = nM * nN; int wgid = (int)L; { const int q = nwg / NXCD, r = nwg % NXCD, xcd = wgid % NXCD, off = wgid / NXCD; wgid = (xcd < r ? xcd * (q + 1) : r * (q + 1) + (xcd - r) * q) + off; }
    const int nig = WGM * nN, gid = wgid / nig, fm = gid * WGM, gsz = (nM - fm) < WGM ? (nM - fm) : WGM;
    u.pm = fm + ((wgid % nig) % gsz); u.pn = ((wgid % nig) / gsz + 4 * gid) % nN;
}
struct RideOrder {
    static constexpr int GIVE = 3;
    int nN, c, nP, sample_e, orphanL;
    __device__ __forceinline__ void init(int nN_, int c_) {
        nN = nN_; c = c_; const int nwgP = 64 * nN, nS = 2 * nN;
        nP = (nwgP - c + 255) / 256; sample_e = (c >= 128 && c < 128 + nS) ? c - 128 : -1; orphanL = -1;
        if (c >= 248) nP -= GIVE;
        else if (c >= 128 + nS && c < 128 + nS + 8 * GIVE) { const int o = c - 128 - nS, sc = 248 + o / GIVE; orphanL = ((nwgP - sc + 255) / 256 - 1 - o % GIVE) * 256 + sc; }
    }
    __device__ __forceinline__ bool next(int i, Unit& u) const {
        if (sample_e >= 0) { if (i == 0) { u.pm = 64 + (sample_e & 1); u.pn = sample_e >> 1; return true; } --i; }
        long L; if (i < nP) L = (long)i * 256 + c; else if (i == nP && orphanL >= 0) L = orphanL; else return false;
        map_tile(L, 64, nN, u); return true;
    }
    __device__ __forceinline__ void a_ready(const Unit&) const {}
    __device__ __forceinline__ void done(const Unit&) const {}
};
struct OneUnit {
    int pm, pn;
    __device__ __forceinline__ bool next(int i, Unit& u) const { if (i != 0 || pm < 0) return false; u.pm = pm; u.pn = pn; return true; }
    __device__ __forceinline__ void a_ready(const Unit&) const {}
    __device__ __forceinline__ void done(const Unit&) const {}
};

constexpr int ROWS_P = 16384;
constexpr int DM_ = 1024, FF_ = 2816;
constexpr size_t OFF_KP = 17455104, OFF_VP = 34232320, OFF_KS = 51271680, OFF_VS = 51795968;
__device__ __forceinline__ unsigned cvt_pk_bf16(float lo, float hi) { unsigned r; asm volatile("v_cvt_pk_bf16_f32 %0, %1, %2" : "=v"(r) : "v"(lo), "v"(hi)); return r; }
__device__ __forceinline__ u32x4 pack8(const f32x4 a, const f32x4 b) { u32x4 w; w.x = cvt_pk_bf16(a[0], a[1]); w.y = cvt_pk_bf16(a[2], a[3]); w.z = cvt_pk_bf16(b[0], b[1]); w.w = cvt_pk_bf16(b[2], b[3]); return w; }
__device__ __forceinline__ float row_rstd(const float* SS, int row) {
    const f32x4* p = (const f32x4*)(SS + (size_t)row * 16);
    const f32x4 a = p[0], b = p[1], c = p[2], d = p[3];
    const float s = (((a[0] + a[1]) + (a[2] + a[3])) + ((b[0] + b[1]) + (b[2] + b[3]))) + (((c[0] + c[1]) + (c[2] + c[3])) + ((d[0] + d[1]) + (d[2] + d[3])));
    return rsqrtf(s * (1.0f / 1024.0f) + 1e-6f);
}
__device__ __forceinline__ void rows_rstd(const float* SS, int row0, int fq, float (&rs)[2][4]) {
    f32x4 t[2][4];
#pragma unroll
    for (int ai = 0; ai < 2; ++ai)
#pragma unroll
        for (int m = 0; m < 4; ++m) t[ai][m] = *(const f32x4*)(SS + (size_t)(row0 + ai * HALF + m * 16) * 16 + 4 * fq);
#pragma unroll
    for (int ai = 0; ai < 2; ++ai)
#pragma unroll
        for (int m = 0; m < 4; ++m) { float s = (t[ai][m][0] + t[ai][m][1]) + (t[ai][m][2] + t[ai][m][3]); s += __shfl_xor(s, 16); s += __shfl_xor(s, 32); rs[ai][m] = rsqrtf(s * (1.0f / 1024.0f) + 1e-6f); }
}
__device__ __forceinline__ float silu_mul(float g, float u) { return g * __builtin_amdgcn_rcpf(1.0f + __builtin_amdgcn_exp2f(-1.4426950408889634f * g)) * u; }

struct EpiSwiglu {
    static constexpr bool PERM = true, AFTER_DRAIN = false;
    bf16_t* ACT; const float* SS; int pn0; unsigned* cnt; PG8_LAS unsigned* lcnt;
    __device__ __forceinline__ void operator()(const f32x4 (&acc)[2][2][4][2], const Unit& u, int wr, int wc, int fr, int fq) const {
        const int row0 = u.pm * BM + wr * 64 + fr, col0 = (u.pn - pn0) * 128 + wc * 32 + 8 * fq;
        float rsv[2][4]; rows_rstd(SS, row0, fq, rsv);
#pragma unroll
        for (int ai = 0; ai < 2; ++ai)
#pragma unroll
            for (int m = 0; m < 4; ++m) {
                const int row = row0 + ai * HALF + m * 16; const float rs = rsv[ai][m];
                const float k1 = -1.4426950408889634f * rs, k2 = rs * rs;
                f32x4 h[2];
#pragma unroll
                for (int n = 0; n < 2; ++n) { const f32x4 g = acc[ai][0][m][n], uu = acc[ai][1][m][n]; const f32x4 t = g * k1; f32x4 ex;
#pragma unroll
                    for (int e = 0; e < 4; ++e) ex[e] = __builtin_amdgcn_exp2f(t[e]);
                    const f32x4 d = ex + 1.0f; f32x4 r;
#pragma unroll
                    for (int e = 0; e < 4; ++e) r[e] = __builtin_amdgcn_rcpf(d[e]);
                    h[n] = ((g * uu) * k2) * r; }
                *(u32x4*)(ACT + (size_t)row * FF_ + col0) = pack8(h[0], h[1]);
            }
        if (cnt && u.pm >= 64) {
            asm volatile("s_waitcnt vmcnt(0)" ::: "memory");
            unsigned old = 0u;
            if ((fr | fq) == 0) old = __hip_atomic_fetch_add(lcnt, 1u, __ATOMIC_RELAXED, __HIP_MEMORY_SCOPE_WORKGROUP);
            old = (unsigned)__builtin_amdgcn_readfirstlane((int)old);
            if (old == 7u) {
                if ((fr | fq) == 0) __hip_atomic_store(lcnt, 0u, __ATOMIC_RELAXED, __HIP_MEMORY_SCOPE_WORKGROUP);
                __builtin_amdgcn_fence(__ATOMIC_RELEASE, "agent");
                if ((fr | fq) == 0) __hip_atomic_fetch_add(cnt + 64 * (u.pm - 64), 8u, __ATOMIC_RELAXED, __HIP_MEMORY_SCOPE_AGENT);
            }
        }
    }
};
struct EpiRes {
    static constexpr bool PERM = true, AFTER_DRAIN = false;
    const float* in_lo; const float* in_hi;
    float* out32; bf16_t* XB; float* SS; const float* colscale; float alpha;
    __device__ __forceinline__ void operator()(const f32x4 (&acc)[2][2][4][2], const Unit& u, int wr, int wc, int fr, int fq) const {
        const int row0 = u.pm * BM + wr * 64 + fr, colw = u.pn * BM + wc * 32 + 8 * fq;
        f32x4 sc[2][2];
#pragma unroll
        for (int bj = 0; bj < 2; ++bj)
#pragma unroll
            for (int n = 0; n < 2; ++n) sc[bj][n] = colscale ? *(const f32x4*)(colscale + colw + bj * HALF + 4 * n) : (f32x4){alpha, alpha, alpha, alpha};
#define EPIRES_ROW(B0, B1, M_, BJ_) do { const int row = row0 + ai * HALF + (M_) * 16, col = colw + (BJ_) * HALF; \
            const f32x4 o0 = (B0) + sc[BJ_][0] * acc[ai][BJ_][M_][0], o1 = (B1) + sc[BJ_][1] * acc[ai][BJ_][M_][1]; \
            if (out32) { float* op = out32 + (size_t)row * DM_ + col; *(f32x4*)op = o0; *(f32x4*)(op + 4) = o1; } \
            *(u32x4*)(XB + (size_t)row * DM_ + col) = pack8(o0, o1); \
            ssq[M_] += ((o0[0] * o0[0] + o0[1] * o0[1]) + (o0[2] * o0[2] + o0[3] * o0[3])) + ((o1[0] * o1[0] + o1[1] * o1[1]) + (o1[2] * o1[2] + o1[3] * o1[3])); } while (0)
#pragma unroll
        for (int ai = 0; ai < 2; ++ai) {
            float ssq[4] = {0.f, 0.f, 0.f, 0.f};
            if (in_lo) {
#pragma unroll
                for (int mh = 0; mh < 2; ++mh) { f32x4 bq[2][2][2];
#pragma unroll
                    for (int mm = 0; mm < 2; ++mm) { const int row = row0 + ai * HALF + (2 * mh + mm) * 16; const float* bp = (row < ROWS_P) ? in_lo + (size_t)row * DM_ : in_hi + (size_t)(row - ROWS_P) * DM_;
#pragma unroll
                        for (int bj = 0; bj < 2; ++bj) { bq[mm][bj][0] = *(const f32x4*)(bp + colw + bj * HALF); bq[mm][bj][1] = *(const f32x4*)(bp + colw + bj * HALF + 4); } }
#pragma unroll
                    for (int mm = 0; mm < 2; ++mm)
#pragma unroll
                        for (int bj = 0; bj < 2; ++bj) EPIRES_ROW(bq[mm][bj][0], bq[mm][bj][1], 2 * mh + mm, bj); }
            } else {
                u32x4 bw[4][2];
#pragma unroll
                for (int m = 0; m < 4; ++m)
#pragma unroll
                    for (int bj = 0; bj < 2; ++bj) bw[m][bj] = *(const u32x4*)(XB + (size_t)(row0 + ai * HALF + m * 16) * DM_ + colw + bj * HALF);
#pragma unroll
                for (int m = 0; m < 4; ++m)
#pragma unroll
                    for (int bj = 0; bj < 2; ++bj) { const u32x4 w = bw[m][bj];
                        const f32x4 b0 = (f32x4){__uint_as_float(w.x << 16), __uint_as_float(w.x & 0xffff0000u), __uint_as_float(w.y << 16), __uint_as_float(w.y & 0xffff0000u)};
                        const f32x4 b1 = (f32x4){__uint_as_float(w.z << 16), __uint_as_float(w.z & 0xffff0000u), __uint_as_float(w.w << 16), __uint_as_float(w.w & 0xffff0000u)};
                        EPIRES_ROW(b0, b1, m, bj); }
            }
#pragma unroll
            for (int m = 0; m < 4; ++m) { float s = ssq[m]; s += __shfl_xor(s, 16); s += __shfl_xor(s, 32);
                if (fq == 0) SS[(size_t)(row0 + ai * HALF + m * 16) * 16 + u.pn * 4 + wc] = s; }
        }
#undef EPIRES_ROW
    }
};
struct EpiKV {
    static constexpr bool PERM = true, AFTER_DRAIN = false;
    float* dout; bf16_t* KBp; bf16_t* VBp; bf16_t* KSp; bf16_t* VSp; const float* SS; unsigned* KMX; unsigned* cnt;
    __device__ __forceinline__ void operator()(const f32x4 (&acc)[2][2][4][2], const Unit& u, int wr, int wc, int fr, int fq) const {
        const bool isV = u.pn >= 4, samp = u.pm >= 64; const int ct = (u.pn & 3) * BM;
        const int row0 = u.pm * BM + wr * 64 + fr, colw = ct + wc * 32 + 8 * fq;
        float rsv[2][4]; rows_rstd(SS, row0, fq, rsv);
#pragma unroll
        for (int ai = 0; ai < 2; ++ai) {
            float mx[2] = {0.f, 0.f};
#pragma unroll
            for (int m = 0; m < 4; ++m) {
                const int row = row0 + ai * HALF + m * 16; const float rs = rsv[ai][m];
                float* fp; bf16_t* bp;
                if (!samp) { fp = dout + (isV ? OFF_VP : OFF_KP) + (size_t)row * DM_; bp = (isV ? VBp : KBp) + (size_t)row * DM_; }
                else { const int r2 = row - ROWS_P, b = r2 >> 6, t = r2 & 63; fp = dout + (isV ? OFF_VS : OFF_KS) + (size_t)r2 * DM_; bp = (isV ? VSp : KSp) + (size_t)(b * 2112 + 2048 + t) * DM_; }
#pragma unroll
                for (int bj = 0; bj < 2; ++bj) {
                    const int col = colw + bj * HALF;
                    const f32x4 v0 = acc[ai][bj][m][0] * rs, v1 = acc[ai][bj][m][1] * rs;
                    __builtin_nontemporal_store(v0, (f32x4*)(fp + col)); __builtin_nontemporal_store(v1, (f32x4*)(fp + col + 4));
                    *(u32x4*)(bp + col) = pack8(v0, v1);
                    if (!isV) {
                        float n2 = ((v0[0] * v0[0] + v0[1] * v0[1]) + (v0[2] * v0[2] + v0[3] * v0[3])) + ((v1[0] * v1[0] + v1[1] * v1[1]) + (v1[2] * v1[2] + v1[3] * v1[3]));
                        n2 += __shfl_xor(n2, 16); n2 += __shfl_xor(n2, 32);
                        mx[bj] = fmaxf(mx[bj], n2);
                    }
                }
            }
            if (!isV) {
#pragma unroll
                for (int bj = 0; bj < 2; ++bj) {
                    float v = mx[bj];
                    v = fmaxf(v, __shfl_xor(v, 1)); v = fmaxf(v, __shfl_xor(v, 2)); v = fmaxf(v, __shfl_xor(v, 4)); v = fmaxf(v, __shfl_xor(v, 8));
                    const int sb = samp ? 2 + (u.pm - 64) * 4 + 2 * ai + wr : (u.pm >> 5);
                    const int head = (ct + bj * HALF + wc * 32) >> 6, half = wc & 1;
                    if (fr == 0 && fq == 0) atomicMax(KMX + (sb * 16 + head) * 2 + half, __float_as_uint(v));
                }
            }
        }
        if (cnt && samp) {
            if ((fr | fq) == 0) __hip_atomic_fetch_add(cnt + 64 * (u.pm - 64), 1u, __ATOMIC_RELAXED, __HIP_MEMORY_SCOPE_AGENT);
        }
    }
};
struct EpiQ {
    static constexpr bool PERM = true, AFTER_DRAIN = false;
    bf16_t* Q; const float* SS; float c2;
    __device__ __forceinline__ void operator()(const f32x4 (&acc)[2][2][4][2], const Unit& u, int wr, int wc, int fr, int fq) const {
        const int row0 = u.pm * BM + wr * 64 + fr, colw = u.pn * BM + wc * 32 + 8 * fq;
        float rsv[2][4]; rows_rstd(SS, row0, fq, rsv);
#pragma unroll
        for (int ai = 0; ai < 2; ++ai)
#pragma unroll
            for (int m = 0; m < 4; ++m) {
                const int row = row0 + ai * HALF + m * 16; const float rs = rsv[ai][m] * c2;
#pragma unroll
                for (int bj = 0; bj < 2; ++bj) *(u32x4*)(Q + (size_t)row * DM_ + colw + bj * HALF) = pack8(acc[ai][bj][m][0] * rs, acc[ai][bj][m][1] * rs);
            }
    }
};
struct EpiKVSwiglu {
    static constexpr bool PERM = true, AFTER_DRAIN = false;
    EpiKV kv; EpiSwiglu sw;
    __device__ __forceinline__ void operator()(const f32x4 (&acc)[2][2][4][2], const Unit& u, int wr, int wc, int fr, int fq) const {
        if (u.pn < 8) kv(acc, u, wr, wc, fr, fq); else sw(acc, u, wr, wc, fr, fq);
    }
};
template <class Epi, class Sched, bool ALIGN_EPI = false, bool SP2 = false>
__device__ __forceinline__ void gemm_phase(PG8_LAS unsigned char* lds, const Gemm g, const Sched& S, const Epi& E) {
    const int tid = threadIdx.x, wid = __builtin_amdgcn_readfirstlane(tid >> 6), lane = tid & 63, wr = wid >> 2, wc = wid & 3, fr = lane & 15, fq = lane >> 4;
    const int K = g.K, nt = K / BK;
    unsigned voffA[2], voffB[2];
#pragma unroll
    for (int i = 0; i < 2; ++i) { int R, C; stage_rc(tid * 16 + i * 8192, R, C); const int Rb = Epi::PERM ? ((R & ~31) + perm32(R & 31)) : R;
        voffA[i] = (unsigned)(R * g.lda + C) * 2u; voffB[i] = (unsigned)(Rb * K + C) * 2u; }
    const size_t kstep = (size_t)(BK * 2);
    const size_t hstepA = (size_t)HALF * g.lda * 2, hstepB = (size_t)HALF * K * 2;
    const size_t tstepA = 2 * hstepA, tstepB = 2 * hstepB;
    const unsigned ldsw = (unsigned)wid * 1024u;
    const int aoff = lds_byte(wr * 64 + fr, fq * 8), boff = lds_byte(wc * 32 + fr, fq * 8);
#define PG8_SA(b, h) (((b) * 2 + (h)) * HTB)
#define PG8_SB(b, h) ((4 + (b) * 2 + (h)) * HTB)
#define PG8_STAGE(bufoff, gbase, voff) do { _Pragma("unroll") for (int _i = 0; _i < 2; ++_i) \
        __builtin_amdgcn_global_load_lds((const unsigned*)((const char*)(gbase) + (voff)[_i]), (PG8_LAS unsigned*)(lds + (bufoff) + ldsw + _i * 8192), 16, 0, 0); } while (0)
#define PG8_LDA(dst, b, h) do { _Pragma("unroll") for (int m = 0; m < 4; ++m) _Pragma("unroll") for (int k = 0; k < 2; ++k) dst[m][k] = *(const PG8_LAS bf16x8*)(lds + PG8_SA(b, h) + aoff + m * 2048 + k * 1024); } while (0)
#define PG8_LDB(dst, b, h) do { _Pragma("unroll") for (int n = 0; n < 2; ++n) _Pragma("unroll") for (int k = 0; k < 2; ++k) dst[n][k] = *(const PG8_LAS bf16x8*)(lds + PG8_SB(b, h) + boff + n * 2048 + k * 1024); } while (0)
#define PG8_MMA(ai, bj, At, Bt) do { __builtin_amdgcn_s_setprio(1); _Pragma("unroll") for (int m = 0; m < 4; ++m) _Pragma("unroll") for (int n = 0; n < 2; ++n) _Pragma("unroll") for (int k = 0; k < 2; ++k) \
        acc[ai][bj][m][n] = __builtin_amdgcn_mfma_f32_16x16x32_bf16(Bt[n][k], At[m][k], acc[ai][bj][m][n], 0, 0, 0); __builtin_amdgcn_s_setprio(0); } while (0)
#define PG8_WAIT_V(n) asm volatile("s_waitcnt vmcnt(" #n ")" ::: "memory")
#define PG8_WAIT_L(n) asm volatile("s_waitcnt lgkmcnt(" #n ")" ::: "memory")
#define PG8_BAR __builtin_amdgcn_s_barrier()
#define PG8_SCHED __builtin_amdgcn_sched_barrier(0)
    Unit cur, nxt; int ui = 0;
    if (!S.next(0, cur)) return;
    f32x4 acc[2][2][4][2];
#pragma unroll
    for (int a = 0; a < 2; ++a)
#pragma unroll
        for (int b = 0; b < 2; ++b)
#pragma unroll
            for (int m = 0; m < 4; ++m)
#pragma unroll
                for (int n = 0; n < 2; ++n) acc[a][b][m][n] = (f32x4){0.f, 0.f, 0.f, 0.f};
    bf16x8 At[4][2], B0[2][2], B1[2][2];
    const char* cA = (const char*)g.A + (size_t)cur.pm * tstepA + (size_t)cur.pn * g.a_pn_step; const char* cB = (const char*)g.Bt + (size_t)cur.pn * tstepB;
    S.a_ready(cur);
    if constexpr (SP2) {
        PG8_STAGE(PG8_SB(0, 0), cB, voffB); PG8_STAGE(PG8_SB(0, 1), cB + hstepB, voffB); PG8_STAGE(PG8_SA(0, 0), cA, voffA); PG8_STAGE(PG8_SA(0, 1), cA + hstepA, voffA);
        if (wr == 1) PG8_BAR;
        PG8_WAIT_V(2); PG8_BAR;
        PG8_STAGE(PG8_SB(1, 0), cB + kstep, voffB); PG8_STAGE(PG8_SA(1, 0), cA + kstep, voffA); PG8_STAGE(PG8_SB(1, 1), cB + hstepB + kstep, voffB);
        PG8_WAIT_V(6); PG8_BAR;
    } else {
        PG8_STAGE(PG8_SB(0, 0), cB, voffB); PG8_STAGE(PG8_SA(0, 0), cA, voffA); PG8_STAGE(PG8_SB(0, 1), cB + hstepB, voffB); PG8_STAGE(PG8_SA(0, 1), cA + hstepA, voffA);
        if (wr == 1) PG8_BAR;
        PG8_WAIT_V(4); PG8_BAR;
        PG8_STAGE(PG8_SB(1, 0), cB + kstep, voffB); PG8_STAGE(PG8_SA(1, 0), cA + kstep, voffA); PG8_STAGE(PG8_SB(1, 1), cB + hstepB + kstep, voffB);
        PG8_WAIT_V(6); PG8_BAR;
    }
    for (;;) {
        const bool has_next = S.next(ui + 1, nxt);
        const char* nA = has_next ? (const char*)g.A + (size_t)nxt.pm * tstepA + (size_t)nxt.pn * g.a_pn_step : cA; const char* nB = has_next ? (const char*)g.Bt + (size_t)nxt.pn * tstepB : cB;
        for (int t = 0; t < nt; t += 2) {
            const bool last = (t == nt - 2);
            const char* a1 = cA + (size_t)(t + 1) * kstep;
            const char* a2 = last ? nA : cA + (size_t)(t + 2) * kstep; const char* b2 = last ? nB : cB + (size_t)(t + 2) * kstep;
            const char* a3 = a2 + kstep; const char* b3 = b2 + kstep;
            if (last && has_next) S.a_ready(nxt);
            if constexpr (SP2) {
            PG8_LDB(B0, 0, 0); PG8_LDB(B1, 0, 1); PG8_SCHED; PG8_LDA(At, 0, 0); PG8_STAGE(PG8_SA(1, 1), a1 + hstepA, voffA);
            PG8_WAIT_V(8); PG8_WAIT_L(0); PG8_BAR; PG8_MMA(0, 0, At, B0); PG8_MMA(0, 1, At, B1); PG8_BAR; PG8_SCHED;
            PG8_LDA(At, 0, 1); PG8_STAGE(PG8_SB(0, 0), b2, voffB); PG8_STAGE(PG8_SB(0, 1), b2 + hstepB, voffB); PG8_STAGE(PG8_SA(0, 0), a2, voffA);
            PG8_WAIT_V(8); PG8_WAIT_L(0); PG8_BAR; PG8_MMA(1, 0, At, B0); PG8_MMA(1, 1, At, B1); PG8_BAR; PG8_SCHED;
            PG8_LDB(B0, 1, 0); PG8_LDB(B1, 1, 1); PG8_SCHED; PG8_LDA(At, 1, 0); PG8_STAGE(PG8_SA(0, 1), a2 + hstepA, voffA);
            PG8_WAIT_V(8); PG8_WAIT_L(0); PG8_BAR; PG8_MMA(0, 0, At, B0); PG8_MMA(0, 1, At, B1); PG8_BAR; PG8_SCHED;
            PG8_LDA(At, 1, 1); PG8_STAGE(PG8_SB(1, 0), b3, voffB); PG8_STAGE(PG8_SB(1, 1), b3 + hstepB, voffB); PG8_STAGE(PG8_SA(1, 0), a3, voffA);
            PG8_WAIT_V(8); PG8_WAIT_L(0); PG8_BAR; PG8_MMA(1, 0, At, B0); PG8_MMA(1, 1, At, B1); PG8_BAR; PG8_SCHED;
            } else {
            PG8_LDB(B0, 0, 0); PG8_SCHED; PG8_LDA(At, 0, 0); PG8_STAGE(PG8_SA(1, 1), a1 + hstepA, voffA);
            PG8_WAIT_L(8); PG8_BAR; PG8_WAIT_L(0); PG8_MMA(0, 0, At, B0); PG8_BAR; PG8_SCHED;
            PG8_LDB(B1, 0, 1); PG8_STAGE(PG8_SB(0, 0), b2, voffB);
            PG8_BAR; PG8_WAIT_L(0); PG8_MMA(0, 1, At, B1); PG8_BAR;
            PG8_LDA(At, 0, 1); PG8_STAGE(PG8_SA(0, 0), a2, voffA);
            PG8_BAR; PG8_WAIT_L(0); PG8_MMA(1, 0, At, B0); PG8_BAR; PG8_SCHED;
            PG8_STAGE(PG8_SB(0, 1), b2 + hstepB, voffB);
            PG8_WAIT_V(6); PG8_BAR; PG8_MMA(1, 1, At, B1); PG8_BAR;
            PG8_LDB(B0, 1, 0); PG8_SCHED; PG8_LDA(At, 1, 0); PG8_STAGE(PG8_SA(0, 1), a2 + hstepA, voffA);
            PG8_WAIT_L(8); PG8_BAR; PG8_WAIT_L(0); PG8_MMA(0, 0, At, B0); PG8_BAR; PG8_SCHED;
            PG8_LDB(B1, 1, 1); PG8_STAGE(PG8_SB(1, 0), b3, voffB);
            PG8_BAR; PG8_WAIT_L(0); PG8_MMA(0, 1, At, B1); PG8_BAR;
            PG8_LDA(At, 1, 1); PG8_STAGE(PG8_SA(1, 0), a3, voffA);
            PG8_BAR; PG8_WAIT_L(0); PG8_MMA(1, 0, At, B0); PG8_BAR; PG8_SCHED;
            PG8_STAGE(PG8_SB(1, 1), b3 + hstepB, voffB);
            PG8_WAIT_V(6); PG8_BAR; PG8_MMA(1, 1, At, B1); PG8_BAR;
            }
        }
        if constexpr (ALIGN_EPI) { if (wr == 0) PG8_BAR; }
        if constexpr (!Epi::AFTER_DRAIN) { E(acc, cur, wr, wc, fr, fq); S.done(cur); }
        if (!has_next) break;
#pragma unroll
        for (int a = 0; a < 2; ++a)
#pragma unroll
            for (int b = 0; b < 2; ++b)
#pragma unroll
                for (int m = 0; m < 4; ++m)
#pragma unroll
                    for (int n = 0; n < 2; ++n) acc[a][b][m][n] = (f32x4){0.f, 0.f, 0.f, 0.f};
        cur = nxt; cA = nA; cB = nB; ++ui;
        if constexpr (ALIGN_EPI) { if (wr == 1) PG8_BAR; }
    }
    PG8_WAIT_V(0);
    if constexpr (!ALIGN_EPI) { if (wr == 0) PG8_BAR; }
    PG8_BAR;
    if constexpr (Epi::AFTER_DRAIN) { E.fused(acc, cur, wr, wc, fr, fq, lds, wid, lane); S.done(cur); }
#undef PG8_SA
#undef PG8_SB
#undef PG8_STAGE
#undef PG8_LDA
#undef PG8_LDB
#undef PG8_MMA
#undef PG8_WAIT_V
#undef PG8_WAIT_L
#undef PG8_BAR
#undef PG8_SCHED
}}

namespace att {
#define ALAS __attribute__((address_space(3)))
using bf16 = unsigned short;
using bf16x8 = __attribute__((ext_vector_type(8))) short;
using s16x4 = __attribute__((ext_vector_type(4))) short;
using f32x16 = __attribute__((ext_vector_type(16))) float;
using f32x4 = __attribute__((ext_vector_type(4))) float;
using u32x4 = __attribute__((ext_vector_type(4))) unsigned;
typedef float f32x2_t __attribute__((ext_vector_type(2))); typedef __bf16 bf16x2_t __attribute__((ext_vector_type(2)));
#ifndef ATT_PREFETCH
#define ATT_PREFETCH 1
#endif
#ifndef ATT_EXIT_LOG2
#define ATT_EXIT_LOG2 -48.f
#endif
#ifndef ATT_EARLY_EXIT
#define ATT_EARLY_EXIT 1
#endif
constexpr int WLDS = 8192 + 4096 + 256 + 256;
__device__ __forceinline__ int crow(int r, int hi) { return (r & 3) + 8 * (r >> 2) + 4 * hi; }
__device__ __forceinline__ unsigned cvtpk_s(float lo, float hi) { f32x2_t v = {lo, hi}; bf16x2_t b = __builtin_convertvector(v, bf16x2_t); return __builtin_bit_cast(unsigned, b); }
__device__ __forceinline__ float bf2f(short s) { return __uint_as_float(((unsigned)(unsigned short)s) << 16); }
typedef short v4i16_t __attribute__((ext_vector_type(4)));
__device__ __forceinline__ s16x4 vtr(const ALAS unsigned char* p) { return __builtin_bit_cast(s16x4, __builtin_amdgcn_ds_read_tr16_b64_v4i16((ALAS v4i16_t*)p)); }
__device__ __forceinline__ void pv(f32x16* o, const ALAS unsigned char* vp, bf16x8 pa0, bf16x8 pa1, bf16x8 pa2, bf16x8 pa3) {
#pragma unroll
    for (int d0 = 0; d0 < 2; ++d0) { s16x4 lo[4], hi[4];
#pragma unroll
        for (int ks = 0; ks < 4; ++ks) { lo[ks] = vtr(vp + d0 * 4096 + ks * 1024); hi[ks] = vtr(vp + d0 * 4096 + ks * 1024 + 512); }
#define PK(k) (bf16x8){lo[k][0], lo[k][1], lo[k][2], lo[k][3], hi[k][0], hi[k][1], hi[k][2], hi[k][3]}
        o[d0] = __builtin_amdgcn_mfma_f32_32x32x16_bf16(pa0, PK(0), o[d0], 0, 0, 0);
        o[d0] = __builtin_amdgcn_mfma_f32_32x32x16_bf16(pa1, PK(1), o[d0], 0, 0, 0);
        o[d0] = __builtin_amdgcn_mfma_f32_32x32x16_bf16(pa2, PK(2), o[d0], 0, 0, 0);
        o[d0] = __builtin_amdgcn_mfma_f32_32x32x16_bf16(pa3, PK(3), o[d0], 0, 0, 0);
#undef PK
    }
}
__device__ __forceinline__ void wave_unit(const bf16* Qp, bf16* Op, const bf16* Kp, const bf16* Vp, const float* ckl, int qpos0, float kmaxn, ALAS unsigned char* wl, int lane) {
    const int r32 = lane & 31, hi = lane >> 5;
    ALAS unsigned char* vt = wl; ALAS bf16* stg = (ALAS bf16*)(wl + 8192); ALAS float* wsf = (ALAS float*)(wl + 8192 + 4096);
    const ALAS unsigned char* vp = vt + ((lane >> 4) & 1) * 32 + (lane & 3) * 8 + (4 * hi + ((lane & 15) >> 2)) * 64;
    bf16x8 qr[4];
#pragma unroll
    for (int d0 = 0; d0 < 4; ++d0) qr[d0] = *(const bf16x8*)(Qp + (size_t)r32 * 1024 + d0 * 16 + hi * 8);
    float qn2 = 0.f;
#pragma unroll
    for (int d0 = 0; d0 < 4; ++d0)
#pragma unroll
        for (int e = 0; e < 8; ++e) { const float v = bf2f(qr[d0][e]); qn2 += v * v; }
    qn2 += __shfl_xor(qn2, 32);
    const float qkb = __builtin_amdgcn_sqrtf(qn2) * kmaxn * 1.03f + 1.0f;
    const float cq = ckl[qpos0 + r32];
    float mref = 0.f, l = 0.f; f32x16 o[2]; o[0] = f32x16{}; o[1] = f32x16{};
    const int jd = (qpos0 + 31) >> 6;
    bf16x8 kf[8]; f32x4 bpre;
    ALAS float* bl = (ALAS float*)(wl + 8192 + 4096 + 256);
#define ATT_LOADK(JT) do { const bf16* kp_ = Kp + (size_t)(64 * (JT) + r32) * 1024 + hi * 8; \
        _Pragma("unroll") for (int d0 = 0; d0 < 4; ++d0) { kf[2 * d0] = *(const bf16x8*)(kp_ + d0 * 16); kf[2 * d0 + 1] = *(const bf16x8*)(kp_ + 32 * 1024 + d0 * 16); } \
        bpre = *(const f32x4*)(ckl + 64 * (JT) + 4 * (lane & 15)); } while (0)
#define ATT_LOADV(JT) do { _Pragma("unroll") for (int w = 0; w < 8; ++w) __builtin_amdgcn_global_load_lds((const unsigned*)(Vp + (size_t)(64 * (JT) + 16 * (w & 3) + (lane >> 2)) * 1024 + 32 * (w >> 2) + 8 * (lane & 3)), \
        (ALAS unsigned*)(vt + w * 1024), 16, 0, 0); } while (0)
    ATT_LOADK(jd); ATT_LOADV(jd);
    for (int j = jd; j >= 0; --j) {
        const int s0 = 64 * j;
        f32x16 p0, p1; const float base = cq - mref;
        if (lane < 16) *(ALAS f32x4*)(bl + 4 * lane) = bpre;
#pragma unroll
        for (int jj = 0; jj < 4; ++jj) { const f32x4 a = *(const ALAS f32x4*)(bl + 8 * jj + 4 * hi), b = *(const ALAS f32x4*)(bl + 32 + 8 * jj + 4 * hi);
#pragma unroll
            for (int e = 0; e < 4; ++e) { p0[4 * jj + e] = base - a[e]; p1[4 * jj + e] = base - b[e]; } }
#pragma unroll
        for (int d0 = 0; d0 < 4; ++d0) { p0 = __builtin_amdgcn_mfma_f32_32x32x16_bf16(kf[2 * d0], qr[d0], p0, 0, 0, 0); p1 = __builtin_amdgcn_mfma_f32_32x32x16_bf16(kf[2 * d0 + 1], qr[d0], p1, 0, 0, 0); }
        if (j > 0) ATT_LOADK(j - 1);
        if (j == jd) { const int qp = qpos0 + r32;
#pragma unroll
            for (int r = 0; r < 16; ++r) { const int kv = s0 + crow(r, hi); if (kv > qp) p0[r] = -INFINITY; if (kv + 32 > qp) p1[r] = -INFINITY; } }
        float rm;
        { float a = fmaxf(p0[0], p1[0]);
#pragma unroll
          for (int r = 1; r < 16; ++r) a = fmaxf(a, fmaxf(p0[r], p1[r]));
          rm = fmaxf(a, __shfl_xor(a, 32)); }
        if (j == jd) {
            mref = rm;
#pragma unroll
            for (int r = 0; r < 16; ++r) { p0[r] -= rm; p1[r] -= rm; }
        } else if (__any(rm > 0.f)) {
            const float dl = fmaxf(rm, 0.f); mref += dl;
#pragma unroll
            for (int r = 0; r < 16; ++r) { p0[r] -= dl; p1[r] -= dl; }
            const float f = __builtin_amdgcn_exp2f(-dl); l *= f; if (hi == 0) wsf[r32] = f;
            asm volatile("s_waitcnt lgkmcnt(0)" ::: "memory");
#pragma unroll
            for (int d_ = 0; d_ < 2; ++d_)
#pragma unroll
                for (int r = 0; r < 16; ++r) o[d_][r] *= wsf[crow(r, hi)];
        }
        float sacc = 0.f;
#pragma unroll
        for (int r = 0; r < 16; ++r) { p0[r] = __builtin_amdgcn_exp2f(p0[r]); p1[r] = __builtin_amdgcn_exp2f(p1[r]); sacc += p0[r] + p1[r]; }
        l += sacc;
        u32x4 pw0, pw1, pw2, pw3;
        pw0 = (u32x4){cvtpk_s(p0[0], p0[1]), cvtpk_s(p0[2], p0[3]), cvtpk_s(p0[4], p0[5]), cvtpk_s(p0[6], p0[7])};
        pw1 = (u32x4){cvtpk_s(p0[8], p0[9]), cvtpk_s(p0[10], p0[11]), cvtpk_s(p0[12], p0[13]), cvtpk_s(p0[14], p0[15])};
        pw2 = (u32x4){cvtpk_s(p1[0], p1[1]), cvtpk_s(p1[2], p1[3]), cvtpk_s(p1[4], p1[5]), cvtpk_s(p1[6], p1[7])};
        pw3 = (u32x4){cvtpk_s(p1[8], p1[9]), cvtpk_s(p1[10], p1[11]), cvtpk_s(p1[12], p1[13]), cvtpk_s(p1[14], p1[15])};
        if (j > 0) asm volatile("s_waitcnt vmcnt(9)" ::: "memory"); else asm volatile("s_waitcnt vmcnt(0)" ::: "memory");
        pv(o, vp, __builtin_bit_cast(bf16x8, pw0), __builtin_bit_cast(bf16x8, pw1), __builtin_bit_cast(bf16x8, pw2), __builtin_bit_cast(bf16x8, pw3));
        asm volatile("s_waitcnt lgkmcnt(0)" ::: "memory");
#if ATT_EARLY_EXIT
        if (j > 0) { const float cl = __uint_as_float(__builtin_amdgcn_readlane(__float_as_uint(bpre[3]), 15));
            const float ub = qkb + (cq - cl) - mref; if (!__any(ub > ATT_EXIT_LOG2)) break; }
#endif
        if (j > 0) ATT_LOADV(j - 1);
    }
    l += __shfl_xor(l, 32);
    if (hi == 0) wsf[32 + r32] = l;
    asm volatile("s_waitcnt lgkmcnt(0)" ::: "memory");
    float rli[16];
#pragma unroll
    for (int r = 0; r < 16; ++r) rli[r] = 1.0f / wsf[32 + crow(r, hi)];
#pragma unroll
    for (int r = 0; r < 16; ++r) { const int orow = crow(r, hi);
#pragma unroll
        for (int d0 = 0; d0 < 2; ++d0) { const unsigned w = cvtpk_s(o[d0][r] * rli[r], 0.f); stg[orow * 64 + d0 * 32 + r32] = (bf16)(w & 0xffffu); } }
    asm volatile("s_waitcnt lgkmcnt(0)" ::: "memory");
#pragma unroll
    for (int i = 0; i < 4; ++i) { const int row = i * 8 + (lane >> 3), ch = lane & 7; const u32x4 v = *(const ALAS u32x4*)(stg + row * 64 + ch * 8); *(u32x4*)(Op + (size_t)row * 1024 + ch * 8) = v; }
    asm volatile("s_waitcnt lgkmcnt(0)" ::: "memory");
}

constexpr int G_K = 0, G_V = 16384, G_PW = 32768, G_PWB = 4096 + 256 + 256, G_FLAG = G_PW + 8 * G_PWB, G_BYTES = G_FLAG + 64;
__device__ __forceinline__ void wg_unit(const bf16* Qb, bf16* Ob, const bf16* Kp, const bf16* Vp, const float* ckl, int qbase, int nact, float kmaxn, ALAS unsigned char* L, int wave, int lane) {
    const int r32 = lane & 31, hi = lane >> 5;
    ALAS unsigned char* pw = L + G_PW + wave * G_PWB;
    ALAS bf16* stg = (ALAS bf16*)pw; ALAS float* wsf = (ALAS float*)(pw + 4096); ALAS float* bl = (ALAS float*)(pw + 4096 + 256);
    ALAS unsigned* flags = (ALAS unsigned*)(L + G_FLAG);
    const bool active = wave < nact;
    const int qpos0 = qbase + 32 * wave, jd = (qpos0 + 31) >> 6, jmax = (qbase + 32 * nact - 1) >> 6;
    __syncthreads();
    if (threadIdx.x < 16) flags[threadIdx.x] = 0u;
    const ALAS unsigned char* vpo = L + G_V + ((lane >> 4) & 1) * 32 + (lane & 3) * 8 + (4 * hi + ((lane & 15) >> 2)) * 64;
#define WG_DMA(JT) do { const int sl_ = ((JT) & 1) * 8192; \
        __builtin_amdgcn_global_load_lds((const unsigned*)(Kp + (size_t)(64 * (JT) + lane) * 1024 + 8 * wave), (ALAS unsigned*)(L + G_K + sl_ + wave * 1024), 16, 0, 0); \
        __builtin_amdgcn_global_load_lds((const unsigned*)(Vp + (size_t)(64 * (JT) + 16 * (wave & 3) + (lane >> 2)) * 1024 + 32 * (wave >> 2) + 8 * (lane & 3)), (ALAS unsigned*)(L + G_V + sl_ + wave * 1024), 16, 0, 0); } while (0)
    WG_DMA(jmax);
    bf16x8 qr[4]; float qkb = 0.f, cq = 0.f;
    if (active) {
#pragma unroll
        for (int d0 = 0; d0 < 4; ++d0) qr[d0] = *(const bf16x8*)(Qb + (size_t)(32 * wave + r32) * 1024 + d0 * 16 + hi * 8);
        float qn2 = 0.f;
#pragma unroll
        for (int d0 = 0; d0 < 4; ++d0)
#pragma unroll
            for (int e = 0; e < 8; ++e) { const float v = bf2f(qr[d0][e]); qn2 += v * v; }
        qn2 += __shfl_xor(qn2, 32);
        qkb = __builtin_amdgcn_sqrtf(qn2) * kmaxn * 1.03f + 1.0f;
        cq = ckl[qpos0 + r32];
    } else {
#pragma unroll
        for (int d0 = 0; d0 < 4; ++d0) qr[d0] = bf16x8{};
    }
    float mref = 0.f, l = 0.f; f32x16 o[2]; o[0] = f32x16{}; o[1] = f32x16{};
    f32x4 bpre = *(const f32x4*)(ckl + 64 * jmax + 4 * (lane & 15));
    bool done = false;
    for (int j = jmax; j >= 0; --j) {
        asm volatile("s_waitcnt vmcnt(0)" ::: "memory");
        __syncthreads();
        { unsigned nd = 0;
#pragma unroll
          for (int w = 0; w < 8; ++w) nd += (w < nact) ? flags[((j + 1) & 1) * 8 + w] : 0u;
          if (nd >= (unsigned)nact) break; }
        if (j > 0) WG_DMA(j - 1);
        const f32x4 bcur = bpre;
        if (j > 0) bpre = *(const f32x4*)(ckl + 64 * (j - 1) + 4 * (lane & 15));
        if (active && !done && j <= jd) {
            const ALAS unsigned char* ks = L + G_K + (j & 1) * 8192 + hi * 1024 + r32 * 16;
            f32x16 p0, p1; const float base = cq - mref;
            if (lane < 16) *(ALAS f32x4*)(bl + 4 * lane) = bcur;
            { f32x4 qa[4], qb[4];
#pragma unroll
              for (int jj = 0; jj < 4; ++jj) { qa[jj] = base - *(const ALAS f32x4*)(bl + 8 * jj + 4 * hi); qb[jj] = base - *(const ALAS f32x4*)(bl + 32 + 8 * jj + 4 * hi); }
              p0 = (f32x16){qa[0][0], qa[0][1], qa[0][2], qa[0][3], qa[1][0], qa[1][1], qa[1][2], qa[1][3], qa[2][0], qa[2][1], qa[2][2], qa[2][3], qa[3][0], qa[3][1], qa[3][2], qa[3][3]};
              p1 = (f32x16){qb[0][0], qb[0][1], qb[0][2], qb[0][3], qb[1][0], qb[1][1], qb[1][2], qb[1][3], qb[2][0], qb[2][1], qb[2][2], qb[2][3], qb[3][0], qb[3][1], qb[3][2], qb[3][3]}; }
#pragma unroll
            for (int d0 = 0; d0 < 4; ++d0) { const bf16x8 k0 = *(const ALAS bf16x8*)(ks + d0 * 2048), k1 = *(const ALAS bf16x8*)(ks + d0 * 2048 + 512);
                p0 = __builtin_amdgcn_mfma_f32_32x32x16_bf16(k0, qr[d0], p0, 0, 0, 0); p1 = __builtin_amdgcn_mfma_f32_32x32x16_bf16(k1, qr[d0], p1, 0, 0, 0); }
            if (j == jd) { const int qp = qpos0 + r32, s0 = 64 * j;
#pragma unroll
                for (int r = 0; r < 16; ++r) { const int kv = s0 + crow(r, hi); if (kv > qp) p0[r] = -INFINITY; if (kv + 32 > qp) p1[r] = -INFINITY; } }
            float rm;
            { float a = fmaxf(p0[0], p1[0]);
#pragma unroll
              for (int r = 1; r < 16; ++r) a = fmaxf(a, fmaxf(p0[r], p1[r]));
              rm = fmaxf(a, __shfl_xor(a, 32)); }
            if (j == jd) {
                mref = rm;
#pragma unroll
                for (int r = 0; r < 16; ++r) { p0[r] -= rm; p1[r] -= rm; }
            } else if (__any(rm > 0.f)) {
                const float dl = fmaxf(rm, 0.f); mref += dl;
#pragma unroll
                for (int r = 0; r < 16; ++r) { p0[r] -= dl; p1[r] -= dl; }
                const float f = __builtin_amdgcn_exp2f(-dl); l *= f; if (hi == 0) wsf[r32] = f;
                asm volatile("s_waitcnt lgkmcnt(0)" ::: "memory");
#pragma unroll
                for (int d_ = 0; d_ < 2; ++d_)
#pragma unroll
                    for (int r = 0; r < 16; ++r) o[d_][r] *= wsf[crow(r, hi)];
            }
#pragma unroll
            for (int r = 0; r < 16; ++r) { p0[r] = __builtin_amdgcn_exp2f(p0[r]); p1[r] = __builtin_amdgcn_exp2f(p1[r]); }
            { const f32x16 ps = p0 + p1;
              const f32x4 s4 = ((f32x4){ps[0], ps[1], ps[2], ps[3]} + (f32x4){ps[4], ps[5], ps[6], ps[7]}) + ((f32x4){ps[8], ps[9], ps[10], ps[11]} + (f32x4){ps[12], ps[13], ps[14], ps[15]});
              l += (s4[0] + s4[1]) + (s4[2] + s4[3]); }
            u32x4 pw0, pw1, pw2, pw3;
            pw0 = (u32x4){cvtpk_s(p0[0], p0[1]), cvtpk_s(p0[2], p0[3]), cvtpk_s(p0[4], p0[5]), cvtpk_s(p0[6], p0[7])};
            pw1 = (u32x4){cvtpk_s(p0[8], p0[9]), cvtpk_s(p0[10], p0[11]), cvtpk_s(p0[12], p0[13]), cvtpk_s(p0[14], p0[15])};
            pw2 = (u32x4){cvtpk_s(p1[0], p1[1]), cvtpk_s(p1[2], p1[3]), cvtpk_s(p1[4], p1[5]), cvtpk_s(p1[6], p1[7])};
            pw3 = (u32x4){cvtpk_s(p1[8], p1[9]), cvtpk_s(p1[10], p1[11]), cvtpk_s(p1[12], p1[13]), cvtpk_s(p1[14], p1[15])};
            pv(o, vpo + (j & 1) * 8192, __builtin_bit_cast(bf16x8, pw0), __builtin_bit_cast(bf16x8, pw1), __builtin_bit_cast(bf16x8, pw2), __builtin_bit_cast(bf16x8, pw3));
            if (j == 0) done = true;
            else { const float cl = __uint_as_float(__builtin_amdgcn_readlane(__float_as_uint(bpre[3]), 15));
                const float ub = qkb + (cq - cl) - mref; if (!__any(ub > ATT_EXIT_LOG2)) done = true; }
        }
        if (lane == 0) flags[(j & 1) * 8 + wave] = done ? 1u : 0u;
        asm volatile("s_waitcnt lgkmcnt(0)" ::: "memory");
    }
    if (active) {
        l += __shfl_xor(l, 32);
        if (hi == 0) wsf[32 + r32] = l;
        asm volatile("s_waitcnt lgkmcnt(0)" ::: "memory");
        float rli[16];
#pragma unroll
        for (int r = 0; r < 16; ++r) rli[r] = 1.0f / wsf[32 + crow(r, hi)];
#pragma unroll
        for (int r = 0; r < 16; ++r) { const int orow = crow(r, hi);
#pragma unroll
            for (int d0 = 0; d0 < 2; ++d0) { const unsigned w = cvtpk_s(o[d0][r] * rli[r], 0.f); stg[orow * 64 + d0 * 32 + r32] = (bf16)(w & 0xffffu); } }
        asm volatile("s_waitcnt lgkmcnt(0)" ::: "memory");
        bf16* Op = Ob + (size_t)(32 * wave) * 1024;
#pragma unroll
        for (int i = 0; i < 4; ++i) { const int row = i * 8 + (lane >> 3), ch = lane & 7; const u32x4 v = *(const ALAS u32x4*)(stg + row * 64 + ch * 8); *(u32x4*)(Op + (size_t)row * 1024 + ch * 8) = v; }
        asm volatile("s_waitcnt lgkmcnt(0)" ::: "memory");
    }
#undef WG_DMA
}
#undef ATT_LOADK
#undef ATT_LOADV
}

constexpr int NWAVES = 8;
constexpr int DM = 1024, FF = 2816, NH = 16;
constexpr int MP = 16384, MS = 512, M = MP + MS;
constexpr int TP = 8192, TS = 64, PAST = 2048, TKS = PAST + TS;
constexpr float C2 = 0.125f * 1.4426950408889634f;
constexpr float LOG2E = 1.4426950408889634f;
#ifndef MK_N_LAUNCHES
#define MK_N_LAUNCHES 1
#endif
constexpr int NPHASE = 15;
#ifndef PROBE_P0_REPS
#define PROBE_P0_REPS 1
#endif
#ifndef PROBE_P3_REPS
#define PROBE_P3_REPS 1
#endif
#ifndef PROBE_P1_REPS
#define PROBE_P1_REPS 1
#endif
#ifndef PROBE_P2_REPS
#define PROBE_P2_REPS 1
#endif
#ifndef PROBE_P9_REPS
#define PROBE_P9_REPS 1
#endif
#ifndef PROBE_P7_REPS
#define PROBE_P7_REPS 1
#endif
#ifndef USE_XCD_BAR
#define USE_XCD_BAR 1
#endif
#ifndef RUNTIME_DELAY
#define RUNTIME_DELAY 0
#endif
#ifndef RUNTIME_USE_CG
#define RUNTIME_USE_CG 0
#endif
#ifndef PROBE_ATT_REPS
#define PROBE_ATT_REPS 1
#endif
constexpr size_t OFF_Y = 0, OFF_POOLP = 17301504, OFF_POOLS = 17332224, OFF_LFP = 51009536, OFF_LFS = 52320256, OUT_TOTAL = 52328448;
constexpr size_t MiB = 1u << 20;
constexpr size_t WS_BAR = 65536, WS_CNT = 131072;
constexpr size_t WS_KMX = 0, WS_SS = 1 * MiB, WS_CKLP = 3 * MiB, WS_CKLS = 4 * MiB, WS_WFG = 6 * MiB, WS_WPOOL = 7 * MiB;
constexpr size_t WS_WKVIN = 8 * MiB  , WS_WIN00 = 23 * MiB, WS_WIN01 = 34 * MiB, WS_WIN11 = 45 * MiB, WS_WOUT = 56 * MiB  ;
constexpr size_t WOUT_BYTES = (size_t)DM * FF * 2;
constexpr size_t WS_WQ = 78 * MiB, WS_WO = 80 * MiB, WS_XB = 82 * MiB, WS_ACT = 115 * MiB, WS_QO = WS_ACT, WS_DP = WS_ACT + 33 * MiB;
constexpr size_t WS_KB = 206 * MiB, WS_VB = 238 * MiB, WS_KS = 270 * MiB, WS_VS = 303 * MiB, WS_END = 336 * MiB;
static_assert(WS_WOUT + 4 * WOUT_BYTES <= WS_WQ && WS_XB + (size_t)M * DM * 2 <= WS_ACT && WS_ACT + (size_t)M * FF * 2 <= WS_KB && WS_DP + (size_t)M * DM * 2 <= WS_KB, "ws map");
static_assert(WS_KS + (size_t)8 * TKS * DM * 2 <= WS_VS && WS_VS + (size_t)8 * TKS * DM * 2 <= WS_END && WS_CKLS + (size_t)8 * 16 * TKS * 4 <= WS_WFG, "ws map 2");
constexpr int RING_BYTES = 131072, LDS_BYTES = 147456;

#define LAS __attribute__((address_space(3)))
typedef unsigned short bf16;
typedef unsigned v4u __attribute__((ext_vector_type(4)));
typedef unsigned v2u __attribute__((ext_vector_type(2)));
typedef float f32x4 __attribute__((ext_vector_type(4)));
typedef float f32x2 __attribute__((ext_vector_type(2)));
typedef short bf16x8 __attribute__((ext_vector_type(8)));
#define LDS_WAIT() asm volatile("s_waitcnt lgkmcnt(0)" ::: "memory")
__device__ __forceinline__ unsigned pk2(float lo, float hi) { return pg8::cvt_pk_bf16(lo, hi); }
__device__ __forceinline__ float wave_sum(float v) {
#pragma unroll
    for (int o = 1; o < 64; o <<= 1) v += __shfl_xor(v, o);
    return v;
}
__device__ __forceinline__ void tr_item(const float* W, int K, int N, bf16* WT, int k0, int n0, int drow0, const float* gain, int lane) {
    const int kg = lane >> 3, nl = lane & 7;
    const float* src = W + (size_t)(k0 + 8 * kg) * N + n0 + 4 * nl;
    f32x4 v[8];
#pragma unroll
    for (int i = 0; i < 8; ++i) v[i] = __builtin_nontemporal_load((const f32x4*)(src + (size_t)i * N));
    if (gain) { const f32x4 g0 = *(const f32x4*)(gain + k0 + 8 * kg), g1 = *(const f32x4*)(gain + k0 + 8 * kg + 4);
#pragma unroll
        for (int i = 0; i < 4; ++i) { v[i] = v[i] * g0[i]; v[4 + i] = v[4 + i] * g1[i]; } }
#pragma unroll
    for (int e = 0; e < 4; ++e) { v4u o; o.x = pk2(v[0][e], v[1][e]); o.y = pk2(v[2][e], v[3][e]); o.z = pk2(v[4][e], v[5][e]); o.w = pk2(v[6][e], v[7][e]);
        *(v4u*)(WT + (size_t)(drow0 + 4 * nl + e) * K + k0 + 8 * kg) = o; }
}
template <int W> __device__ __forceinline__ void pool_emit(const f32x4 (&u)[31], int posbase, int t0, bf16* dst  ) {
#pragma unroll
    for (int i = 0; i < 16; ++i) {
        f32x4 s = {0.f, 0.f, 0.f, 0.f};
#pragma unroll
        for (int j = W - 1; j >= 0; --j) s += u[15 + i - j];
        const int pos = posbase + t0 + i; const float cnt = (float)(pos + 1 < W ? pos + 1 : W);
        const f32x4 d = s / cnt - u[15 + i];
        v2u w; w.x = pk2(d[0], d[1]); w.y = pk2(d[2], d[3]);
        *(v2u*)(dst + (size_t)i * 256) = w;
    }
}

#define XB_TMO      128
#define XB_XCNT(j)  (256  + 64 * (j))
#define XB_XSUB(j)  (1280 + 64 * (j))
#define XB_XGEN(j)  (2304 + 64 * (j))
#define XB_TOP      3328
#define XB_TOPGEN   3392
#define XCD_BAR_WORDS 3456
#define XB_SPIN_CAP (1u << 18)

__device__ __forceinline__ unsigned xb_ld(unsigned* p)              { return __hip_atomic_load(p, __ATOMIC_RELAXED, __HIP_MEMORY_SCOPE_AGENT); }
__device__ __forceinline__ unsigned xb_add(unsigned* p, unsigned v) { return __hip_atomic_fetch_add(p, v, __ATOMIC_RELAXED, __HIP_MEMORY_SCOPE_AGENT); }
__device__ __forceinline__ unsigned xb_xcc_id() { return (unsigned)__builtin_amdgcn_s_getreg((3 << 11) | 20) & 0xFu; }
#define XB_SPIN(cond, bar) do { unsigned _sp = 0; while (cond) { __builtin_amdgcn_s_sleep(1); \
    if ((++_sp & 255u) == 0u) { if (xb_ld(&(bar)[XB_TMO])) break; if (_sp > XB_SPIN_CAP) { atomicAdd(&(bar)[XB_TMO], 1u); break; } } } } while (0)

struct XcdBarrier {
    unsigned* bar; unsigned x;
    volatile LAS unsigned* st;
};

__device__ __forceinline__ XcdBarrier xcd_barrier_post(unsigned* bar, volatile LAS unsigned* st) {
    XcdBarrier b; b.bar = bar; b.x = xb_xcc_id(); b.st = st;
    if (threadIdx.x == 0) (void)xb_add(&bar[XB_XCNT(b.x)], 1u);
    return b;
}
__device__ __forceinline__ void xcd_barrier_complete(unsigned* bar, unsigned x, unsigned& nloc, unsigned& nx) {
    const unsigned G = gridDim.x * gridDim.y * gridDim.z;
    unsigned sum, cnt, mine, sp = 0u;
    for (;;) {
        sum = 0u; cnt = 0u; mine = 0u;
#pragma unroll
        for (unsigned j = 0; j < 16; ++j) { const unsigned c = xb_ld(&bar[XB_XCNT(j)]); sum += c; cnt += (c > 0u) ? 1u : 0u; mine = (j == x) ? c : mine; }
        if (sum == G) break;
        __builtin_amdgcn_s_sleep(1);
        if ((++sp & 255u) == 0u) { if (xb_ld(&bar[XB_TMO])) break; if (sp > XB_SPIN_CAP) { atomicAdd(&bar[XB_TMO], 1u); break; } }
    }
    nloc = mine > 0u ? mine : 1u; nx = cnt > 0u ? cnt : 1u;
}

__device__ __forceinline__ void xcd_barrier(const XcdBarrier& b) {
    asm volatile("s_waitcnt vmcnt(0)" ::: "memory");
    __syncthreads();
    if (threadIdx.x == 0) {
        unsigned* bar = b.bar;
        __builtin_amdgcn_s_waitcnt(0);
        unsigned nloc = b.st[0], nx = b.st[1];
        if (nloc == 0u) { xcd_barrier_complete(bar, b.x, nloc, nx); b.st[0] = nloc; b.st[1] = nx; }
        const unsigned old = xb_add(&bar[XB_XSUB(b.x)], 1u);
        const unsigned gen = old / nloc;
        if (old + 1u == (gen + 1u) * nloc) {
            __builtin_amdgcn_fence(__ATOMIC_RELEASE, "agent");
            asm volatile("s_waitcnt vmcnt(0)" ::: "memory");
            const unsigned og = xb_add(&bar[XB_TOP], 1u);
            const unsigned tg = og / nx;
            if (og + 1u == (tg + 1u) * nx) xb_add(&bar[XB_TOPGEN], 1u);
            else XB_SPIN(xb_ld(&bar[XB_TOPGEN]) == tg, bar);
            __builtin_amdgcn_fence(__ATOMIC_ACQUIRE, "agent");
            xb_add(&bar[XB_XGEN(b.x)], 1u);
            asm volatile("s_waitcnt vmcnt(0)" ::: "memory");
        } else {
            XB_SPIN(xb_ld(&bar[XB_XGEN(b.x)]) == gen, bar);
            __builtin_amdgcn_fence(__ATOMIC_ACQUIRE, "agent");
            asm volatile("s_waitcnt vmcnt(0)" ::: "memory");
        }
    }
    __syncthreads();
}
#define GB_SUB(g) (64 * (g))
#define GB_GEN(g) (512 + 64 * (g))
#define GB_TOP 1024
#define GB_TOPGEN 1088
__device__ __forceinline__ void grp_barrier(unsigned* gb, int delay) {
    asm volatile("s_waitcnt vmcnt(0)" ::: "memory");
    __syncthreads();
    if (threadIdx.x == 0) {
        __builtin_amdgcn_fence(__ATOMIC_RELEASE, "agent");
        asm volatile("s_waitcnt vmcnt(0)" ::: "memory");
        for (int d_ = 0; d_ < delay; ++d_) __builtin_amdgcn_s_sleep(16);
        const unsigned g = blockIdx.x & 7u, nloc = gridDim.x >> 3;
        const unsigned old = xb_add(&gb[GB_SUB(g)], 1u), gen = old / nloc;
        if (old + 1u == (gen + 1u) * nloc) {
            const unsigned og = xb_add(&gb[GB_TOP], 1u), tg = og >> 3;
            if (og + 1u == (tg + 1u) * 8u) xb_add(&gb[GB_TOPGEN], 1u);
            else { unsigned sp = 0; while (xb_ld(&gb[GB_TOPGEN]) == tg) { __builtin_amdgcn_s_sleep(1); if (++sp > (1u << 24)) break; } }
            xb_add(&gb[GB_GEN(g)], 1u);
        } else { unsigned sp = 0; while (xb_ld(&gb[GB_GEN(g)]) == gen) { __builtin_amdgcn_s_sleep(1); if (++sp > (1u << 24)) break; } }
        __builtin_amdgcn_fence(__ATOMIC_ACQUIRE, "agent");
        asm volatile("s_waitcnt vmcnt(0)" ::: "memory");
    }
    __syncthreads();
}
struct Args { const float* in[20]; float* out; unsigned char* ws; int ph_lo, ph_hi, use_cg, pad; };

__global__ void __launch_bounds__(NWAVES * 64, 2) mega_fwd(Args args) {
    extern __shared__ __attribute__((aligned(16))) unsigned char lds_raw[];
    cg::grid_group grid = cg::this_grid();
    LAS unsigned char* lds = (LAS unsigned char*)lds_raw;
    const int tid = threadIdx.x, lane = tid & 63, wave = __builtin_amdgcn_readfirstlane(tid >> 6);
    const int G = gridDim.x, bx = blockIdx.x;
    const int gw = bx * NWAVES + wave, NGW = G * NWAVES;
    unsigned char* ws = args.ws; float* dout = args.out;
    const float* x_prompt = args.in[0]; const float* x_sample = args.in[1]; const float* cache_pool = args.in[2];
    const float* cache_k = args.in[3]; const float* cache_v = args.in[4]; const float* cache_logf = args.in[5];
    const float* ln_ffn1 = args.in[6]; const float* ln_mix = args.in[7]; const float* ln_ffn2 = args.in[8];
    const float* w_ffn_in = args.in[9]; const float* w_ffn_out = args.in[10]; const float* w_pool = args.in[11]; const float* pool_scale = args.in[12];
    const float* ln_kv = args.in[13]; const float* w_kv = args.in[14]; const float* w_fgate = args.in[15]; const float* b_fgate = args.in[16];
    const float* w_q = args.in[17]; const float* w_o = args.in[18]; const float* ln_final = args.in[19];
    unsigned* KMX = (unsigned*)(ws + WS_KMX); float* SS = (float*)(ws + WS_SS); float* CKLP = (float*)(ws + WS_CKLP); float* CKLS = (float*)(ws + WS_CKLS);
    bf16* WFG = (bf16*)(ws + WS_WFG); bf16* WPOOL = (bf16*)(ws + WS_WPOOL); bf16* WKVIN = (bf16*)(ws + WS_WKVIN);
    bf16* WIN00 = (bf16*)(ws + WS_WIN00); bf16* WIN01 = (bf16*)(ws + WS_WIN01); bf16* WIN11 = (bf16*)(ws + WS_WIN11);
    bf16* WQ = (bf16*)(ws + WS_WQ); bf16* WO = (bf16*)(ws + WS_WO); bf16* XB = (bf16*)(ws + WS_XB); bf16* ACT = (bf16*)(ws + WS_ACT); bf16* QO = (bf16*)(ws + WS_QO); bf16* DP = (bf16*)(ws + WS_DP); bf16* OB = DP;
    bf16* KB = (bf16*)(ws + WS_KB); bf16* VB = (bf16*)(ws + WS_VB); bf16* KS = (bf16*)(ws + WS_KS); bf16* VS = (bf16*)(ws + WS_VS);
    float* X32 = dout + OFF_Y;
    const int lo = args.ph_lo, hi = args.ph_hi;
#define IN(k) (lo <= (k) && (k) < hi)
    volatile LAS unsigned* MISC = (volatile LAS unsigned*)(lds + LDS_BYTES - 256);
    LAS unsigned* LCNT = (LAS unsigned*)(lds + LDS_BYTES - 1024);
    if (tid < 32) MISC[tid] = 0u;
    if (tid == 32) *LCNT = 0u;
    __syncthreads();
    unsigned* barw = (unsigned*)(ws + WS_BAR); unsigned* CNT = (unsigned*)(ws + WS_CNT);
    XcdBarrier bar; bar.bar = barw; bar.x = 0; bar.st = nullptr;
#define SEAM(k) do { if (IN(k) && IN((k) + 1)) { if ((k) == lo) { grid.sync(); bar = xcd_barrier_post(barw, MISC + 8); } else xcd_barrier(bar); } } while (0)
#define GEMM_PHASE(EPI, E, Aptr, Bptr, Kdim, LDA, PNSTEP, NCOLS) do { pg8::Gemm g_{(const pg8::bf16_t*)(Aptr), (const pg8::bf16_t*)(Bptr), (Kdim), (LDA), (size_t)(PNSTEP)}; \
        pg8::StaticOrder S_; S_.init(M, (NCOLS), G, bx); pg8::gemm_phase<EPI, pg8::StaticOrder, true, true>(lds, g_, S_, E); } while (0)

#define RIDE_PHASE(EPI, E, Bptr, NTILES, SLOT, WOUTP, BASE_LO, BASE_HI, OUT32) do {   \
        { pg8::Gemm g_{(const pg8::bf16_t*)XB, (const pg8::bf16_t*)(Bptr), DM, DM, (size_t)0}; pg8::RideOrder S_; S_.init((NTILES), bx); pg8::gemm_phase<EPI, pg8::RideOrder, true, true>(lds, g_, S_, E); } \
        if (bx >= 248) { const int s_ = bx - 248, pan_ = s_ >> 2; unsigned* cw_ = CNT + 128 * (SLOT) + 64 * pan_; \
            if (tid == 0) { unsigned sp_ = 0; while (__hip_atomic_load(cw_, __ATOMIC_RELAXED, __HIP_MEMORY_SCOPE_AGENT) < (unsigned)(NTILES) * 8u) { __builtin_amdgcn_s_sleep(2); if (++sp_ > (1u << 22)) break; } } \
            __syncthreads(); __builtin_amdgcn_fence(__ATOMIC_ACQUIRE, "agent"); asm volatile("s_waitcnt vmcnt(0)" ::: "memory"); \
            pg8::Gemm g2_{(const pg8::bf16_t*)ACT, (const pg8::bf16_t*)(WOUTP), FF, FF, (size_t)0}; pg8::OneUnit S2_{64 + pan_, s_ & 3}; \
            pg8::EpiRes E2_{(BASE_LO), (BASE_HI), (OUT32), XB, SS, nullptr, 0.5f}; pg8::gemm_phase<pg8::EpiRes, pg8::OneUnit, true, true>(lds, g2_, S2_, E2_); } } while (0)
#define GEMM_PROMPT(EPI, E, Aptr, Bptr, Kdim, LDA, NCOLS) do { pg8::Gemm g_{(const pg8::bf16_t*)(Aptr), (const pg8::bf16_t*)(Bptr), (Kdim), (LDA), (size_t)0}; \
        pg8::StaticOrder S_; S_.init(MP, (NCOLS), G, bx); pg8::gemm_phase<EPI, pg8::StaticOrder, true, true>(lds, g_, S_, E); } while (0)

#define FGATE_ROWS(IT0, IT1, W0, NW) do { \
        const int fr = lane & 15, fq = lane >> 4; \
        for (int it = (IT0) + (W0); it < (IT1); it += (NW)) { \
            const int row = it * 16 + fr; f32x4 acc = {0.f, 0.f, 0.f, 0.f}; \
            const bf16* ap = XB + (size_t)row * DM + 8 * fq; const bf16* bp = WFG + (size_t)fr * DM + 8 * fq; \
_Pragma("unroll 16") \
            for (int ks = 0; ks < 32; ++ks) { const bf16x8 av = *(const bf16x8*)(ap + 32 * ks), bv = *(const bf16x8*)(bp + 32 * ks); acc = __builtin_amdgcn_mfma_f32_16x16x32_bf16(bv, av, acc, 0, 0, 0); } \
            const float rs = pg8::row_rstd(SS, row); const f32x4 bb = *(const f32x4*)(b_fgate + 4 * fq); f32x4 lf; \
_Pragma("unroll") \
            for (int e = 0; e < 4; ++e) { const float z = acc[e] * rs + bb[e]; lf[e] = fminf(z, 0.f) - 0.6931471805599453f * __builtin_amdgcn_logf(1.0f + __builtin_amdgcn_exp2f(-1.4426950408889634f * fabsf(z))); }   \
            float* dp = (row < MP) ? dout + OFF_LFP + (size_t)row * 16 : dout + OFF_LFS + (size_t)(row - MP) * 16; \
            *(f32x4*)(dp + 4 * fq) = lf; \
        } \
    } while (0)

#define CONV_CHUNK(ch) do { LAS float* red = (LAS float*)lds; \
                const int ch_ = (ch), b = ch_ >> 7; float mx[4] = {0.f, 0.f, 0.f, 0.f}; \
                for (int i = 0; i < 2; ++i) { \
                    const int r = ch_ * 16 + wave * 2 + i, s = r & 2047; \
                    const f32x4* kx = (const f32x4*)(cache_k + (size_t)r * DM) + lane; const f32x4* vx = (const f32x4*)(cache_v + (size_t)r * DM) + lane; \
                    f32x4 kv[4], vv[4]; \
_Pragma("unroll") \
                    for (int j = 0; j < 4; ++j) { kv[j] = __builtin_nontemporal_load(kx + 64 * j); vv[j] = __builtin_nontemporal_load(vx + 64 * j); } \
                    v2u* ko = (v2u*)(KS + (size_t)(b * TKS + s) * DM) + lane; v2u* vo = (v2u*)(VS + (size_t)(b * TKS + s) * DM) + lane; \
_Pragma("unroll") \
                    for (int j = 0; j < 4; ++j) { v2u w; w.x = pk2(kv[j].x, kv[j].y); w.y = pk2(kv[j].z, kv[j].w); ko[64 * j] = w; w.x = pk2(vv[j].x, vv[j].y); w.y = pk2(vv[j].z, vv[j].w); vo[64 * j] = w; \
                        float n2 = (kv[j].x * kv[j].x + kv[j].y * kv[j].y) + (kv[j].z * kv[j].z + kv[j].w * kv[j].w); n2 += __shfl_xor(n2, 1); n2 += __shfl_xor(n2, 2); n2 += __shfl_xor(n2, 4); \
                        mx[j] = fmaxf(mx[j], n2); } \
                } \
                if ((lane & 7) == 0) { \
_Pragma("unroll") \
                    for (int j = 0; j < 4; ++j) red[(wave * 4 + j) * 8 + (lane >> 3)] = mx[j]; } \
                __syncthreads(); \
                if (tid < 32) { float v = red[tid]; \
_Pragma("unroll") \
                    for (int w = 1; w < 8; ++w) v = fmaxf(v, red[w * 32 + tid]); \
                    atomicMax(KMX + ((2 + b) * 16 + 4 * (tid >> 3) + ((tid & 7) >> 1)) * 2 + (tid & 1), __float_as_uint(v)); } \
                __syncthreads(); \
    } while (0)

    if (IN(0)) for (int rep0 = 0; rep0 < PROBE_P0_REPS; ++rep0) {
        constexpr int I_IN = 16 * 176, I_OUT = 44 * 32, I_KV = 16 * 64, I_Q = 16 * 32, I_P = 4 * 8;
        constexpr int NITEMS = 4 * I_IN + 4 * I_OUT + I_KV + 2 * I_Q + 4 * I_P;
        for (int it = gw; it < NITEMS; it += NGW) {
            int r = it;
            if (r < 4 * I_IN) { const int f = r / I_IN; r -= f * I_IN; const int kb = r / 176, nb = r % 176, n0 = 32 * nb;
                const int drow = (n0 < FF) ? (n0 >> 7) * 256 + (n0 & 127) : ((n0 - FF) >> 7) * 256 + 128 + ((n0 - FF) & 127);
                bf16* dst = (f == 0) ? WIN00 : (f == 1) ? WIN01 : (f == 2) ? WKVIN + (size_t)2048 * DM : WIN11;
                const float* gain = ((f & 1) ? ln_ffn2 : ln_ffn1) + (f >> 1) * DM;
                tr_item(w_ffn_in + (size_t)f * DM * 2 * FF, DM, 2 * FF, dst, 64 * kb, n0, drow, gain, lane); continue; }
            r -= 4 * I_IN;
            if (r < 4 * I_OUT) { const int f = r / I_OUT; r -= f * I_OUT; const int kb = r / 32, nb = r % 32;
                tr_item(w_ffn_out + (size_t)f * FF * DM, FF, DM, (bf16*)(ws + WS_WOUT + f * WOUT_BYTES), 64 * kb, 32 * nb, 32 * nb, nullptr, lane); continue; }
            r -= 4 * I_OUT;
            if (r < I_KV) { const int kb = r / 64, nb = r % 64; tr_item(w_kv, DM, 2048, WKVIN, 64 * kb, 32 * nb, 32 * nb, ln_kv, lane); continue; }
            r -= I_KV;
            if (r < I_Q) { const int kb = r / 32, nb = r % 32; tr_item(w_q, DM, DM, WQ, 64 * kb, 32 * nb, 32 * nb, ln_mix + DM, lane); continue; }
            r -= I_Q;
            if (r < I_Q) { const int kb = r / 32, nb = r % 32; tr_item(w_o, DM, DM, WO, 64 * kb, 32 * nb, 32 * nb, nullptr, lane); continue; }
            r -= I_Q;
            { const int gq = r / I_P; r -= gq * I_P; const int kb = r / 8, nb = r % 8; tr_item(w_pool + (size_t)gq * 65536, 256, 256, WPOOL, 64 * kb, 32 * nb, gq * 256 + 32 * nb, nullptr, lane); }
        }
        for (int i = bx * 512 + tid; i < 16 * DM; i += G * 512) { const int n = i >> 10, k = i & 1023; WFG[i] = (bf16)(pk2(w_fgate[k * 16 + n] * ln_kv[k], 0.f) & 0xffffu); }
        if (bx == 0) { if (tid < 320) KMX[tid] = 0u; for (int i = tid; i < XCD_BAR_WORDS; i += 512) barw[i] = 0u; CNT[tid] = 0u; }
        for (int m0 = gw; m0 < M; m0 += 2 * NGW) {
            const int m1 = (m0 + NGW < M) ? m0 + NGW : m0;
            const float* xr0 = (m0 < MP) ? x_prompt + (size_t)m0 * DM : x_sample + (size_t)(m0 - MP) * DM;
            const float* xr1 = (m1 < MP) ? x_prompt + (size_t)m1 * DM : x_sample + (size_t)(m1 - MP) * DM;
            const f32x4* xv0 = (const f32x4*)xr0 + lane; const f32x4* xv1 = (const f32x4*)xr1 + lane; f32x4 v0[4], v1[4]; float s0 = 0.f, s1 = 0.f;
#pragma unroll
            for (int j = 0; j < 4; ++j) { v0[j] = __builtin_nontemporal_load(xv0 + 64 * j); v1[j] = __builtin_nontemporal_load(xv1 + 64 * j); }
#pragma unroll
            for (int j = 0; j < 4; ++j) { s0 += (v0[j].x * v0[j].x + v0[j].y * v0[j].y) + (v0[j].z * v0[j].z + v0[j].w * v0[j].w); s1 += (v1[j].x * v1[j].x + v1[j].y * v1[j].y) + (v1[j].z * v1[j].z + v1[j].w * v1[j].w); }
            s0 = wave_sum(s0); s1 = wave_sum(s1);
            v2u* o0 = (v2u*)(XB + (size_t)m0 * DM) + lane; v2u* o1 = (v2u*)(XB + (size_t)m1 * DM) + lane;
#pragma unroll
            for (int j = 0; j < 4; ++j) { v2u w; w.x = pk2(v0[j].x, v0[j].y); w.y = pk2(v0[j].z, v0[j].w); o0[64 * j] = w; w.x = pk2(v1[j].x, v1[j].y); w.y = pk2(v1[j].z, v1[j].w); o1[64 * j] = w; }
            if (lane < 16) { SS[(size_t)m0 * 16 + lane] = (lane == 0) ? s0 : 0.f; SS[(size_t)m1 * 16 + lane] = (lane == 0) ? s1 : 0.f; }
        }
    }
    SEAM(0);
    if (IN(1) && PROBE_P1_REPS > 1) { pg8::EpiSwiglu E{ACT, SS, 0, nullptr, LCNT}; GEMM_PROMPT(pg8::EpiSwiglu, E, XB, WIN00, DM, DM, 2 * FF); }
    if (IN(1)) { pg8::EpiSwiglu E{ACT, SS, 0, CNT + 128 * 0, LCNT}; RIDE_PHASE(pg8::EpiSwiglu, E, WIN00, 22, 0, ws + WS_WOUT, x_prompt, x_sample, (float*)nullptr);
        if (bx >= 196 && bx < 248) for (int k = 0; k < 4; ++k) CONV_CHUNK(0 + (bx - 196) + 52 * k); }
    SEAM(1);
    if (IN(2) && PROBE_P2_REPS > 1) { pg8::EpiRes E{x_prompt, x_sample, nullptr, XB, SS, nullptr, 0.5f}; GEMM_PROMPT(pg8::EpiRes, E, ACT, ws + WS_WOUT, FF, FF, DM); }
    if (IN(2)) { pg8::EpiRes E{x_prompt, x_sample, nullptr, XB, SS, nullptr, 0.5f}; GEMM_PROMPT(pg8::EpiRes, E, ACT, ws + WS_WOUT, FF, FF, DM); }
    SEAM(2);
    if (IN(3)) for (int rep3 = 0; rep3 < PROBE_P3_REPS; ++rep3) {
        LAS float* rsl = (LAS float*)lds;
        const int hb = tid >> 8, t2 = tid & 255;
        for (int it3 = 0; it3 < 3; ++it3) {
            const int item = 2 * bx + hb + 512 * it3; const bool valid = item < 1024 + 32;
            int sb = 0, ch = 0; if (item < 1024) { sb = item >> 9; ch = item & 511; } else if (valid) { const int r = item - 1024; sb = 2 + (r >> 2); ch = r & 3; }
            const bool prompt = sb < 2; const int T = prompt ? TP : TS, t0 = ch * 16, grow0 = prompt ? sb * TP : MP + (sb - 2) * TS;
            if (valid && t2 < 31) { const int t = t0 - 15 + t2; rsl[hb * 32 + t2] = (t >= 0) ? pg8::row_rstd(SS, grow0 + t) : 0.f; }
            __syncthreads();
            if (valid) {
                const int c = 4 * t2; const f32x4 g4 = *(const f32x4*)(ln_mix + c);
                f32x4 u[31];
#pragma unroll
                for (int i = 0; i < 31; ++i) { const int t = t0 - 15 + i;
                    if (t >= 0) { const v2u xw = *(const v2u*)(XB + (size_t)(grow0 + t) * DM + c); const float rs = rsl[hb * 32 + i];
                        u[i] = (f32x4){__uint_as_float(xw.x << 16), __uint_as_float(xw.x & 0xffff0000u), __uint_as_float(xw.y << 16), __uint_as_float(xw.y & 0xffff0000u)} * rs * g4; }
                    else if (!prompt) u[i] = *(const f32x4*)(cache_pool + (size_t)((sb - 2) * 15 + 15 + t) * DM + c);
                    else u[i] = (f32x4){0.f, 0.f, 0.f, 0.f}; }
                const int gq = c >> 8, posbase = prompt ? 0 : PAST;
                bf16* dst = DP + (size_t)gq * M * 256 + (size_t)(grow0 + t0) * 256 + (c & 255);
                if (gq == 0) pool_emit<2>(u, posbase, t0, dst); else if (gq == 1) pool_emit<4>(u, posbase, t0, dst); else if (gq == 2) pool_emit<8>(u, posbase, t0, dst); else pool_emit<16>(u, posbase, t0, dst);
                float* pout = dout + (prompt ? OFF_POOLP + (size_t)sb * 15 * DM : OFF_POOLS + (size_t)(sb - 2) * 15 * DM);
#pragma unroll
                for (int i = 0; i < 16; ++i) { const int t = t0 + i; if (t >= T - 15) *(f32x4*)(pout + (size_t)(t - (T - 15)) * DM + c) = u[15 + i]; }
            }
            __syncthreads();
        }
    }
    SEAM(3);
    if (IN(4)) { pg8::EpiRes E{nullptr, nullptr, nullptr, XB, SS, pool_scale, 1.0f}; GEMM_PHASE(pg8::EpiRes, E, DP, WPOOL, 256, 256, (size_t)M * 256 * 2, DM); }
    SEAM(4);
    if (IN(5)) { pg8::EpiSwiglu E{ACT, SS, 0, CNT + 128 * 1, LCNT}; RIDE_PHASE(pg8::EpiSwiglu, E, WIN01, 22, 1, ws + WS_WOUT + WOUT_BYTES, (const float*)nullptr, (const float*)nullptr, (float*)nullptr);
        if (bx >= 196 && bx < 248) for (int k = 0; k < 4; ++k) CONV_CHUNK(208 + (bx - 196) + 52 * k); }
    SEAM(5);
    if (IN(6)) { pg8::EpiRes E{nullptr, nullptr, nullptr, XB, SS, nullptr, 0.5f}; GEMM_PROMPT(pg8::EpiRes, E, ACT, ws + WS_WOUT + WOUT_BYTES, FF, FF, DM);
        FGATE_ROWS(MP / 16, M / 16, gw, NGW); }
    SEAM(6);
    if (IN(7) && PROBE_P7_REPS > 1) { pg8::EpiKVSwiglu E{pg8::EpiKV{dout, KB, VB, KS, VS, SS, KMX, nullptr}, pg8::EpiSwiglu{ACT, SS, 8, nullptr, LCNT}}; GEMM_PROMPT(pg8::EpiKVSwiglu, E, XB, WKVIN, DM, DM, 2048 + 2 * FF); }
    if (IN(7)) {
        pg8::EpiKVSwiglu E{pg8::EpiKV{dout, KB, VB, KS, VS, SS, KMX, CNT + 128 * 2}, pg8::EpiSwiglu{ACT, SS, 8, CNT + 128 * 2, LCNT}};
        RIDE_PHASE(pg8::EpiKVSwiglu, E, WKVIN, 30, 2, ws + WS_WOUT + 2 * WOUT_BYTES, (const float*)nullptr, (const float*)nullptr, (float*)nullptr);
        if (bx >= 212 && bx < 248) for (int k = 0; k < 4; ++k) CONV_CHUNK(416 + (bx - 212) + 36 * k);
        FGATE_ROWS(0, MP / 16, gw, NGW);
    }
    SEAM(7);
    if (IN(8)) {
        pg8::EpiRes E{nullptr, nullptr, nullptr, XB, SS, nullptr, 0.5f}; GEMM_PROMPT(pg8::EpiRes, E, ACT, ws + WS_WOUT + 2 * WOUT_BYTES, FF, FF, DM);
    }
    SEAM(8);
    if (IN(9)) for (int rep9 = 0; rep9 < PROBE_P9_REPS; ++rep9) { { pg8::EpiQ E{QO, SS, C2}; GEMM_PHASE(pg8::EpiQ, E, XB, WQ, DM, DM, 0, DM); }
        if (bx >= 8 && bx < 246) {
            for (int ch = 560 + bx - 8; ch < 1024; ch += 238) CONV_CHUNK(ch);
        }
        LAS f32x4* part4 = (LAS f32x4*)lds;
        for (int sb = G - 1 - bx; sb < 10; sb += G) {
            const bool prompt = sb < 2; const int b = prompt ? 0 : sb - 2, T = prompt ? TP : TKS, NCH = prompt ? 128 : 66, CH = prompt ? 64 : 32, c = tid >> 2, hq = tid & 3;
            const float* srcA = prompt ? dout + OFF_LFP + (size_t)sb * TP * 16 : cache_logf + (size_t)b * PAST * 16;
            const float* srcB = dout + OFF_LFS + (size_t)b * TS * 16 - (size_t)PAST * 16;
#define LF4_AT(t) (*(const f32x4*)((((prompt) || (t) < PAST) ? srcA : srcB) + (size_t)(t) * 16 + 4 * hq))
            f32x4 s = {0.f, 0.f, 0.f, 0.f};
            if (c < NCH) for (int t0 = c * CH; t0 < (c + 1) * CH; t0 += 16) { f32x4 v[16];
#pragma unroll
                for (int i = 0; i < 16; ++i) v[i] = LF4_AT(t0 + i);
#pragma unroll
                for (int i = 0; i < 16; ++i) s += v[i]; }
            part4[c * 4 + hq] = s; __syncthreads();
            if (c < NCH) {
                f32x4 run = {0.f, 0.f, 0.f, 0.f}; for (int cc = 0; cc < c; ++cc) run += part4[cc * 4 + hq];
                float* dst = (prompt ? CKLP + (size_t)(sb * 16 + 4 * hq) * TP : CKLS + (size_t)(b * 16 + 4 * hq) * TKS);
                for (int t0 = c * CH; t0 < (c + 1) * CH; t0 += 16) { f32x4 v[16];
#pragma unroll
                    for (int i = 0; i < 16; ++i) v[i] = LF4_AT(t0 + i);
#pragma unroll
                    for (int i = 0; i < 16; ++i) { run += v[i]; v[i] = run * LOG2E; }
#pragma unroll
                    for (int e = 0; e < 4; ++e)
#pragma unroll
                        for (int i = 0; i < 4; ++i) *(f32x4*)(dst + (size_t)e * T + t0 + 4 * i) = (f32x4){v[4 * i][e], v[4 * i + 1][e], v[4 * i + 2][e], v[4 * i + 3][e]}; }
            }
#undef LF4_AT
            __syncthreads();
        }
    }
    SEAM(9);
    if (IN(10)) {
        for (int rep = 0; rep < PROBE_ATT_REPS; ++rep)
        for (int gi = bx; gi < 1024 + 128; gi += G) {
            int qrow0, qbase, sb, h, nact; const bf16 *Kp, *Vp; const float* ckl;
            if (gi < 1024) { const int bh = gi >> 5, qb = gi & 31, b = bh >> 4; h = bh & 15; sb = b; qrow0 = b * TP + 256 * qb; qbase = 256 * qb; nact = 8;
                Kp = KB + (size_t)b * TP * DM + h * 64; Vp = VB + (size_t)b * TP * DM + h * 64; ckl = CKLP + (size_t)bh * TP; }
            else { const int bh = gi - 1024, b = bh >> 4; h = bh & 15; sb = 2 + b; qrow0 = MP + b * TS; qbase = PAST; nact = 2;
                Kp = KS + (size_t)b * TKS * DM + h * 64; Vp = VS + (size_t)b * TKS * DM + h * 64; ckl = CKLS + (size_t)bh * TKS; }
            const float kmaxn = __builtin_amdgcn_sqrtf(__uint_as_float(KMX[(sb * 16 + h) * 2]) + __uint_as_float(KMX[(sb * 16 + h) * 2 + 1]));
            att::wg_unit(QO + (size_t)qrow0 * DM + h * 64, OB + (size_t)qrow0 * DM + h * 64, Kp, Vp, ckl, qbase, nact, kmaxn, lds, wave, lane);
        }
        __syncthreads();
    }
    SEAM(10);
    if (IN(11)) { pg8::EpiRes E{nullptr, nullptr, nullptr, XB, SS, nullptr, 1.0f}; GEMM_PHASE(pg8::EpiRes, E, OB, WO, DM, DM, 0, DM); }
    SEAM(11);
    if (IN(12)) { pg8::EpiSwiglu E{ACT, SS, 0, CNT + 128 * 3, LCNT}; RIDE_PHASE(pg8::EpiSwiglu, E, WIN11, 22, 3, ws + WS_WOUT + 3 * WOUT_BYTES, (const float*)nullptr, (const float*)nullptr, (float*)nullptr); }
    SEAM(12);
    if (IN(13)) { pg8::EpiRes E{nullptr, nullptr, nullptr, XB, SS, nullptr, 0.5f}; GEMM_PROMPT(pg8::EpiRes, E, ACT, ws + WS_WOUT + 3 * WOUT_BYTES, FF, FF, DM); }
    SEAM(13);
    if (IN(14)) {
        for (int m0 = gw; m0 < M; m0 += 2 * NGW) {
            const int m1 = (m0 + NGW < M) ? m0 + NGW : m0;
            const v2u* xa = (const v2u*)(XB + (size_t)m0 * DM) + lane; const v2u* xb = (const v2u*)(XB + (size_t)m1 * DM) + lane; const f32x4* gv = (const f32x4*)ln_final + lane;
            v2u wa[4], wb[4];
#pragma unroll
            for (int j = 0; j < 4; ++j) { wa[j] = xa[64 * j]; wb[j] = xb[64 * j]; }
            const float ra = pg8::row_rstd(SS, m0), rb = pg8::row_rstd(SS, m1);
            f32x4* ya = (f32x4*)(X32 + (size_t)m0 * DM) + lane; f32x4* yb = (f32x4*)(X32 + (size_t)m1 * DM) + lane;
#pragma unroll
            for (int j = 0; j < 4; ++j) { const f32x4 g = gv[64 * j];
                __builtin_nontemporal_store((f32x4){__uint_as_float(wa[j].x << 16) * ra * g.x, __uint_as_float(wa[j].x & 0xffff0000u) * ra * g.y, __uint_as_float(wa[j].y << 16) * ra * g.z, __uint_as_float(wa[j].y & 0xffff0000u) * ra * g.w}, ya + 64 * j);
                __builtin_nontemporal_store((f32x4){__uint_as_float(wb[j].x << 16) * rb * g.x, __uint_as_float(wb[j].x & 0xffff0000u) * rb * g.y, __uint_as_float(wb[j].y << 16) * rb * g.z, __uint_as_float(wb[j].y & 0xffff0000u) * rb * g.w}, yb + 64 * j); }
        }
    }
#undef IN
#undef SEAM
#undef GEMM_PHASE
#undef GEMM_PROMPT
#undef RIDE_PHASE
#undef CONV_CHUNK
#undef FGATE_ROWS
}

extern "C" void kernel_launch(void* const* d_in, const int* in_sizes, int n_in, void* d_out, int out_size, void* d_ws, size_t ws_size, hipStream_t stream) {
    static int grid = 0;
    if (grid == 0) {
        if (n_in != 20 || (size_t)out_size != OUT_TOTAL || ws_size < WS_END) { fprintf(stderr, "kernel_launch: unexpected shapes (n_in %d out %d ws %zu)\n", n_in, out_size, ws_size); grid = -1; return; }
        int dev = 0, cus = 0, per_cu = 0;
        if (hipGetDevice(&dev) != hipSuccess || hipDeviceGetAttribute(&cus, hipDeviceAttributeMultiprocessorCount, dev) != hipSuccess) { grid = -1; return; }
        if (hipFuncSetAttribute((const void*)mega_fwd, hipFuncAttributeMaxDynamicSharedMemorySize, LDS_BYTES) != hipSuccess) { fprintf(stderr, "kernel_launch: hipFuncSetAttribute failed\n"); grid = -1; return; }
        if (hipOccupancyMaxActiveBlocksPerMultiprocessor(&per_cu, (const void*)mega_fwd, NWAVES * 64, LDS_BYTES) != hipSuccess || per_cu < 1) { fprintf(stderr, "kernel_launch: occupancy query says %d\n", per_cu); (void)hipGetLastError(); grid = -1; return; }
        if (cus != 256) { fprintf(stderr, "kernel_launch: built for a 256-CU device (got %d)\n", cus); grid = -1; return; }
        grid = cus * 1;
    }
    if (grid < 0) return;
    Args a{};
    for (int i = 0; i < 20; ++i) a.in[i] = (const float*)d_in[i];
    a.out = (float*)d_out; a.ws = (unsigned char*)d_ws; a.use_cg = RUNTIME_USE_CG; a.pad = RUNTIME_DELAY;
#if MK_N_LAUNCHES == 1
    a.ph_lo = 0; a.ph_hi = NPHASE;
    void* kargs[] = {&a};
    hipError_t e = hipLaunchCooperativeKernel((const void*)mega_fwd, dim3(grid), dim3(NWAVES * 64), kargs, LDS_BYTES, stream);
    if (e != hipSuccess) fprintf(stderr, "cooperative launch failed: %s (grid %d)\n", hipGetErrorString(e), grid);
#else
    for (int p = 0; p < NPHASE; ++p) { a.ph_lo = p; a.ph_hi = p + 1; hipLaunchKernelGGL(mega_fwd, dim3(grid), dim3(NWAVES * 64), LDS_BYTES, stream, a); }
#endif
}
```
